# Optimizing an MI355X kernel written in HIP

```python
import numpy as np
import jax, jax.numpy as jnp
from jax import lax

D_MODEL = 1024
BATCH = 1
SEQ = 16384
DEPTH = 2

HEAD_DIM = 64
N_A_LAYERS = DEPTH // 2
N_B_LAYERS = DEPTH - N_A_LAYERS
MEM_LEN = 256
MEM_HEADS = 4
MEM_W = MEM_HEADS * HEAD_DIM
CONV_W = D_MODEL - MEM_W
CONV_K = 31
NSA_HEADS = (D_MODEL - MEM_W) // HEAD_DIM
NSA_W = NSA_HEADS * HEAD_DIM
NSA_KV_GROUPS = 2
HEADS_PER_GROUP = NSA_HEADS // NSA_KV_GROUPS
CMP_L = 32
CMP_STRIDE = 16
CMP_HID = 256
SEL_L = 64
N_SEL = 16
WIN = 512
Q_BLOCK = 128
D_FF = 4 * D_MODEL
KV_W = 6 * NSA_KV_GROUPS * HEAD_DIM
A_IN_W = 2 * CONV_W + MEM_W
B_IN_W = NSA_W + MEM_W + 3 * NSA_HEADS

kernel_name = 'yoco_conformer_nsa_hybrid'


def rms_norm(x, g, eps=1e-6):
    xf = x.astype(jnp.float32)
    y = xf * lax.rsqrt(jnp.mean(xf * xf, axis=-1, keepdims=True) + eps)
    return (y * g.astype(jnp.float32)).astype(x.dtype)


def layer_norm(x, g, b, eps=1e-5):
    xf = x.astype(jnp.float32)
    mu = jnp.mean(xf, axis=-1, keepdims=True)
    var = jnp.mean(jnp.square(xf - mu), axis=-1, keepdims=True)
    y = (xf - mu) * lax.rsqrt(var + eps)
    return (y * g.astype(jnp.float32) + b.astype(jnp.float32)).astype(x.dtype)


def masked_softmax(s, mask):
    s = jnp.where(mask, s.astype(jnp.float32), -jnp.inf)
    m = jnp.max(s, axis=-1, keepdims=True)
    m = jnp.where(jnp.isfinite(m), m, 0.0)
    e = jnp.exp(s - m)
    return e / jnp.maximum(jnp.sum(e, axis=-1, keepdims=True), 1e-30)


def selection_map(n_cmp, n_sb):
    cs = np.arange(n_cmp)[:, None] * CMP_STRIDE
    ss = np.arange(n_sb)[None, :] * SEL_L
    ov = np.minimum(cs + CMP_L, ss + SEL_L) - np.maximum(cs, ss)
    return (np.clip(ov, 0, None) / CMP_STRIDE).astype(np.float32)


def squared_relu_mlp(h, w_in, w_out):
    return jnp.square(jax.nn.relu(h @ w_in)) @ w_out


def memory_attention(q, mk, mv):
    B, S = q.shape[:2]
    s = jnp.einsum('bshd,bmhd->bhsm', q, mk) * HEAD_DIM ** -0.5
    p = jax.nn.softmax(s.astype(jnp.float32), axis=-1)
    return jnp.einsum('bhsm,bmhd->bshd', p.astype(mv.dtype), mv).reshape(B, S, MEM_W)


def conformer_conv(u, dw, dw_b, ln_g, ln_b):
    a, gate = jnp.split(u, 2, axis=-1)
    v = a * jax.nn.sigmoid(gate)
    v = lax.conv_general_dilated(v, dw[:, None, :], window_strides=(1,),
                                 padding=[(CONV_K - 1, 0)],
                                 dimension_numbers=('NWC', 'WIO', 'NWC'),
                                 feature_group_count=CONV_W) + dw_b
    return jax.nn.silu(layer_norm(v, ln_g, ln_b))


def shared_nsa_kv(h, kv_norm_g, w_kv, k_norm_g, pe_k, pe_v, w1_k, w2_k, w1_v, w2_v):
    B, S = h.shape[:2]
    G, HD = NSA_KV_GROUPS, HEAD_DIM
    kv = (rms_norm(h, kv_norm_g) @ w_kv).reshape(B, S, 6, G, HD)
    k_c, v_c, k_s, v_s, k_w, v_w = (kv[:, :, i] for i in range(6))
    n_cmp = (S - CMP_L) // CMP_STRIDE + 1
    idx = np.arange(n_cmp)[:, None] * CMP_STRIDE + np.arange(CMP_L)[None, :]

    def compress(t, pe, w1, w2):
        blk = t[:, idx] + pe[:, None, :]
        blk = blk.transpose(0, 1, 3, 2, 4).reshape(B, n_cmp, G, CMP_L * HD)
        return jax.nn.gelu(blk @ w1) @ w2

    k_cmp = rms_norm(compress(k_c, pe_k, w1_k, w2_k), k_norm_g[0])
    v_cmp = compress(v_c, pe_v, w1_v, w2_v)
    n_sb = S // SEL_L
    k_blk = rms_norm(k_s, k_norm_g[1]).reshape(B, n_sb, SEL_L, G, HD).transpose(0, 3, 1, 2, 4)
    v_blk = v_s.reshape(B, n_sb, SEL_L, G, HD).transpose(0, 3, 1, 2, 4)
    pad = ((0, 0), (WIN, 0), (0, 0), (0, 0))
    k_win = jnp.pad(rms_norm(k_w, k_norm_g[2]), pad)
    v_win = jnp.pad(v_w, pad)
    return k_cmp, v_cmp, k_blk, v_blk, k_win, v_win


def nsa_attention(q, gates, k_cmp, v_cmp, k_blk, v_blk, k_win, v_win):
    B, S = q.shape[:2]
    G, HG, HD = NSA_KV_GROUPS, HEADS_PER_GROUP, HEAD_DIM
    n_qb = S // Q_BLOCK
    n_cmp = k_cmp.shape[1]
    n_sb = k_blk.shape[2]
    n_sel = min(N_SEL, n_sb)
    scale = HD ** -0.5
    cmp_end = jnp.asarray(np.arange(n_cmp) * CMP_STRIDE + CMP_L - 1)
    sel_map = jnp.asarray(selection_map(n_cmp, n_sb))
    blk_ids = jnp.arange(n_sb)
    b_ix = jnp.arange(B)[:, None, None, None]
    g_ix = jnp.arange(G)[None, None, :, None]
    qs = q.reshape(B, n_qb, Q_BLOCK, G, HG, HD).transpose(1, 0, 2, 3, 4, 5)
    gs = gates.reshape(B, n_qb, Q_BLOCK, G, HG, 3).transpose(1, 0, 2, 3, 4, 5)

    def block(args):
        c, qb, gb = args
        t = c * Q_BLOCK + jnp.arange(Q_BLOCK)
        s = jnp.einsum('bqghd,bngd->bqghn', qb, k_cmp) * scale
        p_cmp = masked_softmax(s, (cmp_end[None, :] <= t[:, None])[None, :, None, None, :])
        o_cmp = jnp.einsum('bqghn,bngd->bqghd', p_cmp.astype(v_cmp.dtype), v_cmp)
        imp = jnp.einsum('bqgn,nj->bqgj', jnp.sum(p_cmp, axis=3), sel_map)
        tb = (t // SEL_L)[:, None]
        valid = (blk_ids[None, :] <= tb)[None, :, None, :]
        forced = ((blk_ids[None, :] == 0) | (blk_ids[None, :] == tb)
                  | (blk_ids[None, :] == tb - 1))[None, :, None, :]
        score = jnp.where(forced, jnp.inf, jnp.where(valid, imp, -jnp.inf))
        top_val, top_idx = lax.top_k(score, n_sel)
        kg = k_blk[b_ix, g_ix, top_idx]
        vg = v_blk[b_ix, g_ix, top_idx]
        pos = top_idx[..., None] * SEL_L + jnp.arange(SEL_L)
        smask = (top_val > -jnp.inf)[..., None] & (pos <= t[None, :, None, None, None])
        s = jnp.einsum('bqghd,bqgnkd->bqghnk', qb, kg) * scale
        n_tok = n_sel * SEL_L
        p = masked_softmax(s.reshape(B, Q_BLOCK, G, HG, n_tok),
                           smask.reshape(B, Q_BLOCK, G, 1, n_tok))
        o_slc = jnp.einsum('bqghm,bqgmd->bqghd', p.astype(vg.dtype),
                           vg.reshape(B, Q_BLOCK, G, n_tok, HD))
        kw = lax.dynamic_slice_in_dim(k_win, c * Q_BLOCK, Q_BLOCK + WIN, axis=1)
        vw = lax.dynamic_slice_in_dim(v_win, c * Q_BLOCK, Q_BLOCK + WIN, axis=1)
        kp = c * Q_BLOCK - WIN + jnp.arange(Q_BLOCK + WIN)
        wmask = (kp[None, :] <= t[:, None]) & (kp[None, :] > t[:, None] - WIN) & (kp[None, :] >= 0)
        s = jnp.einsum('bqghd,bkgd->bqghk', qb, kw) * scale
        p = masked_softmax(s, wmask[None, :, None, None, :])
        o_win = jnp.einsum('bqghk,bkgd->bqghd', p.astype(vw.dtype), vw)
        o = o_cmp * gb[..., 0:1] + o_slc * gb[..., 1:2] + o_win * gb[..., 2:3]
        return o.reshape(B, Q_BLOCK, NSA_W)

    out = lax.map(block, (jnp.arange(n_qb), qs, gs))
    return out.transpose(1, 0, 2, 3).reshape(B, S, NSA_W)


def setup_inputs(seed: int = 0) -> dict:
    key = jax.random.key(seed)
    ks = iter(jax.random.split(key, 32))

    def w(shape, fan_in):
        return jax.random.normal(next(ks), shape, jnp.float32) * fan_in ** -0.5

    def gain(shape):
        return 1.0 + 0.1 * jax.random.normal(next(ks), shape, jnp.float32)

    def bias(shape):
        return 0.01 * jax.random.normal(next(ks), shape, jnp.float32)

    return {
        'x': jax.random.normal(next(ks), (BATCH, SEQ, D_MODEL), jnp.float32),
        'mem': jax.random.normal(next(ks), (BATCH, MEM_LEN, D_MODEL), jnp.float32),
        'norm_mix_g': gain((DEPTH, D_MODEL)),
        'norm_mlp_g': gain((DEPTH, D_MODEL)),
        'mem_norm_g': gain((D_MODEL,)),
        'w_mem_kv': w((DEPTH, D_MODEL, 2 * MEM_W), D_MODEL),
        'mem_q_norm_g': gain((DEPTH, HEAD_DIM)),
        'mem_k_norm_g': gain((DEPTH, HEAD_DIM)),
        'w_out': w((DEPTH, D_MODEL, D_MODEL), D_MODEL),
        'w_mlp_in': w((DEPTH, D_MODEL, D_FF), D_MODEL),
        'w_mlp_out': w((DEPTH, D_FF, D_MODEL), D_FF),
        'a_w_in': w((N_A_LAYERS, D_MODEL, A_IN_W), D_MODEL),
        'a_b_glu': bias((N_A_LAYERS, 2 * CONV_W)),
        'a_dw': w((N_A_LAYERS, CONV_K, CONV_W), CONV_K),
        'a_dw_b': bias((N_A_LAYERS, CONV_W)),
        'a_ln_g': gain((N_A_LAYERS, CONV_W)),
        'a_ln_b': bias((N_A_LAYERS, CONV_W)),
        'b_w_in': w((N_B_LAYERS, D_MODEL, B_IN_W), D_MODEL),
        'b_gate_b': bias((N_B_LAYERS, 3 * NSA_HEADS)),
        'b_q_norm_g': gain((N_B_LAYERS, HEAD_DIM)),
        'kv_norm_g': gain((D_MODEL,)),
        'w_kv': w((D_MODEL, KV_W), D_MODEL),
        'k_norm_g': gain((3, HEAD_DIM)),
        'cmp_pe_k': 0.1 * jax.random.normal(next(ks), (CMP_L, HEAD_DIM), jnp.float32),
        'cmp_pe_v': 0.1 * jax.random.normal(next(ks), (CMP_L, HEAD_DIM), jnp.float32),
        'cmp_w1_k': w((CMP_L * HEAD_DIM, CMP_HID), CMP_L * HEAD_DIM),
        'cmp_w2_k': w((CMP_HID, HEAD_DIM), CMP_HID),
        'cmp_w1_v': w((CMP_L * HEAD_DIM, CMP_HID), CMP_L * HEAD_DIM),
        'cmp_w2_v': w((CMP_HID, HEAD_DIM), CMP_HID),
    }


def reference(x, mem, norm_mix_g, norm_mlp_g, mem_norm_g, w_mem_kv, mem_q_norm_g, mem_k_norm_g,
              w_out, w_mlp_in, w_mlp_out, a_w_in, a_b_glu, a_dw, a_dw_b, a_ln_g, a_ln_b,
              b_w_in, b_gate_b, b_q_norm_g, kv_norm_g, w_kv, k_norm_g, cmp_pe_k, cmp_pe_v,
              cmp_w1_k, cmp_w2_k, cmp_w1_v, cmp_w2_v):
    B, S = x.shape[:2]
    mem_n = rms_norm(mem, mem_norm_g)
    shared = None
    for l in range(DEPTH):
        mkv = (mem_n @ w_mem_kv[l]).reshape(B, MEM_LEN, 2, MEM_HEADS, HEAD_DIM)
        mk = rms_norm(mkv[:, :, 0], mem_k_norm_g[l])
        mv = mkv[:, :, 1]
        h = rms_norm(x, norm_mix_g[l])
        if l == N_A_LAYERS:
            shared = shared_nsa_kv(x, kv_norm_g, w_kv, k_norm_g, cmp_pe_k, cmp_pe_v,
                                   cmp_w1_k, cmp_w2_k, cmp_w1_v, cmp_w2_v)
        if l < N_A_LAYERS:
            i = l
            u = h @ a_w_in[i]
            conv_out = conformer_conv(u[..., :2 * CONV_W] + a_b_glu[i], a_dw[i], a_dw_b[i],
                                      a_ln_g[i], a_ln_b[i])
            qm = rms_norm(u[..., 2 * CONV_W:].reshape(B, S, MEM_HEADS, HEAD_DIM), mem_q_norm_g[l])
            mix = jnp.concatenate([conv_out, memory_attention(qm, mk, mv)], axis=-1)
        else:
            i = l - N_A_LAYERS
            u = h @ b_w_in[i]
            q = rms_norm(u[..., :NSA_W].reshape(B, S, NSA_HEADS, HEAD_DIM), b_q_norm_g[i])
            qm = rms_norm(u[..., NSA_W:NSA_W + MEM_W].reshape(B, S, MEM_HEADS, HEAD_DIM),
                          mem_q_norm_g[l])
            gates = jax.nn.sigmoid(u[..., NSA_W + MEM_W:] + b_gate_b[i]).reshape(B, S, NSA_HEADS, 3)
            nsa_out = nsa_attention(q, gates, *shared)
            mix = jnp.concatenate([nsa_out, memory_attention(qm, mk, mv)], axis=-1)
        x = x + mix @ w_out[l]
        x = x + squared_relu_mlp(rms_norm(x, norm_mlp_g[l]), w_mlp_in[l], w_mlp_out[l])
    return x
```

```cpp
#include <hip/hip_runtime.h>
#include <hip/hip_cooperative_groups.h>
#include <cstdio>
#include <cstdint>
namespace cg = cooperative_groups;

#define LAS __attribute__((address_space(3)))
typedef unsigned short bf16;
typedef short bf16x8 __attribute__((ext_vector_type(8)));
typedef short s16x4 __attribute__((ext_vector_type(4)));
typedef float f32x2 __attribute__((ext_vector_type(2)));
typedef float f32x4 __attribute__((ext_vector_type(4)));
typedef float f32x16 __attribute__((ext_vector_type(16)));
typedef unsigned u32x2 __attribute__((ext_vector_type(2)));
typedef unsigned u32x4 __attribute__((ext_vector_type(4)));
typedef __bf16 bf16x2_t __attribute__((ext_vector_type(2)));
#define DI __device__ __forceinline__

DI unsigned pk2(float lo, float hi) { f32x2 v = {lo, hi}; bf16x2_t b = __builtin_convertvector(v, bf16x2_t); return __builtin_bit_cast(unsigned, b); }
DI float wave_sum(float v) {
#pragma unroll
    for (int o = 1; o < 64; o <<= 1) v += __shfl_xor(v, o);
    return v;
}
DI float wave_max(float v) {
#pragma unroll
    for (int o = 1; o < 64; o <<= 1) v = fmaxf(v, __shfl_xor(v, o));
    return v;
}
DI unsigned wave_max_u32(unsigned x) {
#define WMX(ctrl, rm) { const unsigned y = (unsigned)__builtin_amdgcn_update_dpp(0, (int)x, ctrl, rm, 0xf, false); x = y > x ? y : x; }
    WMX(0x111, 0xf) WMX(0x112, 0xf) WMX(0x114, 0xf) WMX(0x118, 0xf) WMX(0x142, 0xa) WMX(0x143, 0xc)
#undef WMX
    return (unsigned)__builtin_amdgcn_readlane((int)x, 63);
}
DI float sigmoidf_(float x) { return 1.0f / (1.0f + __expf(-x)); }
#define LDS_WAIT() asm volatile("s_waitcnt lgkmcnt(0)" ::: "memory")

constexpr int S = 16384, D = 1024, FF = 4096, MEML = 256;
constexpr float EPS = 1e-6f;
constexpr float QSCALE = 0.125f * 1.4426950408889634f;
constexpr float BNDC = 64.0f * QSCALE;

namespace pg8 {
#define PG8_LAS __attribute__((address_space(3)))
constexpr int BM = 256, BK = 64, HALF = 128, HTB = HALF * BK * 2, STAGE_BYTES = 8 * HTB, NXCD = 8, WGM = 4;
__host__ __device__ __forceinline__ int lds_byte(int r, int c) { const int st = (r >> 4) * 2 + (c >> 5), rr = r & 15, cc = c & 31, ob = rr * 64 + cc * 2; return st * 1024 + (ob ^ (((ob >> 9) & 1) << 5)); }
__host__ __device__ __forceinline__ void stage_rc(int b, int& R, int& C) { const int st = b / 1024, sb = b % 1024, swz = sb ^ (((sb >> 9) & 1) << 5); R = (st >> 1) * 16 + swz / 64; C = (st & 1) * 32 + (swz % 64) / 2; }
__host__ __device__ __forceinline__ int perm32(int rho) { const int n = rho >> 4, i = rho & 15; return 8 * (i >> 2) + 4 * n + (i & 3); }
struct Unit { int pm, pn; };
struct Gemm { const bf16* A; const bf16* Bt; int M, N, K, lda; };
struct StaticOrder {
    int nM, nN, nwg, G, c, wgm;
    __device__ void init(int M, int N, int G_, int c_, int wgm_ = WGM) { nM = M / BM; nN = N / BM; nwg = nM * nN; G = G_; c = c_; wgm = wgm_; }
    __device__ bool next(int i, Unit& u) const {
        const long L = (long)i * G + c; if (L >= nwg) return false;
        int wgid = (int)L; { const int q = nwg / NXCD, r = nwg % NXCD, xcd = wgid % NXCD, off = wgid / NXCD; wgid = (xcd < r ? xcd * (q + 1) : r * (q + 1) + (xcd - r) * q) + off; }
        const int nig = wgm * nN, gid = wgid / nig, fm = gid * wgm, gsz = (nM - fm) < wgm ? (nM - fm) : wgm;
        u.pm = fm + ((wgid % nig) % gsz); u.pn = (wgid % nig) / gsz; return true;
    }
    __device__ size_t aoff(const Unit&) const { return 0; }
};
struct ListOrder {
    int n, nN, G, c, cmp;
    __device__ bool next(int i, Unit& u) const { const int L = c + i * G; if (c < 0 || L >= n) return false; if (cmp) { u.pm = L >> 2; u.pn = (L >> 5) * 4 + (L & 3); } else { u.pm = L / nN; u.pn = L % nN; } return true; }
    __device__ size_t aoff(const Unit& u) const { return cmp ? (size_t)(u.pn & 3) * 1024 : 0; }
};

template <class Epi, class Sched, bool ALIGN_EPI>
__device__ __forceinline__ void gemm_phase(PG8_LAS unsigned char* lds, const Gemm g, const Sched& S, const Epi& E) {
    const int tid = threadIdx.x, wid = __builtin_amdgcn_readfirstlane(tid >> 6), lane = tid & 63, wr = wid >> 2, wc = wid & 3, fr = lane & 15, fq = lane >> 4;
    const int K = g.K, nt = K / BK, lda = g.lda;
    unsigned voffA[2], voffB[2];
#pragma unroll
    for (int i = 0; i < 2; ++i) { int R, C; stage_rc(tid * 16 + i * 8192, R, C); const int Rb = Epi::PERM ? ((R & ~31) + perm32(R & 31)) : R;
        voffA[i] = (unsigned)(R * lda + C) * 2u; voffB[i] = (unsigned)(Rb * K + C) * 2u; }
    const size_t kstep = (size_t)(BK * 2);
    const size_t hstepA = (size_t)HALF * lda * 2, hstepB = (size_t)HALF * K * 2;
    const size_t tstepA = 2 * hstepA, tstepB = 2 * hstepB;
    const unsigned ldsw = (unsigned)wid * 1024u;
    const int aoff = lds_byte(wr * 64 + fr, fq * 8), boff = lds_byte(wc * 32 + fr, fq * 8);
#define PG8_SA(b, h) (((b) * 2 + (h)) * HTB)
#define PG8_SB(b, h) ((4 + (b) * 2 + (h)) * HTB)
#define PG8_STAGE(bufoff, gbase, voff) do { _Pragma("unroll") for (int _i = 0; _i < 2; ++_i) \
        __builtin_amdgcn_global_load_lds((const unsigned*)((const char*)(gbase) + (voff)[_i]), (PG8_LAS unsigned*)(lds + (bufoff) + ldsw + _i * 8192), 16, 0, 0); } while (0)
#define PG8_LDA(dst, b, h) do { _Pragma("unroll") for (int m = 0; m < 4; ++m) _Pragma("unroll") for (int k = 0; k < 2; ++k) dst[m][k] = *(const PG8_LAS bf16x8*)(lds + PG8_SA(b, h) + aoff + m * 2048 + k * 1024); } while (0)
#define PG8_LDB(dst, b, h) do { _Pragma("unroll") for (int n = 0; n < 2; ++n) _Pragma("unroll") for (int k = 0; k < 2; ++k) dst[n][k] = *(const PG8_LAS bf16x8*)(lds + PG8_SB(b, h) + boff + n * 2048 + k * 1024); } while (0)
#define PG8_MMA(ai, bj, At, Bt) do { __builtin_amdgcn_s_setprio(1); _Pragma("unroll") for (int m = 0; m < 4; ++m) _Pragma("unroll") for (int n = 0; n < 2; ++n) _Pragma("unroll") for (int k = 0; k < 2; ++k) \
        acc[ai][bj][m][n] = __builtin_amdgcn_mfma_f32_16x16x32_bf16(Bt[n][k], At[m][k], acc[ai][bj][m][n], 0, 0, 0); __builtin_amdgcn_s_setprio(0); } while (0)
#define PG8_WAIT_V(n) asm volatile("s_waitcnt vmcnt(" #n ")" ::: "memory")
#define PG8_WAIT_L(n) asm volatile("s_waitcnt lgkmcnt(" #n ")" ::: "memory")
#define PG8_BAR __builtin_amdgcn_s_barrier()
#define PG8_SCHED __builtin_amdgcn_sched_barrier(0)
    Unit cur, nxt; int ui = 0;
    if (!S.next(0, cur)) return;
    f32x4 acc[2][2][4][2];
#pragma unroll
    for (int a = 0; a < 2; ++a)
#pragma unroll
        for (int b = 0; b < 2; ++b)
#pragma unroll
            for (int m = 0; m < 4; ++m)
#pragma unroll
                for (int n = 0; n < 2; ++n) acc[a][b][m][n] = (f32x4){0.f, 0.f, 0.f, 0.f};
    bf16x8 At[4][2], B0[2][2], B1[2][2];
    const char* cA = (const char*)g.A + (size_t)cur.pm * tstepA + S.aoff(cur); const char* cB = (const char*)g.Bt + (size_t)cur.pn * tstepB;
    PG8_STAGE(PG8_SB(0, 0), cB, voffB); PG8_STAGE(PG8_SB(0, 1), cB + hstepB, voffB); PG8_STAGE(PG8_SA(0, 0), cA, voffA); PG8_STAGE(PG8_SA(0, 1), cA + hstepA, voffA);
    if (wr == 1) PG8_BAR;
    PG8_WAIT_V(2); PG8_BAR;
    PG8_STAGE(PG8_SB(1, 0), cB + kstep, voffB); PG8_STAGE(PG8_SA(1, 0), cA + kstep, voffA); PG8_STAGE(PG8_SB(1, 1), cB + hstepB + kstep, voffB);
    PG8_WAIT_V(6); PG8_BAR;
    for (;;) {
        const bool has_next = S.next(ui + 1, nxt);
        const char* nA = has_next ? (const char*)g.A + (size_t)nxt.pm * tstepA + S.aoff(nxt) : cA; const char* nB = has_next ? (const char*)g.Bt + (size_t)nxt.pn * tstepB : cB;
        for (int t = 0; t < nt; t += 2) {
            const bool last = (t == nt - 2);
            const char* a1 = cA + (size_t)(t + 1) * kstep;
            const char* a2 = last ? nA : cA + (size_t)(t + 2) * kstep; const char* b2 = last ? nB : cB + (size_t)(t + 2) * kstep;
            const char* a3 = a2 + kstep; const char* b3 = b2 + kstep;
            PG8_LDB(B0, 0, 0); PG8_LDB(B1, 0, 1); PG8_SCHED; PG8_LDA(At, 0, 0); PG8_STAGE(PG8_SA(1, 1), a1 + hstepA, voffA);
            PG8_WAIT_V(8); PG8_WAIT_L(0); PG8_BAR; PG8_MMA(0, 0, At, B0); PG8_MMA(0, 1, At, B1); PG8_BAR; PG8_SCHED;
            PG8_LDA(At, 0, 1); PG8_STAGE(PG8_SB(0, 0), b2, voffB); PG8_STAGE(PG8_SB(0, 1), b2 + hstepB, voffB); PG8_STAGE(PG8_SA(0, 0), a2, voffA);
            PG8_WAIT_V(8); PG8_WAIT_L(0); PG8_BAR; PG8_MMA(1, 0, At, B0); PG8_MMA(1, 1, At, B1); PG8_BAR; PG8_SCHED;
            PG8_LDB(B0, 1, 0); PG8_LDB(B1, 1, 1); PG8_SCHED; PG8_LDA(At, 1, 0); PG8_STAGE(PG8_SA(0, 1), a2 + hstepA, voffA);
            PG8_WAIT_V(8); PG8_WAIT_L(0); PG8_BAR; PG8_MMA(0, 0, At, B0); PG8_MMA(0, 1, At, B1); PG8_BAR; PG8_SCHED;
            PG8_LDA(At, 1, 1); PG8_STAGE(PG8_SB(1, 0), b3, voffB); PG8_STAGE(PG8_SB(1, 1), b3 + hstepB, voffB); PG8_STAGE(PG8_SA(1, 0), a3, voffA);
            PG8_WAIT_V(8); PG8_WAIT_L(0); PG8_BAR; PG8_MMA(1, 0, At, B0); PG8_MMA(1, 1, At, B1); PG8_BAR; PG8_SCHED;
        }
        if constexpr (ALIGN_EPI) { if (wr == 0) PG8_BAR; }
        E(acc, cur, wr, wc, fr, fq);
        if (!has_next) break;
#pragma unroll
        for (int a = 0; a < 2; ++a)
#pragma unroll
            for (int b = 0; b < 2; ++b)
#pragma unroll
                for (int m = 0; m < 4; ++m)
#pragma unroll
                    for (int n = 0; n < 2; ++n) acc[a][b][m][n] = (f32x4){0.f, 0.f, 0.f, 0.f};
        cur = nxt; cA = nA; cB = nB; ++ui;
        if constexpr (ALIGN_EPI) { if (wr == 1) PG8_BAR; }
    }
    PG8_WAIT_V(0);
    if constexpr (!ALIGN_EPI) { if (wr == 0) PG8_BAR; }
    PG8_BAR;
#undef PG8_SA
#undef PG8_SB
#undef PG8_STAGE
#undef PG8_LDA
#undef PG8_LDB
#undef PG8_MMA
#undef PG8_WAIT_V
#undef PG8_WAIT_L
#undef PG8_BAR
#undef PG8_SCHED
}
}
using pg8::Unit; using pg8::HALF; using pg8::BM;

typedef f32x4 Acc[2][2][4][2];

DI int kimg(int key, int dim) { return ((((key >> 5) & 1) * 4 + (dim >> 4)) * 64 + ((dim >> 3) & 1) * 32 + (key & 31)) * 8 + (dim & 7); }
DI int vimg(int dim, int key) { return (((((key >> 5) & 1) * 2 + ((key >> 4) & 1)) * 2 + (dim >> 5)) * 64 + ((key >> 2) & 1) * 32 + (dim & 31)) * 8 + ((key >> 3) & 1) * 4 + (key & 3); }
DI f32x4 ld_bf16x4(const bf16* p) { const u32x2 raw = *(const u32x2*)p; return (f32x4){__uint_as_float(raw.x << 16), __uint_as_float(raw.x & 0xffff0000u), __uint_as_float(raw.y << 16), __uint_as_float(raw.y & 0xffff0000u)}; }
DI void st_bf16x4(bf16* p, f32x4 v) { u32x2 w; w.x = pk2(v[0], v[1]); w.y = pk2(v[2], v[3]); *(u32x2*)p = w; }

DI float head_rs(const Acc& acc, int ai, int m, float pre) {
    float s = 0.f;
#pragma unroll
    for (int bj = 0; bj < 2; ++bj)
#pragma unroll
        for (int n = 0; n < 2; ++n) { const f32x4 x = acc[ai][bj][m][n] * pre; s += (x[0] * x[0] + x[1] * x[1]) + (x[2] * x[2] + x[3] * x[3]); }
    s += __shfl_xor(s, 16); s += __shfl_xor(s, 32);
    return __builtin_amdgcn_rsqf(s * (1.0f / 64.0f) + EPS);
}

struct EpiA {
    static constexpr bool PERM = false;
    bf16* vglu; bf16* qm; const float* b_glu; const float* qg; const float* ss0;
    DI void operator()(const Acc& acc, const Unit& u, int wr, int wc, int fr, int fq) const {
        const int row0 = u.pm * BM + wr * 64 + fr;
        if (u.pn < 6) {
#pragma unroll
            for (int n = 0; n < 2; ++n) {
                const int ch0 = 128 * u.pn + 32 * wc + 16 * n + 4 * fq;
                const f32x4 ba = *(const f32x4*)(b_glu + ch0), bg = *(const f32x4*)(b_glu + 768 + ch0);
#pragma unroll
                for (int ai = 0; ai < 2; ++ai)
#pragma unroll
                    for (int m = 0; m < 4; ++m) {
                        const float rs = __builtin_amdgcn_rsqf(ss0[row0 + ai * HALF + m * 16] * (1.0f / D) + EPS);
                        const f32x4 a = acc[ai][0][m][n] * rs + ba, gt = acc[ai][1][m][n] * rs + bg; f32x4 v;
#pragma unroll
                        for (int e = 0; e < 4; ++e) v[e] = a[e] * sigmoidf_(gt[e]);
                        st_bf16x4(vglu + (size_t)(row0 + ai * HALF + m * 16) * 768 + ch0, v);
                    }
            }
        } else {
#pragma unroll
            for (int ai = 0; ai < 2; ++ai)
#pragma unroll
                for (int m = 0; m < 4; ++m) {
                    const float rs = __builtin_amdgcn_rsqf(ss0[row0 + ai * HALF + m * 16] * (1.0f / D) + EPS);
                    const float r = head_rs(acc, ai, m, rs) * rs * QSCALE;
#pragma unroll
                    for (int bj = 0; bj < 2; ++bj)
#pragma unroll
                        for (int n = 0; n < 2; ++n) { const int d0 = 32 * bj + 16 * n + 4 * fq; const f32x4 g4 = *(const f32x4*)(qg + d0);
                            st_bf16x4(qm + (size_t)(row0 + ai * HALF + m * 16) * 256 + wc * 64 + d0, acc[ai][bj][m][n] * r * g4); }
                }
        }
    }
};
struct EpiMem {
    static constexpr bool PERM = false;
    bf16* mk; bf16* mvT; const float* kg;
    DI void operator()(const Acc& acc, const Unit& u, int wr, int wc, int fr, int fq) const {
        const int l = u.pn >> 1, kv = u.pn & 1, row0 = wr * 64 + fr;
#pragma unroll
        for (int ai = 0; ai < 2; ++ai)
#pragma unroll
            for (int m = 0; m < 4; ++m) {
                const int row = row0 + ai * HALF + m * 16;
                if (kv == 0) {
                    const float r = head_rs(acc, ai, m, 1.0f);
#pragma unroll
                    for (int bj = 0; bj < 2; ++bj)
#pragma unroll
                        for (int n = 0; n < 2; ++n) { const int d0 = 32 * bj + 16 * n + 4 * fq; const f32x4 g4 = *(const f32x4*)(kg + l * 64 + d0);
                            st_bf16x4(mk + ((size_t)((l * 4 + wc) * 4 + (row >> 6))) * 4096 + ((row >> 5) & 1) * 2048 + (row & 31) * 8 + (2 * bj + n) * 512 + (fq >> 1) * 256 + 4 * (fq & 1), acc[ai][bj][m][n] * r * g4); }
                } else {
#pragma unroll
                    for (int bj = 0; bj < 2; ++bj)
#pragma unroll
                        for (int n = 0; n < 2; ++n) { const int d0 = 32 * bj + 16 * n + 4 * fq; const f32x4 v = acc[ai][bj][m][n];
#pragma unroll
                            for (int e = 0; e < 4; ++e) mvT[((size_t)((l * 4 + wc) * 4 + (row >> 6))) * 4096 + vimg(0, row & 63) + bj * 512 + (16 * n + 4 * fq + e) * 8] = (bf16)(pk2(v[e], 0.f) & 0xffffu); }
                }
            }
    }
};
struct EpiRes {
    static constexpr bool PERM = false;
    const float* bf; const bf16* bb; float* out; bf16* xb; float* ss; int last;
    DI void operator()(const Acc& acc, const Unit& u, int wr, int wc, int fr, int fq) const {
        const int row0 = u.pm * BM + wr * 64 + fr, col0 = u.pn * BM + wc * 32 + 4 * fq;
#pragma unroll
        for (int ai = 0; ai < 2; ++ai)
#pragma unroll
            for (int m = 0; m < 4; ++m) {
                const int row = row0 + ai * HALF + m * 16; const size_t p = (size_t)row * D + col0; float s = 0.f;
#pragma unroll
                for (int bj = 0; bj < 2; ++bj)
#pragma unroll
                    for (int n = 0; n < 2; ++n) { const size_t off = p + bj * HALF + n * 16; const f32x4 v = (bf ? *(const f32x4*)(bf + off) : ld_bf16x4(bb + off)) + acc[ai][bj][m][n];
                        if (out) __builtin_nontemporal_store(v, (f32x4*)(out + off));
                        if (!last) { st_bf16x4(xb + off, v); s += (v[0] * v[0] + v[1] * v[1]) + (v[2] * v[2] + v[3] * v[3]); } }
                if (!last) { s += __shfl_xor(s, 16); s += __shfl_xor(s, 32); if (fq == 0) unsafeAtomicAdd(ss + row, s); }
            }
    }
};
struct EpiMlpIn {
    static constexpr bool PERM = true;
    bf16* hb; const float* ss;
    DI void operator()(const Acc& acc, const Unit& u, int wr, int wc, int fr, int fq) const {
        const int row0 = u.pm * BM + wr * 64 + fr, col0 = u.pn * BM + wc * 32 + 8 * fq;
#pragma unroll
        for (int ai = 0; ai < 2; ++ai)
#pragma unroll
            for (int m = 0; m < 4; ++m) {
                const int row = row0 + ai * HALF + m * 16; const float rs = __builtin_amdgcn_rsqf(ss[row] * (1.0f / D) + EPS);
#pragma unroll
                for (int bj = 0; bj < 2; ++bj) { f32x4 v0 = acc[ai][bj][m][0] * rs, v1 = acc[ai][bj][m][1] * rs;
#pragma unroll
                    for (int e = 0; e < 4; ++e) { const float a = fmaxf(v0[e], 0.f), b = fmaxf(v1[e], 0.f); v0[e] = a * a; v1[e] = b * b; }
                    u32x4 w; w.x = pk2(v0[0], v0[1]); w.y = pk2(v0[2], v0[3]); w.z = pk2(v1[0], v1[1]); w.w = pk2(v1[2], v1[3]);
                    *(u32x4*)(hb + (size_t)row * FF + col0 + bj * HALF) = w; }
            }
    }
};
struct EpiB {
    static constexpr bool PERM = false;
    const float* ss; bf16* cbuf; bf16* ksel; bf16* vTsel; bf16* kwin; bf16* vTwin; bf16* q; bf16* qm; float* gates;
    const float* kng; const float* qng; const float* mqg; const float* gate_b;
    DI void operator()(const Acc& acc, const Unit& u, int wr, int wc, int fr, int fq) const {
        const int row0 = u.pm * BM + wr * 64 + fr; const int pn = u.pn;
#pragma unroll
        for (int ai = 0; ai < 2; ++ai)
#pragma unroll
            for (int m = 0; m < 4; ++m) {
                const int row = row0 + ai * HALF + m * 16; const float rs = __builtin_amdgcn_rsqf(ss[row] * (1.0f / D) + EPS);
                if (pn == 0) {
#pragma unroll
                    for (int bj = 0; bj < 2; ++bj)
#pragma unroll
                        for (int n = 0; n < 2; ++n) { const int d0 = 32 * bj + 16 * n + 4 * fq; st_bf16x4(cbuf + ((size_t)wc * S + row) * 64 + d0, acc[ai][bj][m][n] * rs); }
                } else if (pn <= 2) {
                    bf16* kd = pn == 1 ? ksel : kwin; bf16* vd = pn == 1 ? vTsel : vTwin; const float* g = kng + pn * 64;
                    if (wc < 2) {
                        const float r = head_rs(acc, ai, m, rs) * rs;
#pragma unroll
                        for (int bj = 0; bj < 2; ++bj)
#pragma unroll
                            for (int n = 0; n < 2; ++n) { const int d0 = 32 * bj + 16 * n + 4 * fq; const f32x4 g4 = *(const f32x4*)(g + d0);
                                st_bf16x4(kd + ((size_t)wc * (S / 64) + (row >> 6)) * 4096 + ((row >> 5) & 1) * 2048 + (row & 31) * 8 + (2 * bj + n) * 512 + (fq >> 1) * 256 + 4 * (fq & 1), acc[ai][bj][m][n] * r * g4); }
                    } else {
#pragma unroll
                        for (int bj = 0; bj < 2; ++bj)
#pragma unroll
                            for (int n = 0; n < 2; ++n) { const int d0 = 32 * bj + 16 * n + 4 * fq; const f32x4 v = acc[ai][bj][m][n] * rs;
#pragma unroll
                                for (int e = 0; e < 4; ++e) vd[((size_t)(wc - 2) * (S / 64) + (row >> 6)) * 4096 + vimg(0, row & 63) + bj * 512 + (16 * n + 4 * fq + e) * 8] = (bf16)(pk2(v[e], 0.f) & 0xffffu); }
                    }
                } else if (pn <= 6) {
                    const float r = head_rs(acc, ai, m, rs) * rs * QSCALE; const float* g = pn == 6 ? mqg : qng;
                    bf16* dst = pn == 6 ? qm + (size_t)row * 256 + wc * 64 : q + (size_t)row * 768 + ((pn - 3) * 4 + wc) * 64;
#pragma unroll
                    for (int bj = 0; bj < 2; ++bj)
#pragma unroll
                        for (int n = 0; n < 2; ++n) { const int d0 = 32 * bj + 16 * n + 4 * fq; const f32x4 g4 = *(const f32x4*)(g + d0);
                            st_bf16x4(dst + d0, acc[ai][bj][m][n] * r * g4); }
                } else {
                    if (wc < 2) {
#pragma unroll
                        for (int n = 0; n < 2; ++n) { const int p0 = 32 * wc + 16 * n + 4 * fq;
                            if (p0 < 36) { const f32x4 v = acc[ai][0][m][n] * rs;
#pragma unroll
                                for (int e = 0; e < 4; ++e) gates[(size_t)row * 36 + p0 + e] = sigmoidf_(v[e] + gate_b[p0 + e]); } }
                    }
                }
            }
    }
};
struct EpiC {
    static constexpr bool PERM = false;
    float* part;
    DI void operator()(const Acc& acc, const Unit& u, int wr, int wc, int fr, int fq) const {
        const int row0 = u.pm * BM + wr * 64 + fr, col0 = wc * 32 + 4 * fq; float* pb = part + (size_t)(u.pn & 3) * 4096 * 256;
#pragma unroll
        for (int ai = 0; ai < 2; ++ai)
#pragma unroll
            for (int m = 0; m < 4; ++m) { float* rowp = pb + (size_t)(row0 + ai * HALF + m * 16) * 256 + col0;
#pragma unroll
                for (int bj = 0; bj < 2; ++bj)
#pragma unroll
                    for (int n = 0; n < 2; ++n) *(f32x4*)(rowp + bj * HALF + n * 16) = acc[ai][bj][m][n]; }
    }
};

constexpr size_t MiB = 1u << 20;
constexpr size_t WS_SS = 0;
constexpr size_t WS_BPART = 256 * 1024;
constexpr size_t WS_BIAS1 = 400 * 1024;
constexpr size_t WS_MK = 512 * 1024;
constexpr size_t WS_MVT = 768 * 1024;
constexpr size_t WS_KCMP = 1 * MiB;
constexpr size_t WS_VTCMP = 1 * MiB + 256 * 1024;
constexpr size_t WS_MEMB = 1 * MiB + 512 * 1024;
constexpr size_t WS_W = 8 * MiB;
constexpr size_t WS_WA = WS_W;
constexpr size_t WS_WO = WS_WA + 1792 * 1024 * 2;
constexpr size_t WS_W1 = WS_WO + 2 * 1024 * 1024 * 2;
constexpr size_t WS_W2 = WS_W1 + 2 * 4096 * 1024 * 2;
constexpr size_t WS_WB = WS_W2 + 2 * 4096 * 1024 * 2;
constexpr size_t WS_WM = WS_WB + 2048 * 1024 * 2;
constexpr size_t WS_W1C = WS_WM + 1024 * 1024 * 2;
constexpr size_t WS_W2C = WS_W1C + 512 * 2048 * 2;
constexpr size_t WS_WEND = WS_W2C + 2 * 64 * 256 * 2;
constexpr size_t WS_XB = 58 * MiB;
constexpr size_t WS_MIX = 90 * MiB;
constexpr size_t WS_HB = 122 * MiB;
constexpr size_t WS_END = 250 * MiB;
static_assert(WS_WEND <= WS_XB, "weights fit");
constexpr size_t WS_VGLU = WS_HB;
constexpr size_t WS_QM0 = WS_HB + 24 * MiB;
constexpr size_t WS_CBUF = WS_HB;
constexpr size_t WS_KSEL = WS_HB + 10 * MiB;
constexpr size_t WS_VTSEL = WS_HB + 14 * MiB;
constexpr size_t WS_KWIN = WS_HB + 18 * MiB;
constexpr size_t WS_VTWIN = WS_HB + 22 * MiB;
constexpr size_t WS_Q = WS_HB + 26 * MiB;
constexpr size_t WS_QM1 = WS_HB + 50 * MiB;
constexpr size_t WS_GATES = WS_HB + 58 * MiB;
constexpr size_t WS_IMP = WS_HB + 64 * MiB;
constexpr size_t WS_PART = WS_IMP;
constexpr size_t WS_OC = WS_HB + 96 * MiB;
constexpr size_t WS_CNT = 448 * 1024;

constexpr int LDS_BYTES = 147456;
constexpr int NWAVES = 8;

struct Params { const float* in[29]; float* out; unsigned char* ws; int ph_lo, ph_hi; };
enum { I_X = 0, I_MEM, I_NMIX, I_NMLP, I_MEMN, I_WMEMKV, I_MQG, I_MKG, I_WOUT, I_WMLPIN, I_WMLPOUT, I_AWIN, I_ABGLU, I_ADW, I_ADWB, I_ALNG, I_ALNB,
       I_BWIN, I_BGATEB, I_BQG, I_KVNG, I_WKV, I_KNG, I_PEK, I_PEV, I_W1K, I_W2K, I_W1V, I_W2V };

DI int hp(int p) { return 64 * ((p >> 5) & 3) + 32 * (p >> 7) + (p & 31); }
DI void tr_item(const float* __restrict__ W, int ldw, int src_col0, int nvalid, const float* __restrict__ gain, bf16* WT, int K, int dst_row0, int k0, LAS float* scr, int lane) {
    const int cc = lane & 31; const bool ok = cc < nvalid;
    const float* wp = W + (size_t)(k0 + (lane >> 5)) * ldw + src_col0 + (ok ? cc : 0);
    float v[32];
#pragma unroll
    for (int i = 0; i < 32; ++i) v[i] = __builtin_nontemporal_load(wp + (size_t)(2 * i) * ldw);
    const int c = lane & 7;
    f32x4 g0 = {1.f, 1.f, 1.f, 1.f}, g1 = {1.f, 1.f, 1.f, 1.f};
    if (gain) { g0 = *(const f32x4*)(gain + k0 + 8 * c); g1 = *(const f32x4*)(gain + k0 + 8 * c + 4); }
#pragma unroll
    for (int i = 0; i < 32; ++i) scr[(2 * i + (lane >> 5)) * 33 + cc] = ok ? v[i] : 0.f;
    LDS_WAIT();
#pragma unroll
    for (int j = 0; j < 4; ++j) { const int n = (lane >> 3) + 8 * j; const LAS float* s = scr + (8 * c) * 33 + n;
        u32x4 o; o.x = pk2(s[0 * 33] * g0[0], s[1 * 33] * g0[1]); o.y = pk2(s[2 * 33] * g0[2], s[3 * 33] * g0[3]); o.z = pk2(s[4 * 33] * g1[0], s[5 * 33] * g1[1]); o.w = pk2(s[6 * 33] * g1[2], s[7 * 33] * g1[3]);
        *(u32x4*)(WT + (size_t)(dst_row0 + n) * K + k0 + 8 * c) = o; }
    LDS_WAIT();
}
DI void rms_rows2_to_bf16(const float* xrow, bf16* orow, float* ssq, int lane) {
    const f32x4* xr = (const f32x4*)xrow + lane; f32x4 v[8]; float s0 = 0.f, s1 = 0.f;
#pragma unroll
    for (int j = 0; j < 8; ++j) v[j] = __builtin_nontemporal_load(xr + 64 * j);
#pragma unroll
    for (int j = 0; j < 4; ++j) { s0 += (v[j][0] * v[j][0] + v[j][1] * v[j][1]) + (v[j][2] * v[j][2] + v[j][3] * v[j][3]);
                                  s1 += (v[4 + j][0] * v[4 + j][0] + v[4 + j][1] * v[4 + j][1]) + (v[4 + j][2] * v[4 + j][2] + v[4 + j][3] * v[4 + j][3]); }
    s0 = wave_sum(s0); s1 = wave_sum(s1);
    float r0 = __builtin_amdgcn_rsqf(s0 * (1.0f / D) + EPS), r1 = __builtin_amdgcn_rsqf(s1 * (1.0f / D) + EPS);
    if (ssq) { if (lane == 0) { ssq[0] = s0; ssq[1] = s1; } r0 = 1.0f; r1 = 1.0f; }
    u32x2* o8 = (u32x2*)orow + lane;
#pragma unroll
    for (int j = 0; j < 8; ++j) { const float r = j < 4 ? r0 : r1; u32x2 w; w.x = pk2(v[j][0] * r, v[j][1] * r); w.y = pk2(v[j][2] * r, v[j][3] * r); o8[64 * j] = w; }
}
DI void p0_prologue(const Params& P, LAS unsigned char* lds, int gw, int NGW, int wave, int lane) {
    unsigned char* ws = P.ws;
    LAS float* scr = (LAS float*)(lds + wave * 16384);
    constexpr int NM = 11;
    const int rows[NM] = {1792, 1024, 1024, 4096, 4096, 1024, 1024, 2048, 1024, 512, 128};
    const int Ks[NM]   = {1024, 1024, 1024, 1024, 1024, 4096, 4096, 1024, 1024, 2048, 256};
    int total = 0;
#pragma unroll
    for (int m = 0; m < NM; ++m) total += (rows[m] / 32) * (Ks[m] / 64);
    for (int it = gw; it < total; it += NGW) {
        int r = it, m = 0;
#pragma unroll
        for (int mm = 0; mm < NM; ++mm) { const int cnt = (rows[mm] / 32) * (Ks[mm] / 64); if (m == mm && r >= cnt) { r -= cnt; m = mm + 1; } }
        int K = 1024, nkb = 16;
        if (m == 5 || m == 6) { K = 4096; nkb = 64; } else if (m == 9) { K = 2048; nkb = 32; } else if (m == 10) { K = 256; nkb = 4; }
        const int nb = r / nkb, kb = r % nkb, R0 = nb * 32, k0 = kb * 64;
        const float* W; int ldw, col, nvalid = 32; const float* gain = nullptr; bf16* WT;
        if (m == 0) { W = P.in[I_AWIN]; ldw = 1792; gain = P.in[I_NMIX]; WT = (bf16*)(ws + WS_WA);
            const int j = R0 >> 8, p = R0 & 255; col = j < 6 ? (p < 128 ? 128 * j + p : 768 + 128 * j + p - 128) : 1536 + hp(p); }
        else if (m <= 2) { W = P.in[I_WOUT] + (size_t)(m - 1) * D * D; ldw = D; col = R0; WT = (bf16*)(ws + WS_WO) + (size_t)(m - 1) * D * D; }
        else if (m <= 4) { W = P.in[I_WMLPIN] + (size_t)(m - 3) * D * FF; ldw = FF; col = R0; gain = P.in[I_NMLP] + (m - 3) * D; WT = (bf16*)(ws + WS_W1) + (size_t)(m - 3) * D * FF; }
        else if (m <= 6) { W = P.in[I_WMLPOUT] + (size_t)(m - 5) * D * FF; ldw = D; col = R0; WT = (bf16*)(ws + WS_W2) + (size_t)(m - 5) * D * FF; }
        else if (m == 7) { WT = (bf16*)(ws + WS_WB);
            if (R0 < 768) { W = P.in[I_WKV]; ldw = 768; col = (R0 & ~255) + hp(R0 & 255); gain = P.in[I_KVNG]; }
            else { const int uc = R0 - 768, uj = uc >> 8, p = uc & 255; W = P.in[I_BWIN]; ldw = 1060; gain = P.in[I_NMIX] + D; col = uj < 4 ? uj * 256 + hp(p) : 1024 + p;
                   nvalid = 1060 - col; nvalid = nvalid < 0 ? 0 : (nvalid > 32 ? 32 : nvalid); if (nvalid == 0) col = 0; } }
        else if (m == 8) { const int un = R0 >> 8, p = R0 & 255; W = P.in[I_WMEMKV] + (size_t)(un >> 1) * D * 512; ldw = 512; col = (un & 1) * 256 + hp(p); gain = P.in[I_MEMN]; WT = (bf16*)(ws + WS_WM); }
        else if (m == 9) { W = (R0 >> 8) ? P.in[I_W1V] : P.in[I_W1K]; ldw = 256; col = R0 & 255; WT = (bf16*)(ws + WS_W1C) + (size_t)((R0 >> 8) * 4 + (k0 >> 9)) * 256 * 512; }
        else { W = (R0 >> 6) ? P.in[I_W2V] : P.in[I_W2K]; ldw = 64; col = R0 & 63; WT = (bf16*)(ws + WS_W2C); }
        if (m == 9) tr_item(W + (size_t)(k0 & ~511) * ldw, ldw, col, nvalid, gain, WT, 512, R0 & 255, k0 & 511, scr, lane);
        else tr_item(W, ldw, col, nvalid, gain, WT, K, R0, k0, scr, lane);
    }
    for (int r2 = gw; r2 < (S + MEML) / 2; r2 += NGW) { const int r = 2 * r2;
        if (r < S) rms_rows2_to_bf16(P.in[I_X] + (size_t)r * D, (bf16*)(ws + WS_XB) + (size_t)r * D, (float*)(ws + WS_SS) + 3 * S + r, lane);
        else rms_rows2_to_bf16(P.in[I_MEM] + (size_t)(r - S) * D, (bf16*)(ws + WS_MEMB) + (size_t)(r - S) * D, nullptr, lane);
    }
    const int gt = gw * 64 + lane, NGT = NGW * 64;
    for (int i = gt; i < 3 * S; i += NGT) ((float*)(ws + WS_SS))[i] = 0.f;
    for (int i = gt; i < 2 * 64 * 256; i += NGT) { const int type = i >> 14, kc = (i >> 8) & 63, c = i & 255;
        const float* pe = P.in[type ? I_PEV : I_PEK] + kc * 32; const float* w1 = P.in[type ? I_W1V : I_W1K] + (size_t)kc * 32 * 256 + c; float s = 0.f;
#pragma unroll 8
        for (int k = 0; k < 32; ++k) s += pe[k] * w1[(size_t)k * 256];
        ((float*)(ws + WS_BPART))[i] = s; }
}

DI f32x16 mfma32(bf16x8 a, bf16x8 b, f32x16 c) { return __builtin_amdgcn_mfma_f32_32x32x16_bf16(a, b, c, 0, 0, 0); }
DI f32x4 mfma16(bf16x8 a, bf16x8 b, f32x4 c) { return __builtin_amdgcn_mfma_f32_16x16x32_bf16(a, b, c, 0, 0, 0); }
DI float gain_max(const float* g, int lane) { return wave_max(fabsf(g[lane])); }
DI void conv_task(const Params& P, int t0, int lane) {
    const bf16* vg = (const bf16*)(P.ws + WS_VGLU); const float* dw = P.in[I_ADW]; bf16* mix = (bf16*)(P.ws + WS_MIX);
    f32x4 acc[4][3];
#pragma unroll
    for (int i = 0; i < 3; ++i) { const f32x4 b = *(const f32x4*)(P.in[I_ADWB] + 4 * lane + 256 * i);
#pragma unroll
        for (int tt = 0; tt < 4; ++tt) acc[tt][i] = b; }
    f32x4 vr[4][3];
#define CONV_LDROW(dst, rr) do { _Pragma("unroll") for (int i = 0; i < 3; ++i) { u32x2 raw = *(const u32x2*)(vg + (size_t)((rr) >= 0 ? (rr) : 0) * 768 + 4 * lane + 256 * i); if ((rr) < 0) { raw.x = 0u; raw.y = 0u; } \
        dst[i] = (f32x4){__uint_as_float(raw.x << 16), __uint_as_float(raw.x & 0xffff0000u), __uint_as_float(raw.y << 16), __uint_as_float(raw.y & 0xffff0000u)}; } } while (0)
    CONV_LDROW(vr[0], t0 - 30); CONV_LDROW(vr[1], t0 - 29); CONV_LDROW(vr[2], t0 - 28);
#pragma unroll 8
    for (int j = 0; j < 31; ++j) {
        CONV_LDROW(vr[3], t0 - 27 + j);
        f32x4 w[3];
#pragma unroll
        for (int i = 0; i < 3; ++i) w[i] = *(const f32x4*)(dw + (size_t)j * 768 + 4 * lane + 256 * i);
#pragma unroll
        for (int tt = 0; tt < 4; ++tt)
#pragma unroll
            for (int i = 0; i < 3; ++i) acc[tt][i] += vr[tt][i] * w[i];
#pragma unroll
        for (int i = 0; i < 3; ++i) { vr[0][i] = vr[1][i]; vr[1][i] = vr[2][i]; vr[2][i] = vr[3][i]; }
    }
#undef CONV_LDROW
    f32x4 lg[3], lb[3];
#pragma unroll
    for (int i = 0; i < 3; ++i) { lg[i] = *(const f32x4*)(P.in[I_ALNG] + 4 * lane + 256 * i); lb[i] = *(const f32x4*)(P.in[I_ALNB] + 4 * lane + 256 * i); }
#pragma unroll
    for (int tt = 0; tt < 4; ++tt) {
        float s = 0.f;
#pragma unroll
        for (int i = 0; i < 3; ++i) s += (acc[tt][i][0] + acc[tt][i][1]) + (acc[tt][i][2] + acc[tt][i][3]);
        const float mean = wave_sum(s) * (1.0f / 768.0f); float q = 0.f;
#pragma unroll
        for (int i = 0; i < 3; ++i) { const f32x4 d = acc[tt][i] - mean; q += (d[0] * d[0] + d[1] * d[1]) + (d[2] * d[2] + d[3] * d[3]); }
        const float rstd = __builtin_amdgcn_rsqf(wave_sum(q) * (1.0f / 768.0f) + 1e-5f);
#pragma unroll
        for (int i = 0; i < 3; ++i) { f32x4 y = (acc[tt][i] - mean) * rstd * lg[i] + lb[i];
#pragma unroll
            for (int e = 0; e < 4; ++e) y[e] = y[e] * sigmoidf_(y[e]);
            st_bf16x4(mix + (size_t)(t0 + tt) * D + 4 * lane + 256 * i, y); }
    }
}

DI void cmp2_task(const Params& P, int task, int lane) {
    const int r = lane & 31, h = lane >> 5; const int row0 = task * 32; const int type = row0 >> 11, g = (row0 >> 10) & 1, n0 = row0 & 1023;
    const float* part = (const float*)(P.ws + WS_PART) + (size_t)(row0 + r) * 256 + 8 * h; const float* bb = (const float*)(P.ws + WS_BIAS1) + type * 256 + 8 * h;
    const bf16* w2 = (const bf16*)(P.ws + WS_W2C) + (size_t)type * 64 * 256;
    f32x16 O0, O1;
#pragma unroll
    for (int i = 0; i < 16; ++i) { O0[i] = 0.f; O1[i] = 0.f; }
#pragma unroll 4
    for (int s = 0; s < 16; ++s) {
        f32x4 a0 = *(const f32x4*)(bb + 16 * s), a1 = *(const f32x4*)(bb + 16 * s + 4);
#pragma unroll
        for (int kc = 0; kc < 4; ++kc) { a0 += *(const f32x4*)(part + (size_t)kc * 4096 * 256 + 16 * s); a1 += *(const f32x4*)(part + (size_t)kc * 4096 * 256 + 16 * s + 4); }
#pragma unroll
        for (int e = 0; e < 4; ++e) { float x = a0[e]; a0[e] = x * sigmoidf_(1.5957691216f * (x + 0.044715f * x * x * x)); x = a1[e]; a1[e] = x * sigmoidf_(1.5957691216f * (x + 0.044715f * x * x * x)); }
        u32x4 hw; hw.x = pk2(a0[0], a0[1]); hw.y = pk2(a0[2], a0[3]); hw.z = pk2(a1[0], a1[1]); hw.w = pk2(a1[2], a1[3]);
        const bf16x8 hb = __builtin_bit_cast(bf16x8, hw);
        O0 = mfma32(*(const bf16x8*)(w2 + (size_t)r * 256 + 16 * s + 8 * h), hb, O0);
        O1 = mfma32(*(const bf16x8*)(w2 + (size_t)(32 + r) * 256 + 16 * s + 8 * h), hb, O1);
    }
    if (type == 0) {
        float s = 0.f;
#pragma unroll
        for (int i = 0; i < 16; ++i) s += O0[i] * O0[i] + O1[i] * O1[i];
        s += __shfl_xor(s, 32);
        const float rs = __builtin_amdgcn_rsqf(s * (1.0f / 64.0f) + EPS);
        const int nk = n0 + r; bf16* kp = (bf16*)(P.ws + WS_KCMP) + ((size_t)g * 16 + (nk >> 6)) * 4096; const float* kg = P.in[I_KNG] + 4 * h;
#pragma unroll
        for (int q4 = 0; q4 < 4; ++q4) {
            const f32x4 g0 = *(const f32x4*)(kg + 8 * q4), g1 = *(const f32x4*)(kg + 32 + 8 * q4);
            st_bf16x4(kp + kimg(nk & 63, 4 * h + 8 * q4), (f32x4){O0[4 * q4], O0[4 * q4 + 1], O0[4 * q4 + 2], O0[4 * q4 + 3]} * rs * g0);
            st_bf16x4(kp + kimg(nk & 63, 32 + 4 * h + 8 * q4), (f32x4){O1[4 * q4], O1[4 * q4 + 1], O1[4 * q4 + 2], O1[4 * q4 + 3]} * rs * g1);
        }
    } else {
        const int nn = n0 + r; bf16* vp = (bf16*)(P.ws + WS_VTCMP) + ((size_t)g * 16 + (nn >> 6)) * 4096;
#pragma unroll
        for (int i = 0; i < 16; ++i) { const int c = (i & 3) + 8 * (i >> 2) + 4 * h;
            vp[vimg(c, nn & 63)] = (bf16)(pk2(O0[i], 0.f) & 0xffffu); vp[vimg(c + 32, nn & 63)] = (bf16)(pk2(O1[i], 0.f) & 0xffffu); }
    }
}

struct KV32 { bf16x8 k[4]; s16x4 v[8]; };
DI void kv32_load(KV32& d, const bf16* Kb, const bf16* VT, int key0, int r, int h) {
    const int ln = h * 32 + r; const size_t blk = (size_t)(key0 >> 6) * 4096; const int sub = (key0 >> 5) & 1;
    const bf16* kp = Kb + blk + sub * 2048 + ln * 8;
#pragma unroll
    for (int s = 0; s < 4; ++s) d.k[s] = *(const bf16x8*)(kp + s * 512);
    const bf16* vp = VT + blk + sub * 2048 + ln * 8;
#pragma unroll
    for (int i = 0; i < 4; ++i) { const bf16x8 w = *(const bf16x8*)(vp + i * 512); d.v[2 * i] = __builtin_shufflevector(w, w, 0, 1, 2, 3); d.v[2 * i + 1] = __builtin_shufflevector(w, w, 4, 5, 6, 7); }
}
DI float opaque_zero() { float z; asm volatile("v_mov_b32 %0, 0" : "=v"(z)); return z; }
DI f32x16 tile_qk(const KV32& d, const bf16x8 (&qf)[4], float c0) {
    f32x16 sc; const float c = c0 + opaque_zero();
#pragma unroll
    for (int i = 0; i < 16; ++i) sc[i] = c;
#pragma unroll
    for (int s = 0; s < 4; ++s) sc = mfma32(d.k[s], qf[s], sc);
    return sc;
}
DI void tile_pv(const KV32& d, const float (&p)[16], f32x16& O0, f32x16& O1) {
#pragma unroll
    for (int s2 = 0; s2 < 2; ++s2) {
        u32x4 pw; pw.x = pk2(p[8 * s2], p[8 * s2 + 1]); pw.y = pk2(p[8 * s2 + 2], p[8 * s2 + 3]); pw.z = pk2(p[8 * s2 + 4], p[8 * s2 + 5]); pw.w = pk2(p[8 * s2 + 6], p[8 * s2 + 7]);
        const bf16x8 pb = __builtin_bit_cast(bf16x8, pw);
        O0 = mfma32(__builtin_shufflevector(d.v[(s2 * 2) * 2], d.v[(s2 * 2) * 2 + 1], 0, 1, 2, 3, 4, 5, 6, 7), pb, O0);
        O1 = mfma32(__builtin_shufflevector(d.v[(s2 * 2 + 1) * 2], d.v[(s2 * 2 + 1) * 2 + 1], 0, 1, 2, 3, 4, 5, 6, 7), pb, O1);
    }
}
DI void tile_store(bf16* op, const f32x16& O0, const f32x16& O1, float sc) {
#pragma unroll
    for (int q4 = 0; q4 < 4; ++q4) {
        st_bf16x4(op + 8 * q4, (f32x4){O0[4 * q4], O0[4 * q4 + 1], O0[4 * q4 + 2], O0[4 * q4 + 3]} * sc);
        st_bf16x4(op + 32 + 8 * q4, (f32x4){O1[4 * q4], O1[4 * q4 + 1], O1[4 * q4 + 2], O1[4 * q4 + 3]} * sc);
    }
}
DI void mem_attn_task(const bf16* Qm, const bf16* mk, const bf16* mvT, bf16* mix, int t0, int head, float Bq, int lane) {
    const int r = lane & 31, h = lane >> 5;
    bf16x8 qf[4];
#pragma unroll
    for (int s = 0; s < 4; ++s) qf[s] = *(const bf16x8*)(Qm + (size_t)(t0 + r) * 256 + head * 64 + 16 * s + 8 * h);
    const bf16* Kb = mk + (size_t)head * 4 * 4096; const bf16* Vb = mvT + (size_t)head * 4 * 4096;
    f32x16 O0, O1; float l = 0.f;
#pragma unroll
    for (int i = 0; i < 16; ++i) { O0[i] = 0.f; O1[i] = 0.f; }
    KV32 A, B, C;
#define MA_STEP(BUF, st) do { if ((st) < nst) { const f32x16 sc = tile_qk(BUF, qf, -Bq); float p[16]; \
        _Pragma("unroll") for (int i = 0; i < 16; ++i) { p[i] = __builtin_amdgcn_exp2f(sc[i]); l += p[i]; } \
        tile_pv(BUF, p, O0, O1); } { const int _s = (st) + 3 < nst ? (st) + 3 : nst - 1; kv32_load(BUF, Kb, Vb, 32 * _s, r, h); } } while (0)
    const int nst = 8;
    kv32_load(A, Kb, Vb, 0, r, h); kv32_load(B, Kb, Vb, 32, r, h); kv32_load(C, Kb, Vb, 64, r, h);
#pragma unroll 1
    for (int st = 0; st < nst; st += 3) { MA_STEP(A, st); MA_STEP(B, st + 1); MA_STEP(C, st + 2); }
#undef MA_STEP
    l += __shfl_xor(l, 32);
    tile_store(mix + (size_t)(t0 + r) * D + 768 + head * 64 + 4 * h, O0, O1, 1.0f / l);
}
DI void mem_attn_phase(const Params& P, int layer, const bf16* Qm, int gw, int NGW, int lane) {
    if (gw < 0) return;
    const bf16* mk = (const bf16*)(P.ws + WS_MK) + (size_t)layer * 4 * 256 * 64; const bf16* mvT = (const bf16*)(P.ws + WS_MVT) + (size_t)layer * 4 * 64 * 256;
    const float Bq = BNDC * gain_max(P.in[I_MQG] + layer * 64, lane) * gain_max(P.in[I_MKG] + layer * 64, lane) * 1.02f;
    for (int task = gw; task < (S / 32) * 4; task += NGW) mem_attn_task(Qm, mk, mvT, (bf16*)(P.ws + WS_MIX), (task >> 2) * 32, task & 3, Bq, lane);
}

DI void cmp_tile_task(const Params& P, int qt, int g, float Bc, LAS float* wl, LAS bf16x8* qL, int lane) {
    unsigned char* ws = P.ws;
    const int r = lane & 31, h = lane >> 5, t = 32 * qt + r;
    const int nv = t >= 31 ? ((t - 31) >> 4) + 1 : 0;
    const int tl = 32 * qt + 31, nvmax = tl >= 31 ? ((tl - 31) >> 4) + 1 : 0, nsteps = (nvmax + 31) >> 5;
    const int tf = 32 * qt, nvmin = tf >= 31 ? ((tf - 31) >> 4) + 1 : 0;
    const bf16* Kc = (const bf16*)(ws + WS_KCMP) + (size_t)g * 1024 * 64; const bf16* Vc = (const bf16*)(ws + WS_VTCMP) + (size_t)g * 64 * 1024;
    const bf16* qrow = (const bf16*)(ws + WS_Q) + (size_t)t * 768 + g * 384 + 8 * h;
    bf16* oc = (bf16*)(ws + WS_OC) + (size_t)t * 768 + g * 384 + 4 * h;
    const float* gp = (const float*)(ws + WS_GATES) + (size_t)t * 36 + g * 18;
    for (int hh = 0; hh < 6; ++hh) {
        bf16x8 qf[4];
#pragma unroll
        for (int s = 0; s < 4; ++s) qf[s] = *(const bf16x8*)(qrow + hh * 64 + 16 * s);
        f32x16 O0, O1; float l = 0.f;
#pragma unroll
        for (int i = 0; i < 16; ++i) { O0[i] = 0.f; O1[i] = 0.f; }
        KV32 A, B, C;
#define CA_LD(BUF, st) do { const int _s = (st) < nsteps ? (st) : nsteps - 1; kv32_load(BUF, Kc, Vc, 32 * _s, r, h); } while (0)
#define CA_STEP(BUF, st) do { if ((st) < nsteps) { const f32x16 sc = tile_qk(BUF, qf, -Bc); float p[16]; \
        if (32 * (st) + 32 <= nvmin) { _Pragma("unroll") for (int i = 0; i < 16; ++i) { p[i] = __builtin_amdgcn_exp2f(sc[i]); l += p[i]; } } \
        else { _Pragma("unroll") for (int i = 0; i < 16; ++i) { const int key = 32 * (st) + (i & 3) + 8 * (i >> 2) + 4 * h; p[i] = key < nv ? __builtin_amdgcn_exp2f(sc[i]) : 0.f; l += p[i]; } } \
        tile_pv(BUF, p, O0, O1); } CA_LD(BUF, (st) + 3); } while (0)
        if (nsteps > 0) {
        CA_LD(A, 0); CA_LD(B, 1); CA_LD(C, 2);
        for (int st = 0; st < nsteps; st += 3) { CA_STEP(A, st); CA_STEP(B, st + 1); CA_STEP(C, st + 2); }
        }
#undef CA_LD
#undef CA_STEP
        l += __shfl_xor(l, 32);
        const float inv = l > 0.f ? 1.0f / l : 0.f;
        wl[hh * 32 + r] = inv;
        tile_store(oc + hh * 64, O0, O1, inv * gp[hh * 3]);
    }
    LDS_WAIT();
    float* impr = (float*)(ws + WS_IMP) + ((size_t)t * 2 + g) * 256 + h;
    bf16x8 q3[3][4]; float inv6[6];
#pragma unroll
    for (int hh = 0; hh < 6; ++hh) { const float iv = wl[hh * 32 + r]; inv6[hh] = iv > 0.f ? __builtin_amdgcn_logf(iv) - Bc : -1e30f; }
#pragma unroll
    for (int hh = 0; hh < 3; ++hh)
#pragma unroll
        for (int s = 0; s < 4; ++s) { q3[hh][s] = *(const bf16x8*)(qrow + hh * 64 + 16 * s); qL[(hh * 4 + s) * 64] = *(const bf16x8*)(qrow + (3 + hh) * 64 + 16 * s); }
    LDS_WAIT();
    float carry = 0.f;
    bf16x8 kf[4], kn[4];
    { const bf16* kp = Kc + (h * 32 + r) * 8;
#pragma unroll
      for (int s = 0; s < 4; ++s) kf[s] = *(const bf16x8*)(kp + s * 512); }
    for (int st = 0; st < nsteps; ++st) {
        { const int sn = st + 1 < nsteps ? st + 1 : st; const bf16* kp = Kc + (size_t)(sn >> 1) * 4096 + (sn & 1) * 2048 + (h * 32 + r) * 8;
#pragma unroll
            for (int s = 0; s < 4; ++s) kn[s] = *(const bf16x8*)(kp + s * 512); }
        asm volatile("" ::: "memory");
        float Ps[16];
#pragma unroll
        for (int i = 0; i < 16; ++i) Ps[i] = 0.f;
#pragma unroll
        for (int hh = 0; hh < 6; ++hh) {
            f32x16 sc; const float c = inv6[hh] + opaque_zero();
#pragma unroll
            for (int i = 0; i < 16; ++i) sc[i] = c;
            if (hh < 3) {
#pragma unroll
                for (int s = 0; s < 4; ++s) sc = mfma32(kf[s], q3[hh][s], sc);
            } else {
#pragma unroll
                for (int s = 0; s < 4; ++s) sc = mfma32(kf[s], qL[((hh - 3) * 4 + s) * 64], sc);
            }
            if (32 * st + 32 <= nvmin) {
#pragma unroll
                for (int i = 0; i < 16; ++i) Ps[i] += __builtin_amdgcn_exp2f(sc[i]);
            } else {
#pragma unroll
                for (int i = 0; i < 16; ++i) { const int key = 32 * st + (i & 3) + 8 * (i >> 2) + 4 * h; Ps[i] += key < nv ? __builtin_amdgcn_exp2f(sc[i]) : 0.f; }
            }
        }
        float y[4], val[4];
#pragma unroll
        for (int q4 = 0; q4 < 4; ++q4) { y[q4] = __shfl_xor(Ps[4 * q4 + 3], 32); val[q4] = 2.0f * (Ps[4 * q4] + Ps[4 * q4 + 1] + Ps[4 * q4 + 2]) + Ps[4 * q4 + 3]; }
        if (h == 1) {
#pragma unroll
            for (int q4 = 0; q4 < 4; ++q4) val[q4] += y[q4];
        } else { val[0] += carry; val[1] += y[0]; val[2] += y[1]; val[3] += y[2]; }
        carry = y[3];
#pragma unroll
        for (int q4 = 0; q4 < 4; ++q4) impr[8 * st + 2 * q4] = val[q4];
#pragma unroll
        for (int s = 0; s < 4; ++s) kf[s] = kn[s];
    }
    LDS_WAIT();
}
DI void win_tile_task(const Params& P, int qt, int head, float Bw, int lane) {
    unsigned char* ws = P.ws;
    const int r = lane & 31, h = lane >> 5, t0 = 32 * qt, t = t0 + r, g = head / 6;
    const bf16* Kw = (const bf16*)(ws + WS_KWIN) + (size_t)g * S * 64; const bf16* Vw = (const bf16*)(ws + WS_VTWIN) + (size_t)g * 64 * S;
    const int kstart = t0 >= 512 ? t0 - 512 : 0, nsteps = (t0 + 32 - kstart) >> 5;
    bf16x8 qf[4];
#pragma unroll
    for (int s = 0; s < 4; ++s) qf[s] = *(const bf16x8*)((const bf16*)(ws + WS_Q) + (size_t)t * 768 + head * 64 + 16 * s + 8 * h);
    f32x16 O0, O1; float l = 0.f;
#pragma unroll
    for (int i = 0; i < 16; ++i) { O0[i] = 0.f; O1[i] = 0.f; }
    KV32 cur, nxt;
    kv32_load(cur, Kw, Vw, kstart, r, h);
    for (int st = 0; st < nsteps; ++st) {
        { const int sn = st + 1 < nsteps ? st + 1 : st; kv32_load(nxt, Kw, Vw, kstart + 32 * sn, r, h); }
        const f32x16 sc = tile_qk(cur, qf, -Bw); float p[16];
        if (st > 0 && st + 1 < nsteps) {
#pragma unroll
            for (int i = 0; i < 16; ++i) { p[i] = __builtin_amdgcn_exp2f(sc[i]); l += p[i]; }
        } else {
#pragma unroll
            for (int i = 0; i < 16; ++i) { const int kp = kstart + 32 * st + (i & 3) + 8 * (i >> 2) + 4 * h; p[i] = (kp <= t && kp > t - 512) ? __builtin_amdgcn_exp2f(sc[i]) : 0.f; l += p[i]; }
        }
        tile_pv(cur, p, O0, O1);
        cur = nxt;
    }
    l += __shfl_xor(l, 32);
    const float g2 = ((const float*)(ws + WS_GATES))[(size_t)t * 36 + head * 3 + 2];
    tile_store((bf16*)P.out + (size_t)t * 768 + head * 64 + 4 * h, O0, O1, l > 0.f ? g2 / l : 0.f);
}

DI void sel_sub(const KV32& X, int key0, unsigned mb, const bf16x8 (&qa)[4], const LAS bf16x8* qbl, int kl, int tqa, int tqb, float Bs,
                f32x16& Oa0, f32x16& Oa1, f32x16& Ob0, f32x16& Ob1, float& la, float& lb, int h) {
    if (mb & 15u) {
        const bool vr = kl < 4 && ((mb >> kl) & 1u);
        const f32x16 sc = tile_qk(X, qa, vr ? -Bs : -1e30f); float p[16];
#pragma unroll
        for (int i = 0; i < 16; ++i) { const int key = key0 + (i & 3) + 8 * (i >> 2) + 4 * h; p[i] = key <= tqa ? __builtin_amdgcn_exp2f(sc[i]) : 0.f; la += p[i]; }
        tile_pv(X, p, Oa0, Oa1);
    }
    if (mb >> 4) {
        const bool vr = kl < 4 && ((mb >> (4 + kl)) & 1u);
        bf16x8 qb[4];
#pragma unroll
        for (int s = 0; s < 4; ++s) qb[s] = qbl[s * 64];
        const f32x16 sc = tile_qk(X, qb, vr ? -Bs : -1e30f); float p[16];
#pragma unroll
        for (int i = 0; i < 16; ++i) { const int key = key0 + (i & 3) + 8 * (i >> 2) + 4 * h; p[i] = key <= tqb ? __builtin_amdgcn_exp2f(sc[i]) : 0.f; lb += p[i]; }
        tile_pv(X, p, Ob0, Ob1);
    }
}
DI void sel_out(const Params& P, const f32x16& O0, const f32x16& O1, float l, int t, int head, int h) {
    unsigned char* ws = P.ws;
    l += __shfl_xor(l, 32);
    const float g1 = ((const float*)(ws + WS_GATES))[(size_t)t * 36 + head * 3 + 1];
    const float sc = l > 0.f ? g1 / l : 0.f;
    const size_t off = (size_t)t * 768 + head * 64 + 4 * h;
    bf16* op = (bf16*)(ws + WS_MIX) + (size_t)t * D + head * 64 + 4 * h;
    const bf16* oc = (const bf16*)(ws + WS_OC) + off; const bf16* ow = (const bf16*)P.out + off;
#pragma unroll
    for (int q4 = 0; q4 < 4; ++q4) {
        st_bf16x4(op + 8 * q4, (f32x4){O0[4 * q4], O0[4 * q4 + 1], O0[4 * q4 + 2], O0[4 * q4 + 3]} * sc + ld_bf16x4(oc + 8 * q4) + ld_bf16x4(ow + 8 * q4));
        st_bf16x4(op + 32 + 8 * q4, (f32x4){O1[4 * q4], O1[4 * q4 + 1], O1[4 * q4 + 2], O1[4 * q4 + 3]} * sc + ld_bf16x4(oc + 32 + 8 * q4) + ld_bf16x4(ow + 32 + 8 * q4));
    }
}
DI void sel_unit(const Params& P, int tb, int g, float Bs, LAS unsigned char* lds, int tid, int wave, int lane) {
    unsigned char* ws = P.ws;
    LAS unsigned* mask = (LAS unsigned*)lds;
    mask[tid] = 0u;
    __syncthreads();
    if (tb <= 15) { if (tid <= tb) { mask[2 * tid] = 0xffffffffu; mask[2 * tid + 1] = 0xffffffffu; } }
    else {
        if (tid < 3) { const int j = tid == 0 ? 0 : (tid == 1 ? tb - 1 : tb); mask[2 * j] = 0xffffffffu; mask[2 * j + 1] = 0xffffffffu; }
        for (int k = 0; k < 8; ++k) {
            const int q = wave * 8 + k, t = 64 * tb + q;
            const f32x4 a = *(const f32x4*)((const float*)(ws + WS_IMP) + ((size_t)t * 2 + g) * 256 + 4 * lane);
            unsigned key[4];
#pragma unroll
            for (int e = 0; e < 4; ++e) { const int j = 4 * lane + e; key[e] = (j >= 1 && j <= tb - 2) ? __float_as_uint(a[e]) + 1u : 0u; }
            for (int it = 0; it < 13; ++it) {
                unsigned m = key[0] > key[1] ? key[0] : key[1]; const unsigned m2 = key[2] > key[3] ? key[2] : key[3]; m = m > m2 ? m : m2;
                const unsigned wm = wave_max_u32(m);
                const unsigned long long bal = __ballot(m == wm);
                const int src = __ffsll((long long)bal) - 1;
                if (lane == src) {
                    const int e = key[0] == wm ? 0 : (key[1] == wm ? 1 : (key[2] == wm ? 2 : 3));
                    __hip_atomic_fetch_or(mask + 2 * (4 * lane + e) + (q >> 5), 1u << (q & 31), __ATOMIC_RELAXED, __HIP_MEMORY_SCOPE_WORKGROUP);
                    key[0] = e == 0 ? 0u : key[0]; key[1] = e == 1 ? 0u : key[1]; key[2] = e == 2 ? 0u : key[2]; key[3] = e == 3 ? 0u : key[3];
                }
            }
        }
    }
    __syncthreads();
    const int r = lane & 31, h = lane >> 5;
    const int kl = (r * 43) >> 8, hd = r - 6 * kl, klc = kl < 4 ? kl : 0;
    const int tqa = 64 * tb + wave * 8 + klc, tqb = tqa + 4, head = g * 6 + (kl < 4 ? hd : 0);
    const bf16* Ks = (const bf16*)(ws + WS_KSEL) + (size_t)g * S * 64; const bf16* Vs = (const bf16*)(ws + WS_VTSEL) + (size_t)g * 64 * S;
    bf16x8 qa[4]; LAS bf16x8* qb = (LAS bf16x8*)(lds + 16384 + wave * 4096) + lane;
#pragma unroll
    for (int s = 0; s < 4; ++s) { qa[s] = *(const bf16x8*)((const bf16*)(ws + WS_Q) + (size_t)tqa * 768 + head * 64 + 16 * s + 8 * h);
                                  qb[s * 64] = *(const bf16x8*)((const bf16*)(ws + WS_Q) + (size_t)tqb * 768 + head * 64 + 16 * s + 8 * h); }
    LDS_WAIT();
    f32x16 Oa0, Oa1, Ob0, Ob1; float la = 0.f, lb = 0.f;
#pragma unroll
    for (int i = 0; i < 16; ++i) { Oa0[i] = 0.f; Oa1[i] = 0.f; Ob0[i] = 0.f; Ob1[i] = 0.f; }
    LAS unsigned short* wlist = (LAS unsigned short*)(lds + 2048 + wave * 512);
    int n = 0;
#pragma unroll
    for (int i = 0; i < 4; ++i) { const int jj = 64 * i + lane; unsigned bb = 0u;
        if (jj <= tb) bb = (mask[2 * jj + (wave >> 2)] >> (8 * (wave & 3))) & 0xffu;
        const unsigned long long bal = __ballot(bb != 0u); const int pos = n + __popcll(bal & ((1ull << lane) - 1ull));
        if (bb) wlist[pos] = (unsigned short)(jj | (bb << 8));
        n += __popcll(bal); }
    const int n2 = 2 * __builtin_amdgcn_readfirstlane(n);
    LDS_WAIT();
    KV32 A, B, C;
#define SEL_LD(BUF, pos) do { const int _pp = (pos) < n2 ? (pos) : n2 - 1; const int _e = __builtin_amdgcn_readfirstlane((int)wlist[_pp >> 1]); kv32_load(BUF, Ks, Vs, 64 * (_e & 255) + 32 * (_pp & 1), r, h); } while (0)
#define SEL_STEP(BUF, pos) do { if ((pos) < n2) { const int _e = __builtin_amdgcn_readfirstlane((int)wlist[(pos) >> 1]); \
        sel_sub(BUF, 64 * (_e & 255) + 32 * ((pos) & 1), (unsigned)_e >> 8, qa, qb, kl, tqa, tqb, Bs, Oa0, Oa1, Ob0, Ob1, la, lb, h); } SEL_LD(BUF, (pos) + 3); } while (0)
    if (n2 > 0) {
        SEL_LD(A, 0); SEL_LD(B, 1); SEL_LD(C, 2);
        for (int p = 0; p < n2; p += 3) { SEL_STEP(A, p); SEL_STEP(B, p + 1); SEL_STEP(C, p + 2); }
    }
#undef SEL_LD
#undef SEL_STEP
    if (kl < 4) { sel_out(P, Oa0, Oa1, la, tqa, head, h); sel_out(P, Ob0, Ob1, lb, tqb, head, h); }
    __syncthreads();
}

#define XB_TMO      128
#define XB_XCNT(j)  (256  + 64 * (j))
#define XB_XSUB(j)  (1280 + 64 * (j))
#define XB_XGEN(j)  (2304 + 64 * (j))
#define XB_TOP      3328
#define XB_TOPGEN   3392
#define XCD_BAR_WORDS 3456
#define XB_SPIN_CAP (1u << 18)

__device__ __forceinline__ unsigned xb_ld(unsigned* p)              { return __hip_atomic_load(p, __ATOMIC_RELAXED, __HIP_MEMORY_SCOPE_AGENT); }
__device__ __forceinline__ unsigned xb_add(unsigned* p, unsigned v) { return __hip_atomic_fetch_add(p, v, __ATOMIC_RELAXED, __HIP_MEMORY_SCOPE_AGENT); }
__device__ __forceinline__ unsigned xb_xcc_id() { return (unsigned)__builtin_amdgcn_s_getreg((3 << 11) | 20) & 0xFu; }
#define XB_SPIN(cond, bar) do { unsigned _sp = 0; while (cond) { __builtin_amdgcn_s_sleep(1); \
    if ((++_sp & 255u) == 0u) { if (xb_ld(&(bar)[XB_TMO])) break; if (_sp > XB_SPIN_CAP) { atomicAdd(&(bar)[XB_TMO], 1u); break; } } } } while (0)

struct XcdBarrier {
    unsigned* bar; unsigned x;
    volatile LAS unsigned* st;
};

__device__ __forceinline__ XcdBarrier xcd_barrier_post(unsigned* bar, volatile LAS unsigned* st) {
    XcdBarrier b; b.bar = bar; b.x = xb_xcc_id(); b.st = st;
    if (threadIdx.x == 0) (void)xb_add(&bar[XB_XCNT(b.x)], 1u);
    return b;
}
__device__ __forceinline__ void xcd_barrier_complete(unsigned* bar, unsigned x, unsigned& nloc, unsigned& nx) {
    const unsigned G = gridDim.x * gridDim.y * gridDim.z;
    unsigned sum, cnt, mine, sp = 0u;
    for (;;) {
        sum = 0u; cnt = 0u; mine = 0u;
#pragma unroll
        for (unsigned j = 0; j < 16; ++j) { const unsigned c = xb_ld(&bar[XB_XCNT(j)]); sum += c; cnt += (c > 0u) ? 1u : 0u; mine = (j == x) ? c : mine; }
        if (sum == G) break;
        __builtin_amdgcn_s_sleep(1);
        if ((++sp & 255u) == 0u) { if (xb_ld(&bar[XB_TMO])) break; if (sp > XB_SPIN_CAP) { atomicAdd(&bar[XB_TMO], 1u); break; } }
    }
    nloc = mine > 0u ? mine : 1u; nx = cnt > 0u ? cnt : 1u;
}

__device__ __forceinline__ void xcd_barrier(const XcdBarrier& b) {
    asm volatile("s_waitcnt vmcnt(0)" ::: "memory");
    __syncthreads();
    if (threadIdx.x == 0) {
        unsigned* bar = b.bar;
        __builtin_amdgcn_s_waitcnt(0);
        unsigned nloc = b.st[0], nx = b.st[1];
        if (nloc == 0u) { xcd_barrier_complete(bar, b.x, nloc, nx); b.st[0] = nloc; b.st[1] = nx; }
        const unsigned old = xb_add(&bar[XB_XSUB(b.x)], 1u);
        const unsigned gen = old / nloc;
        if (old + 1u == (gen + 1u) * nloc) {
            __builtin_amdgcn_fence(__ATOMIC_RELEASE, "agent");
            asm volatile("s_waitcnt vmcnt(0)" ::: "memory");
            const unsigned og = xb_add(&bar[XB_TOP], 1u);
            const unsigned tg = og / nx;
            if (og + 1u == (tg + 1u) * nx) xb_add(&bar[XB_TOPGEN], 1u);
            else XB_SPIN(xb_ld(&bar[XB_TOPGEN]) == tg, bar);
            __builtin_amdgcn_fence(__ATOMIC_ACQUIRE, "agent");
            xb_add(&bar[XB_XGEN(b.x)], 1u);
            asm volatile("s_waitcnt vmcnt(0)" ::: "memory");
        } else {
            XB_SPIN(xb_ld(&bar[XB_XGEN(b.x)]) == gen, bar);
            __builtin_amdgcn_fence(__ATOMIC_ACQUIRE, "agent");
            asm volatile("s_waitcnt vmcnt(0)" ::: "memory");
        }
    }
    __syncthreads();
}

__global__ void __launch_bounds__(NWAVES * 64, 2) yoco_fwd(Params P) {
    extern __shared__ __attribute__((aligned(16))) unsigned char lds_raw[];
    LAS unsigned char* lds = (LAS unsigned char*)lds_raw;
    const int tid = threadIdx.x, lane = tid & 63, wave = __builtin_amdgcn_readfirstlane(tid >> 6);
    const int G = gridDim.x, bx = blockIdx.x;
    const int gw = bx * NWAVES + wave, NGW = G * NWAVES;
    unsigned char* ws = P.ws;
    const int lo = P.ph_lo, hi = P.ph_hi;
#ifndef PH_MASK
#define PH_MASK 0x3fff
#endif
#define IN(k) (((PH_MASK >> (k)) & 1) && lo <= (k) && (k) < hi)
    volatile LAS unsigned* xst = (volatile LAS unsigned*)(lds + LDS_BYTES - 64);
    if (tid < 2) xst[tid] = 0u;
    __syncthreads();
    const XcdBarrier xbar = xcd_barrier_post((unsigned*)(ws + WS_CNT) + 1024, xst);
#define SEAM(k) do { if (IN(k) && IN((k) + 1)) { { xcd_barrier(xbar); } } } while (0)
    float* ss1 = (float*)(ws + WS_SS); float* ss2 = ss1 + S; float* ss3 = ss2 + S;
    bf16* xb = (bf16*)(ws + WS_XB); bf16* mix = (bf16*)(ws + WS_MIX); bf16* hb = (bf16*)(ws + WS_HB);

    if (IN(0)) { p0_prologue(P, lds, gw, NGW, wave, lane); __syncthreads(); }
    SEAM(0);
    if (IN(1)) {
        { pg8::Gemm g{xb, (const bf16*)(ws + WS_WA), S, 1792, D, D}; pg8::StaticOrder So; So.init(S, 1792, G, bx);
          EpiA E{(bf16*)(ws + WS_VGLU), (bf16*)(ws + WS_QM0), P.in[I_ABGLU], P.in[I_MQG], ss1 + 3 * S};
          pg8::gemm_phase<EpiA, pg8::StaticOrder, true>(lds, g, So, E); }
        { pg8::Gemm g{(const bf16*)(ws + WS_MEMB), (const bf16*)(ws + WS_WM), 256, 1024, D, D};
          const int c = G >= 4 ? bx - (G - 4) : bx; pg8::ListOrder So{4, 4, G >= 4 ? 4 : G, c, 0};
          EpiMem E{(bf16*)(ws + WS_MK), (bf16*)(ws + WS_MVT), P.in[I_MKG]};
          pg8::gemm_phase<EpiMem, pg8::ListOrder, true>(lds, g, So, E); }
    }
    SEAM(1);
    if (IN(2)) {
        for (int task = gw; task < S / 4; task += NGW) conv_task(P, task * 4, lane);
        mem_attn_phase(P, 0, (const bf16*)(ws + WS_QM0), gw, NGW, lane);
        if (bx == 0) { const int i = tid; float s = 0.f; const float* bp = (const float*)(ws + WS_BPART) + (i >> 8) * 64 * 256 + (i & 255);
            for (int kc = 0; kc < 64; ++kc) s += bp[kc * 256];
            ((float*)(ws + WS_BIAS1))[i] = s; }
    }
    SEAM(2);
    if (IN(3)) { pg8::Gemm g{mix, (const bf16*)(ws + WS_WO), S, D, D, D}; pg8::StaticOrder So; So.init(S, D, G, bx);
        EpiRes E{nullptr, xb, nullptr, xb, ss1, 0}; pg8::gemm_phase<EpiRes, pg8::StaticOrder, true>(lds, g, So, E); }
    SEAM(3);
    if (IN(4)) { pg8::Gemm g{xb, (const bf16*)(ws + WS_W1), S, FF, D, D}; pg8::StaticOrder So; So.init(S, FF, G, bx, 8);
        EpiMlpIn E{hb, ss1}; pg8::gemm_phase<EpiMlpIn, pg8::StaticOrder, true>(lds, g, So, E); }
    SEAM(4);
    if (IN(5)) { pg8::Gemm g{hb, (const bf16*)(ws + WS_W2), S, D, FF, FF}; pg8::StaticOrder So; So.init(S, D, G, bx);
        EpiRes E{nullptr, xb, nullptr, xb, ss2, 0}; pg8::gemm_phase<EpiRes, pg8::StaticOrder, true>(lds, g, So, E); }
    SEAM(5);
    if (IN(6)) {
        if (bx == 0 && tid < 512) ((unsigned*)(ws + WS_CBUF + (size_t)4 * S * 64 * 2))[tid] = 0u;
        pg8::Gemm g{xb, (const bf16*)(ws + WS_WB), S, 2048, D, D}; pg8::StaticOrder So; So.init(S, 2048, G, bx);
        EpiB E{ss2, (bf16*)(ws + WS_CBUF), (bf16*)(ws + WS_KSEL), (bf16*)(ws + WS_VTSEL), (bf16*)(ws + WS_KWIN), (bf16*)(ws + WS_VTWIN), (bf16*)(ws + WS_Q), (bf16*)(ws + WS_QM1),
               (float*)(ws + WS_GATES), P.in[I_KNG], P.in[I_BQG], P.in[I_MQG] + 64, P.in[I_BGATEB]};
        pg8::gemm_phase<EpiB, pg8::StaticOrder, true>(lds, g, So, E); }
    SEAM(6);
    if (IN(7)) {
        { pg8::Gemm g{(const bf16*)(ws + WS_CBUF), (const bf16*)(ws + WS_W1C), 4096, 2048, 512, 1024}; pg8::ListOrder So{64, 1, G, bx, 1};
          EpiC E{(float*)(ws + WS_PART)}; pg8::gemm_phase<EpiC, pg8::ListOrder, true>(lds, g, So, E); }
        if (G > 128) mem_attn_phase(P, 1, (const bf16*)(ws + WS_QM1), bx >= 64 ? gw - 64 * NWAVES : -1, NGW - 64 * NWAVES, lane);
        else mem_attn_phase(P, 1, (const bf16*)(ws + WS_QM1), gw, NGW, lane);
    }
    SEAM(7);
    if (IN(8)) { for (int task = gw; task < 128; task += NGW) cmp2_task(P, task, lane); }
    SEAM(8);
    if (IN(9)) {
        const float gq = gain_max(P.in[I_BQG], lane);
        const float Bc = BNDC * gq * gain_max(P.in[I_KNG], lane) * 1.02f, Bw = BNDC * gq * gain_max(P.in[I_KNG] + 128, lane) * 1.02f;
        LAS float* wl = (LAS float*)(lds + wave * 1024);
        unsigned* cq = (unsigned*)(ws + WS_CNT); unsigned* wq = cq + 3;
        volatile LAS unsigned* pflag = (volatile LAS unsigned*)(lds + 120000);
        unsigned idx0 = 0xffffffffu;
        if (wave < 4) { if (lane == 0) idx0 = atomicAdd(cq, 1u); idx0 = (unsigned)__builtin_amdgcn_readfirstlane((int)idx0); if (lane == 0) pflag[wave] = idx0 < 448u ? 1u : 0u; }
        __syncthreads();
        if (wave < 4) {
            if (idx0 < 1024u) cmp_tile_task(P, 511 - (int)(idx0 >> 1), (int)(idx0 & 1u), Bc, wl, (LAS bf16x8*)(lds + 16384 + wave * 12288) + lane, lane);
            if (lane == 0) pflag[wave] = 0u;
        } else {
            while (__builtin_amdgcn_readfirstlane((int)pflag[wave - 4]) != 0) __builtin_amdgcn_s_sleep(32);
        }
        for (int pass = 0; pass < 2; ++pass) {
            const bool do_cmp = (wave < 4) == (pass == 0);
            for (;;) {
                unsigned idx = 0; if (lane == 0) idx = atomicAdd(do_cmp ? cq : wq, 1u); idx = (unsigned)__builtin_amdgcn_readfirstlane((int)idx);
                if (idx >= (do_cmp ? 1024u : 6144u)) break;
                if (do_cmp) cmp_tile_task(P, 511 - (int)(idx >> 1), (int)(idx & 1u), Bc, wl, (LAS bf16x8*)(lds + 16384 + wave * 12288) + lane, lane);
                else win_tile_task(P, (int)(idx / 12u), (int)(idx % 12u), Bw, lane);
            }
        }
        __syncthreads();
    }
    SEAM(9);
    if (IN(10)) {
        const float Bs = BNDC * gain_max(P.in[I_BQG], lane) * gain_max(P.in[I_KNG] + 64, lane) * 1.02f;
        if (G == 256) {
            sel_unit(P, 255 - (bx >> 1), bx & 1, Bs, lds, tid, wave, lane);
            sel_unit(P, bx >> 1, bx & 1, Bs, lds, tid, wave, lane);
        } else {
            for (int i = 0, u = bx; u < 512; ++i, u += G) {
                const int base = i * G, span = (512 - base) < G ? (512 - base) : G;
                const int uu = (i & 1) ? base + span - 1 - (u - base) : u;
                const int v = 511 - uu;
                sel_unit(P, v >> 1, v & 1, Bs, lds, tid, wave, lane);
            }
        }
    }
    SEAM(10);
    if (IN(11)) { pg8::Gemm g{mix, (const bf16*)(ws + WS_WO) + (size_t)D * D, S, D, D, D}; pg8::StaticOrder So; So.init(S, D, G, bx);
        EpiRes E{nullptr, xb, nullptr, xb, ss3, 0}; pg8::gemm_phase<EpiRes, pg8::StaticOrder, true>(lds, g, So, E); }
    SEAM(11);
    if (IN(12)) { pg8::Gemm g{xb, (const bf16*)(ws + WS_W1) + (size_t)D * FF, S, FF, D, D}; pg8::StaticOrder So; So.init(S, FF, G, bx, 8);
        EpiMlpIn E{hb, ss3}; pg8::gemm_phase<EpiMlpIn, pg8::StaticOrder, true>(lds, g, So, E); }
    SEAM(12);
    if (IN(13)) { pg8::Gemm g{hb, (const bf16*)(ws + WS_W2) + (size_t)D * FF, S, D, FF, FF}; pg8::StaticOrder So; So.init(S, D, G, bx);
        EpiRes E{nullptr, xb, P.out, xb, ss3, 1}; pg8::gemm_phase<EpiRes, pg8::StaticOrder, true>(lds, g, So, E); }
    if (P.ph_hi > 1000) cg::this_grid().sync();
#undef IN
#undef SEAM
}

extern "C" void kernel_launch(void* const* d_in, const int* in_sizes, int n_in, void* d_out, int out_size, void* d_ws, size_t ws_size, hipStream_t stream) {
    static int grid = 0;
    if (grid == 0) {
        if (n_in != 29 || out_size != S * D || ws_size < WS_END) { fprintf(stderr, "kernel_launch: unexpected shapes (n_in %d out %d ws %zu)\n", n_in, out_size, ws_size); grid = -1; return; }
        int dev = 0, cus = 0, per_cu = 0;
        hipGetDevice(&dev); hipDeviceGetAttribute(&cus, hipDeviceAttributeMultiprocessorCount, dev);
        hipFuncSetAttribute((const void*)yoco_fwd, hipFuncAttributeMaxDynamicSharedMemorySize, LDS_BYTES);
        hipOccupancyMaxActiveBlocksPerMultiprocessor(&per_cu, (const void*)yoco_fwd, NWAVES * 64, LDS_BYTES);
        if (per_cu < 1) { fprintf(stderr, "kernel_launch: occupancy query reports %d\n", per_cu); per_cu = 1; }
        (void)hipGetLastError();
        grid = cus;
    }
    if (grid < 0) return;
    (void)hipMemsetAsync((char*)d_ws + WS_CNT, 0, 32768, stream);
    Params p{};
    for (int i = 0; i < 29; ++i) p.in[i] = (const float*)d_in[i];
    p.out = (float*)d_out; p.ws = (unsigned char*)d_ws; p.ph_lo = 0; p.ph_hi = 14;
    void* args[] = {&p};
    hipError_t e = hipLaunchCooperativeKernel((const void*)yoco_fwd, dim3(grid), dim3(NWAVES * 64), args, LDS_BYTES, stream);
    if (e != hipSuccess) fprintf(stderr, "cooperative launch failed: %s (grid %d)\n", hipGetErrorString(e), grid);
}
```

```cpp
#include <hip/hip_runtime.h>
#include <hip/hip_cooperative_groups.h>
#include <cstdio>
#include <cstdint>
namespace cg = cooperative_groups;

#define LAS __attribute__((address_space(3)))
typedef unsigned short bf16;
typedef short bf16x8 __attribute__((ext_vector_type(8)));
typedef short s16x4 __attribute__((ext_vector_type(4)));
typedef float f32x2 __attribute__((ext_vector_type(2)));
typedef float f32x4 __attribute__((ext_vector_type(4)));
typedef float f32x16 __attribute__((ext_vector_type(16)));
typedef unsigned u32x2 __attribute__((ext_vector_type(2)));
typedef unsigned u32x4 __attribute__((ext_vector_type(4)));
typedef __bf16 bf16x2_t __attribute__((ext_vector_type(2)));
#define DI __device__ __forceinline__

DI unsigned pk2(float lo, float hi) { f32x2 v = {lo, hi}; bf16x2_t b = __builtin_convertvector(v, bf16x2_t); return __builtin_bit_cast(unsigned, b); }
DI float wave_sum(float v) {
#pragma unroll
    for (int o = 1; o < 64; o <<= 1) v += __shfl_xor(v, o);
    return v;
}
DI float wave_max(float v) {
#pragma unroll
    for (int o = 1; o < 64; o <<= 1) v = fmaxf(v, __shfl_xor(v, o));
    return v;
}
DI unsigned wave_max_u32(unsigned x) {
#define WMX(ctrl, rm) { const unsigned y = (unsigned)__builtin_amdgcn_update_dpp(0, (int)x, ctrl, rm, 0xf, false); x = y > x ? y : x; }
    WMX(0x111, 0xf) WMX(0x112, 0xf) WMX(0x114, 0xf) WMX(0x118, 0xf) WMX(0x142, 0xa) WMX(0x143, 0xc)
#undef WMX
    return (unsigned)__builtin_amdgcn_readlane((int)x, 63);
}
DI float sigmoidf_(float x) { return 1.0f / (1.0f + __expf(-x)); }
#define LDS_WAIT() asm volatile("s_waitcnt lgkmcnt(0)" ::: "memory")

constexpr int S = 16384, D = 1024, FF = 4096, MEML = 256;
constexpr float EPS = 1e-6f;
constexpr float QSCALE = 0.125f * 1.4426950408889634f;
constexpr float BNDC = 64.0f * QSCALE;

namespace pg8 {
#define PG8_LAS __attribute__((address_space(3)))
constexpr int BM = 256, BK = 64, HALF = 128, HTB = HALF * BK * 2, STAGE_BYTES = 8 * HTB, NXCD = 8, WGM = 4;
__host__ __device__ __forceinline__ int lds_byte(int r, int c) { const int st = (r >> 4) * 2 + (c >> 5), rr = r & 15, cc = c & 31, ob = rr * 64 + cc * 2; return st * 1024 + (ob ^ (((ob >> 9) & 1) << 5)); }
__host__ __device__ __forceinline__ void stage_rc(int b, int& R, int& C) { const int st = b / 1024, sb = b % 1024, swz = sb ^ (((sb >> 9) & 1) << 5); R = (st >> 1) * 16 + swz / 64; C = (st & 1) * 32 + (swz % 64) / 2; }
__host__ __device__ __forceinline__ int perm32(int rho) { const int n = rho >> 4, i = rho & 15; return 8 * (i >> 2) + 4 * n + (i & 3); }
struct Unit { int pm, pn; };
struct Gemm { const bf16* A; const bf16* Bt; int M, N, K, lda; };
struct StaticOrder {
    int nM, nN, nwg, G, c;
    __device__ void init(int M, int N, int G_, int c_) { nM = M / BM; nN = N / BM; nwg = nM * nN; G = G_; c = c_; }
    __device__ bool next(int i, Unit& u) const {
        const long L = (long)i * G + c; if (L >= nwg) return false;
        int wgid = (int)L; { const int q = nwg / NXCD, r = nwg % NXCD, xcd = wgid % NXCD, off = wgid / NXCD; wgid = (xcd < r ? xcd * (q + 1) : r * (q + 1) + (xcd - r) * q) + off; }
        const int nig = WGM * nN, gid = wgid / nig, fm = gid * WGM, gsz = (nM - fm) < WGM ? (nM - fm) : WGM;
        u.pm = fm + ((wgid % nig) % gsz); u.pn = (wgid % nig) / gsz; return true;
    }
    __device__ size_t aoff(const Unit&) const { return 0; }
};
struct ListOrder {
    int n, nN, G, c, cmp;
    __device__ bool next(int i, Unit& u) const { const int L = c + i * G; if (c < 0 || L >= n) return false; if (cmp) { u.pm = L >> 2; u.pn = (L >> 5) * 4 + (L & 3); } else { u.pm = L / nN; u.pn = L % nN; } return true; }
    __device__ size_t aoff(const Unit& u) const { return cmp ? (size_t)(u.pn & 3) * 1024 : 0; }
};

template <class Epi, class Sched, bool ALIGN_EPI>
__device__ __forceinline__ void gemm_phase(PG8_LAS unsigned char* lds, const Gemm g, const Sched& S, const Epi& E) {
    const int tid = threadIdx.x, wid = __builtin_amdgcn_readfirstlane(tid >> 6), lane = tid & 63, wr = wid >> 2, wc = wid & 3, fr = lane & 15, fq = lane >> 4;
    const int K = g.K, nt = K / BK, lda = g.lda;
    unsigned voffA[2], voffB[2];
#pragma unroll
    for (int i = 0; i < 2; ++i) { int R, C; stage_rc(tid * 16 + i * 8192, R, C); const int Rb = Epi::PERM ? ((R & ~31) + perm32(R & 31)) : R;
        voffA[i] = (unsigned)(R * lda + C) * 2u; voffB[i] = (unsigned)(Rb * K + C) * 2u; }
    const size_t kstep = (size_t)(BK * 2);
    const size_t hstepA = (size_t)HALF * lda * 2, hstepB = (size_t)HALF * K * 2;
    const size_t tstepA = 2 * hstepA, tstepB = 2 * hstepB;
    const unsigned ldsw = (unsigned)wid * 1024u;
    const int aoff = lds_byte(wr * 64 + fr, fq * 8), boff = lds_byte(wc * 32 + fr, fq * 8);
#define PG8_SA(b, h) (((b) * 2 + (h)) * HTB)
#define PG8_SB(b, h) ((4 + (b) * 2 + (h)) * HTB)
#define PG8_STAGE(bufoff, gbase, voff) do { _Pragma("unroll") for (int _i = 0; _i < 2; ++_i) \
        __builtin_amdgcn_global_load_lds((const unsigned*)((const char*)(gbase) + (voff)[_i]), (PG8_LAS unsigned*)(lds + (bufoff) + ldsw + _i * 8192), 16, 0, 0); } while (0)
#define PG8_LDA(dst, b, h) do { _Pragma("unroll") for (int m = 0; m < 4; ++m) _Pragma("unroll") for (int k = 0; k < 2; ++k) dst[m][k] = *(const PG8_LAS bf16x8*)(lds + PG8_SA(b, h) + aoff + m * 2048 + k * 1024); } while (0)
#define PG8_LDB(dst, b, h) do { _Pragma("unroll") for (int n = 0; n < 2; ++n) _Pragma("unroll") for (int k = 0; k < 2; ++k) dst[n][k] = *(const PG8_LAS bf16x8*)(lds + PG8_SB(b, h) + boff + n * 2048 + k * 1024); } while (0)
#define PG8_MMA(ai, bj, At, Bt) do { __builtin_amdgcn_s_setprio(1); _Pragma("unroll") for (int m = 0; m < 4; ++m) _Pragma("unroll") for (int n = 0; n < 2; ++n) _Pragma("unroll") for (int k = 0; k < 2; ++k) \
        acc[ai][bj][m][n] = __builtin_amdgcn_mfma_f32_16x16x32_bf16(Bt[n][k], At[m][k], acc[ai][bj][m][n], 0, 0, 0); __builtin_amdgcn_s_setprio(0); } while (0)
#define PG8_WAIT_V(n) asm volatile("s_waitcnt vmcnt(" #n ")" ::: "memory")
#define PG8_WAIT_L(n) asm volatile("s_waitcnt lgkmcnt(" #n ")" ::: "memory")
#define PG8_BAR __builtin_amdgcn_s_barrier()
#define PG8_SCHED __builtin_amdgcn_sched_barrier(0)
    Unit cur, nxt; int ui = 0;
    if (!S.next(0, cur)) return;
    f32x4 acc[2][2][4][2];
#pragma unroll
    for (int a = 0; a < 2; ++a)
#pragma unroll
        for (int b = 0; b < 2; ++b)
#pragma unroll
            for (int m = 0; m < 4; ++m)
#pragma unroll
                for (int n = 0; n < 2; ++n) acc[a][b][m][n] = (f32x4){0.f, 0.f, 0.f, 0.f};
    bf16x8 At[4][2], B0[2][2], B1[2][2];
    const char* cA = (const char*)g.A + (size_t)cur.pm * tstepA + S.aoff(cur); const char* cB = (const char*)g.Bt + (size_t)cur.pn * tstepB;
    PG8_STAGE(PG8_SB(0, 0), cB, voffB); PG8_STAGE(PG8_SB(0, 1), cB + hstepB, voffB); PG8_STAGE(PG8_SA(0, 0), cA, voffA); PG8_STAGE(PG8_SA(0, 1), cA + hstepA, voffA);
    if (wr == 1) PG8_BAR;
    PG8_WAIT_V(2); PG8_BAR;
    PG8_STAGE(PG8_SB(1, 0), cB + kstep, voffB); PG8_STAGE(PG8_SA(1, 0), cA + kstep, voffA); PG8_STAGE(PG8_SB(1, 1), cB + hstepB + kstep, voffB);
    PG8_WAIT_V(6); PG8_BAR;
    for (;;) {
        const bool has_next = S.next(ui + 1, nxt);
        const char* nA = has_next ? (const char*)g.A + (size_t)nxt.pm * tstepA + S.aoff(nxt) : cA; const char* nB = has_next ? (const char*)g.Bt + (size_t)nxt.pn * tstepB : cB;
        for (int t = 0; t < nt; t += 2) {
            const bool last = (t == nt - 2);
            const char* a1 = cA + (size_t)(t + 1) * kstep;
            const char* a2 = last ? nA : cA + (size_t)(t + 2) * kstep; const char* b2 = last ? nB : cB + (size_t)(t + 2) * kstep;
            const char* a3 = a2 + kstep; const char* b3 = b2 + kstep;
            PG8_LDB(B0, 0, 0); PG8_LDB(B1, 0, 1); PG8_SCHED; PG8_LDA(At, 0, 0); PG8_STAGE(PG8_SA(1, 1), a1 + hstepA, voffA);
            PG8_WAIT_V(8); PG8_WAIT_L(0); PG8_BAR; PG8_MMA(0, 0, At, B0); PG8_MMA(0, 1, At, B1); PG8_BAR; PG8_SCHED;
            PG8_LDA(At, 0, 1); PG8_STAGE(PG8_SB(0, 0), b2, voffB); PG8_STAGE(PG8_SB(0, 1), b2 + hstepB, voffB); PG8_STAGE(PG8_SA(0, 0), a2, voffA);
            PG8_WAIT_V(8); PG8_WAIT_L(0); PG8_BAR; PG8_MMA(1, 0, At, B0); PG8_MMA(1, 1, At, B1); PG8_BAR; PG8_SCHED;
            PG8_LDB(B0, 1, 0); PG8_LDB(B1, 1, 1); PG8_SCHED; PG8_LDA(At, 1, 0); PG8_STAGE(PG8_SA(0, 1), a2 + hstepA, voffA);
            PG8_WAIT_V(8); PG8_WAIT_L(0); PG8_BAR; PG8_MMA(0, 0, At, B0); PG8_MMA(0, 1, At, B1); PG8_BAR; PG8_SCHED;
            PG8_LDA(At, 1, 1); PG8_STAGE(PG8_SB(1, 0), b3, voffB); PG8_STAGE(PG8_SB(1, 1), b3 + hstepB, voffB); PG8_STAGE(PG8_SA(1, 0), a3, voffA);
            PG8_WAIT_V(8); PG8_WAIT_L(0); PG8_BAR; PG8_MMA(1, 0, At, B0); PG8_MMA(1, 1, At, B1); PG8_BAR; PG8_SCHED;
        }
        if constexpr (ALIGN_EPI) { if (wr == 0) PG8_BAR; }
        E(acc, cur, wr, wc, fr, fq);
        if (!has_next) break;
#pragma unroll
        for (int a = 0; a < 2; ++a)
#pragma unroll
            for (int b = 0; b < 2; ++b)
#pragma unroll
                for (int m = 0; m < 4; ++m)
#pragma unroll
                    for (int n = 0; n < 2; ++n) acc[a][b][m][n] = (f32x4){0.f, 0.f, 0.f, 0.f};
        cur = nxt; cA = nA; cB = nB; ++ui;
        if constexpr (ALIGN_EPI) { if (wr == 1) PG8_BAR; }
    }
    PG8_WAIT_V(0);
    if constexpr (!ALIGN_EPI) { if (wr == 0) PG8_BAR; }
    PG8_BAR;
#undef PG8_SA
#undef PG8_SB
#undef PG8_STAGE
#undef PG8_LDA
#undef PG8_LDB
#undef PG8_MMA
#undef PG8_WAIT_V
#undef PG8_WAIT_L
#undef PG8_BAR
#undef PG8_SCHED
}
}
using pg8::Unit; using pg8::HALF; using pg8::BM;

typedef f32x4 Acc[2][2][4][2];

DI int kimg(int key, int dim) { return ((((key >> 5) & 1) * 4 + (dim >> 4)) * 64 + ((dim >> 3) & 1) * 32 + (key & 31)) * 8 + (dim & 7); }
DI int vimg(int dim, int key) { return (((((key >> 5) & 1) * 2 + ((key >> 4) & 1)) * 2 + (dim >> 5)) * 64 + ((key >> 2) & 1) * 32 + (dim & 31)) * 8 + ((key >> 3) & 1) * 4 + (key & 3); }
DI f32x4 ld_bf16x4(const bf16* p) { const u32x2 raw = *(const u32x2*)p; return (f32x4){__uint_as_float(raw.x << 16), __uint_as_float(raw.x & 0xffff0000u), __uint_as_float(raw.y << 16), __uint_as_float(raw.y & 0xffff0000u)}; }
DI void st_bf16x4(bf16* p, f32x4 v) { u32x2 w; w.x = pk2(v[0], v[1]); w.y = pk2(v[2], v[3]); *(u32x2*)p = w; }

DI float head_rs(const Acc& acc, int ai, int m, float pre) {
    float s = 0.f;
#pragma unroll
    for (int bj = 0; bj < 2; ++bj)
#pragma unroll
        for (int n = 0; n < 2; ++n) { const f32x4 x = acc[ai][bj][m][n] * pre; s += (x[0] * x[0] + x[1] * x[1]) + (x[2] * x[2] + x[3] * x[3]); }
    s += __shfl_xor(s, 16); s += __shfl_xor(s, 32);
    return __builtin_amdgcn_rsqf(s * (1.0f / 64.0f) + EPS);
}

struct EpiA {
    static constexpr bool PERM = false;
    bf16* vglu; bf16* qm; const float* b_glu; const float* qg; const float* ss0;
    DI void operator()(const Acc& acc, const Unit& u, int wr, int wc, int fr, int fq) const {
        const int row0 = u.pm * BM + wr * 64 + fr;
        if (u.pn < 6) {
#pragma unroll
            for (int n = 0; n < 2; ++n) {
                const int ch0 = 128 * u.pn + 32 * wc + 16 * n + 4 * fq;
                const f32x4 ba = *(const f32x4*)(b_glu + ch0), bg = *(const f32x4*)(b_glu + 768 + ch0);
#pragma unroll
                for (int ai = 0; ai < 2; ++ai)
#pragma unroll
                    for (int m = 0; m < 4; ++m) {
                        const float rs = __builtin_amdgcn_rsqf(ss0[row0 + ai * HALF + m * 16] * (1.0f / D) + EPS);
                        const f32x4 a = acc[ai][0][m][n] * rs + ba, gt = acc[ai][1][m][n] * rs + bg; f32x4 v;
#pragma unroll
                        for (int e = 0; e < 4; ++e) v[e] = a[e] * sigmoidf_(gt[e]);
                        st_bf16x4(vglu + (size_t)(row0 + ai * HALF + m * 16) * 768 + ch0, v);
                    }
            }
        } else {
#pragma unroll
            for (int ai = 0; ai < 2; ++ai)
#pragma unroll
                for (int m = 0; m < 4; ++m) {
                    const float rs = __builtin_amdgcn_rsqf(ss0[row0 + ai * HALF + m * 16] * (1.0f / D) + EPS);
                    const float r = head_rs(acc, ai, m, rs) * rs * QSCALE;
#pragma unroll
                    for (int bj = 0; bj < 2; ++bj)
#pragma unroll
                        for (int n = 0; n < 2; ++n) { const int d0 = 32 * bj + 16 * n + 4 * fq; const f32x4 g4 = *(const f32x4*)(qg + d0);
                            st_bf16x4(qm + (size_t)(row0 + ai * HALF + m * 16) * 256 + wc * 64 + d0, acc[ai][bj][m][n] * r * g4); }
                }
        }
    }
};
struct EpiMem {
    static constexpr bool PERM = false;
    bf16* mk; bf16* mvT; const float* kg;
    DI void operator()(const Acc& acc, const Unit& u, int wr, int wc, int fr, int fq) const {
        const int l = u.pn >> 1, kv = u.pn & 1, row0 = wr * 64 + fr;
#pragma unroll
        for (int ai = 0; ai < 2; ++ai)
#pragma unroll
            for (int m = 0; m < 4; ++m) {
                const int row = row0 + ai * HALF + m * 16;
                if (kv == 0) {
                    const float r = head_rs(acc, ai, m, 1.0f);
#pragma unroll
                    for (int bj = 0; bj < 2; ++bj)
#pragma unroll
                        for (int n = 0; n < 2; ++n) { const int d0 = 32 * bj + 16 * n + 4 * fq; const f32x4 g4 = *(const f32x4*)(kg + l * 64 + d0);
                            st_bf16x4(mk + ((size_t)((l * 4 + wc) * 4 + (row >> 6))) * 4096 + ((row >> 5) & 1) * 2048 + (row & 31) * 8 + (2 * bj + n) * 512 + (fq >> 1) * 256 + 4 * (fq & 1), acc[ai][bj][m][n] * r * g4); }
                } else {
#pragma unroll
                    for (int bj = 0; bj < 2; ++bj)
#pragma unroll
                        for (int n = 0; n < 2; ++n) { const int d0 = 32 * bj + 16 * n + 4 * fq; const f32x4 v = acc[ai][bj][m][n];
#pragma unroll
                            for (int e = 0; e < 4; ++e) mvT[((size_t)((l * 4 + wc) * 4 + (row >> 6))) * 4096 + vimg(0, row & 63) + bj * 512 + (16 * n + 4 * fq + e) * 8] = (bf16)(pk2(v[e], 0.f) & 0xffffu); }
                }
            }
    }
};
struct EpiRes {
    static constexpr bool PERM = true;
    const float* bf; const bf16* bb; float* out; bf16* xb; float* ss; int last;
    DI void operator()(const Acc& acc, const Unit& u, int wr, int wc, int fr, int fq) const {
        const int row0 = u.pm * BM + wr * 64 + fr, col0 = u.pn * BM + wc * 32 + 8 * fq;
#pragma unroll
        for (int ai = 0; ai < 2; ++ai)
#pragma unroll
            for (int m = 0; m < 4; ++m) {
                const int row = row0 + ai * HALF + m * 16; const size_t p = (size_t)row * D + col0; float s = 0.f;
#pragma unroll
                for (int bj = 0; bj < 2; ++bj) { const size_t off = p + bj * HALF;
                    const u32x4 raw = *(const u32x4*)(bb + off);
                    const f32x4 v0 = (f32x4){__uint_as_float(raw.x << 16), __uint_as_float(raw.x & 0xffff0000u), __uint_as_float(raw.y << 16), __uint_as_float(raw.y & 0xffff0000u)} + acc[ai][bj][m][0];
                    const f32x4 v1 = (f32x4){__uint_as_float(raw.z << 16), __uint_as_float(raw.z & 0xffff0000u), __uint_as_float(raw.w << 16), __uint_as_float(raw.w & 0xffff0000u)} + acc[ai][bj][m][1];
                    if (out) { __builtin_nontemporal_store(v0, (f32x4*)(out + off)); __builtin_nontemporal_store(v1, (f32x4*)(out + off + 4)); }
                    if (!last) { u32x4 w; w.x = pk2(v0[0], v0[1]); w.y = pk2(v0[2], v0[3]); w.z = pk2(v1[0], v1[1]); w.w = pk2(v1[2], v1[3]); *(u32x4*)(xb + off) = w;
                        s += (v0[0] * v0[0] + v0[1] * v0[1]) + (v0[2] * v0[2] + v0[3] * v0[3]) + (v1[0] * v1[0] + v1[1] * v1[1]) + (v1[2] * v1[2] + v1[3] * v1[3]); } }
                if (!last) { s += __shfl_xor(s, 16); s += __shfl_xor(s, 32); if (fq == 0) unsafeAtomicAdd(ss + row, s); }
            }
    }
};
struct EpiMlpIn {
    static constexpr bool PERM = true;
    bf16* hb; const float* ss;
    DI void operator()(const Acc& acc, const Unit& u, int wr, int wc, int fr, int fq) const {
        const int row0 = u.pm * BM + wr * 64 + fr, col0 = u.pn * BM + wc * 32 + 8 * fq;
#pragma unroll
        for (int ai = 0; ai < 2; ++ai)
#pragma unroll
            for (int m = 0; m < 4; ++m) {
                const int row = row0 + ai * HALF + m * 16; const float rs = __builtin_amdgcn_rsqf(ss[row] * (1.0f / D) + EPS);
#pragma unroll
                for (int bj = 0; bj < 2; ++bj) { f32x4 v0 = acc[ai][bj][m][0] * rs, v1 = acc[ai][bj][m][1] * rs;
#pragma unroll
                    for (int e = 0; e < 4; ++e) { const float a = fmaxf(v0[e], 0.f), b = fmaxf(v1[e], 0.f); v0[e] = a * a; v1[e] = b * b; }
                    u32x4 w; w.x = pk2(v0[0], v0[1]); w.y = pk2(v0[2], v0[3]); w.z = pk2(v1[0], v1[1]); w.w = pk2(v1[2], v1[3]);
                    *(u32x4*)(hb + (size_t)row * FF + col0 + bj * HALF) = w; }
            }
    }
};
struct EpiB {
    static constexpr bool PERM = false;
    const float* ss; bf16* cbuf; bf16* ksel; bf16* vTsel; bf16* kwin; bf16* vTwin; bf16* q; bf16* qm; float* gates;
    const float* kng; const float* qng; const float* mqg; const float* gate_b;
    DI void operator()(const Acc& acc, const Unit& u, int wr, int wc, int fr, int fq) const {
        const int row0 = u.pm * BM + wr * 64 + fr; const int pn = u.pn;
#pragma unroll
        for (int ai = 0; ai < 2; ++ai)
#pragma unroll
            for (int m = 0; m < 4; ++m) {
                const int row = row0 + ai * HALF + m * 16; const float rs = __builtin_amdgcn_rsqf(ss[row] * (1.0f / D) + EPS);
                if (pn == 0) {
#pragma unroll
                    for (int bj = 0; bj < 2; ++bj)
#pragma unroll
                        for (int n = 0; n < 2; ++n) { const int d0 = 32 * bj + 16 * n + 4 * fq; st_bf16x4(cbuf + ((size_t)wc * S + row) * 64 + d0, acc[ai][bj][m][n] * rs); }
                } else if (pn <= 2) {
                    bf16* kd = pn == 1 ? ksel : kwin; bf16* vd = pn == 1 ? vTsel : vTwin; const float* g = kng + pn * 64;
                    if (wc < 2) {
                        const float r = head_rs(acc, ai, m, rs) * rs;
#pragma unroll
                        for (int bj = 0; bj < 2; ++bj)
#pragma unroll
                            for (int n = 0; n < 2; ++n) { const int d0 = 32 * bj + 16 * n + 4 * fq; const f32x4 g4 = *(const f32x4*)(g + d0);
                                st_bf16x4(kd + ((size_t)wc * (S / 64) + (row >> 6)) * 4096 + ((row >> 5) & 1) * 2048 + (row & 31) * 8 + (2 * bj + n) * 512 + (fq >> 1) * 256 + 4 * (fq & 1), acc[ai][bj][m][n] * r * g4); }
                    } else {
#pragma unroll
                        for (int bj = 0; bj < 2; ++bj)
#pragma unroll
                            for (int n = 0; n < 2; ++n) { const int d0 = 32 * bj + 16 * n + 4 * fq; const f32x4 v = acc[ai][bj][m][n] * rs;
#pragma unroll
                                for (int e = 0; e < 4; ++e) vd[((size_t)(wc - 2) * (S / 64) + (row >> 6)) * 4096 + vimg(0, row & 63) + bj * 512 + (16 * n + 4 * fq + e) * 8] = (bf16)(pk2(v[e], 0.f) & 0xffffu); }
                    }
                } else if (pn <= 6) {
                    const float r = head_rs(acc, ai, m, rs) * rs * QSCALE; const float* g = pn == 6 ? mqg : qng;
                    bf16* dst = pn == 6 ? qm + (size_t)row * 256 + wc * 64 : q + (size_t)row * 768 + ((pn - 3) * 4 + wc) * 64;
#pragma unroll
                    for (int bj = 0; bj < 2; ++bj)
#pragma unroll
                        for (int n = 0; n < 2; ++n) { const int d0 = 32 * bj + 16 * n + 4 * fq; const f32x4 g4 = *(const f32x4*)(g + d0);
                            st_bf16x4(dst + d0, acc[ai][bj][m][n] * r * g4); }
                } else {
                    if (wc < 2) {
#pragma unroll
                        for (int n = 0; n < 2; ++n) { const int p0 = 32 * wc + 16 * n + 4 * fq;
                            if (p0 < 36) { const f32x4 v = acc[ai][0][m][n] * rs;
#pragma unroll
                                for (int e = 0; e < 4; ++e) gates[(size_t)row * 36 + p0 + e] = sigmoidf_(v[e] + gate_b[p0 + e]); } }
                    }
                }
            }
    }
};
struct EpiC {
    static constexpr bool PERM = false;
    float* part;
    DI void operator()(const Acc& acc, const Unit& u, int wr, int wc, int fr, int fq) const {
        const int row0 = u.pm * BM + wr * 64 + fr, col0 = wc * 32 + 4 * fq; float* pb = part + (size_t)(u.pn & 3) * 4096 * 256;
#pragma unroll
        for (int ai = 0; ai < 2; ++ai)
#pragma unroll
            for (int m = 0; m < 4; ++m) { float* rowp = pb + (size_t)(row0 + ai * HALF + m * 16) * 256 + col0;
#pragma unroll
                for (int bj = 0; bj < 2; ++bj)
#pragma unroll
                    for (int n = 0; n < 2; ++n) *(f32x4*)(rowp + bj * HALF + n * 16) = acc[ai][bj][m][n]; }
    }
};

constexpr size_t MiB = 1u << 20;
constexpr size_t WS_SS = 0;
constexpr size_t WS_BPART = 256 * 1024;
constexpr size_t WS_BIAS1 = 400 * 1024;
constexpr size_t WS_MK = 512 * 1024;
constexpr size_t WS_MVT = 768 * 1024;
constexpr size_t WS_KCMP = 1 * MiB;
constexpr size_t WS_VTCMP = 1 * MiB + 256 * 1024;
constexpr size_t WS_MEMB = 1 * MiB + 512 * 1024;
constexpr size_t WS_W = 8 * MiB;
constexpr size_t WS_WA = WS_W;
constexpr size_t WS_WO = WS_WA + 1792 * 1024 * 2;
constexpr size_t WS_W1 = WS_WO + 2 * 1024 * 1024 * 2;
constexpr size_t WS_W2 = WS_W1 + 2 * 4096 * 1024 * 2;
constexpr size_t WS_WB = WS_W2 + 2 * 4096 * 1024 * 2;
constexpr size_t WS_WM = WS_WB + 2048 * 1024 * 2;
constexpr size_t WS_W1C = WS_WM + 1024 * 1024 * 2;
constexpr size_t WS_W2C = WS_W1C + 512 * 2048 * 2;
constexpr size_t WS_WEND = WS_W2C + 2 * 64 * 256 * 2;
constexpr size_t WS_XB = 58 * MiB;
constexpr size_t WS_MIX = 90 * MiB;
constexpr size_t WS_HB = 122 * MiB;
constexpr size_t WS_END = 250 * MiB;
static_assert(WS_WEND <= WS_XB, "weights fit");
constexpr size_t WS_VGLU = WS_HB;
constexpr size_t WS_QM0 = WS_HB + 24 * MiB;
constexpr size_t WS_CBUF = WS_HB;
constexpr size_t WS_KSEL = WS_HB + 10 * MiB;
constexpr size_t WS_VTSEL = WS_HB + 14 * MiB;
constexpr size_t WS_KWIN = WS_HB + 18 * MiB;
constexpr size_t WS_VTWIN = WS_HB + 22 * MiB;
constexpr size_t WS_Q = WS_HB + 26 * MiB;
constexpr size_t WS_QM1 = WS_HB + 50 * MiB;
constexpr size_t WS_GATES = WS_HB + 58 * MiB;
constexpr size_t WS_IMP = WS_HB + 64 * MiB;
constexpr size_t WS_PART = WS_IMP;
constexpr size_t WS_OC = WS_HB + 96 * MiB;
constexpr size_t WS_CNT = 448 * 1024;

constexpr int LDS_BYTES = 147456;
constexpr int NWAVES = 8;

struct Params { const float* in[29]; float* out; unsigned char* ws; int ph_lo, ph_hi; };
enum { I_X = 0, I_MEM, I_NMIX, I_NMLP, I_MEMN, I_WMEMKV, I_MQG, I_MKG, I_WOUT, I_WMLPIN, I_WMLPOUT, I_AWIN, I_ABGLU, I_ADW, I_ADWB, I_ALNG, I_ALNB,
       I_BWIN, I_BGATEB, I_BQG, I_KVNG, I_WKV, I_KNG, I_PEK, I_PEV, I_W1K, I_W2K, I_W1V, I_W2V };

DI int hp(int p) { return 64 * ((p >> 5) & 3) + 32 * (p >> 7) + (p & 31); }
DI void tr_item(const float* __restrict__ W, int ldw, int src_col0, int nvalid, const float* __restrict__ gain, bf16* WT, int K, int dst_row0, int k0, LAS float* scr, int lane) {
    const int cc = lane & 31; const bool ok = cc < nvalid;
    const float* wp = W + (size_t)(k0 + (lane >> 5)) * ldw + src_col0 + (ok ? cc : 0);
    float v[32];
#pragma unroll
    for (int i = 0; i < 32; ++i) v[i] = __builtin_nontemporal_load(wp + (size_t)(2 * i) * ldw);
    const int c = lane & 7;
    f32x4 g0 = {1.f, 1.f, 1.f, 1.f}, g1 = {1.f, 1.f, 1.f, 1.f};
    if (gain) { g0 = *(const f32x4*)(gain + k0 + 8 * c); g1 = *(const f32x4*)(gain + k0 + 8 * c + 4); }
#pragma unroll
    for (int i = 0; i < 32; ++i) scr[(2 * i + (lane >> 5)) * 33 + cc] = ok ? v[i] : 0.f;
    LDS_WAIT();
#pragma unroll
    for (int j = 0; j < 4; ++j) { const int n = (lane >> 3) + 8 * j; const LAS float* s = scr + (8 * c) * 33 + n;
        u32x4 o; o.x = pk2(s[0 * 33] * g0[0], s[1 * 33] * g0[1]); o.y = pk2(s[2 * 33] * g0[2], s[3 * 33] * g0[3]); o.z = pk2(s[4 * 33] * g1[0], s[5 * 33] * g1[1]); o.w = pk2(s[6 * 33] * g1[2], s[7 * 33] * g1[3]);
        *(u32x4*)(WT + (size_t)(dst_row0 + n) * K + k0 + 8 * c) = o; }
    LDS_WAIT();
}
DI void rms_rows2_to_bf16(const float* xrow, bf16* orow, float* ssq, int lane) {
    const f32x4* xr = (const f32x4*)xrow + lane; f32x4 v[8]; float s0 = 0.f, s1 = 0.f;
#pragma unroll
    for (int j = 0; j < 8; ++j) v[j] = __builtin_nontemporal_load(xr + 64 * j);
#pragma unroll
    for (int j = 0; j < 4; ++j) { s0 += (v[j][0] * v[j][0] + v[j][1] * v[j][1]) + (v[j][2] * v[j][2] + v[j][3] * v[j][3]);
                                  s1 += (v[4 + j][0] * v[4 + j][0] + v[4 + j][1] * v[4 + j][1]) + (v[4 + j][2] * v[4 + j][2] + v[4 + j][3] * v[4 + j][3]); }
    s0 = wave_sum(s0); s1 = wave_sum(s1);
    float r0 = __builtin_amdgcn_rsqf(s0 * (1.0f / D) + EPS), r1 = __builtin_amdgcn_rsqf(s1 * (1.0f / D) + EPS);
    if (ssq) { if (lane == 0) { ssq[0] = s0; ssq[1] = s1; } r0 = 1.0f; r1 = 1.0f; }
    u32x2* o8 = (u32x2*)orow + lane;
#pragma unroll
    for (int j = 0; j < 8; ++j) { const float r = j < 4 ? r0 : r1; u32x2 w; w.x = pk2(v[j][0] * r, v[j][1] * r); w.y = pk2(v[j][2] * r, v[j][3] * r); o8[64 * j] = w; }
}
DI void p0_prologue(const Params& P, LAS unsigned char* lds, int gw, int NGW, int wave, int lane) {
    unsigned char* ws = P.ws;
    LAS float* scr = (LAS float*)(lds + wave * 16384);
    constexpr int NM = 11;
    const int rows[NM] = {1792, 1024, 1024, 4096, 4096, 1024, 1024, 2048, 1024, 512, 128};
    const int Ks[NM]   = {1024, 1024, 1024, 1024, 1024, 4096, 4096, 1024, 1024, 2048, 256};
    int total = 0;
#pragma unroll
    for (int m = 0; m < NM; ++m) total += (rows[m] / 32) * (Ks[m] / 64);
    for (int it = gw; it < total; it += NGW) {
        int r = it, m = 0;
#pragma unroll
        for (int mm = 0; mm < NM; ++mm) { const int cnt = (rows[mm] / 32) * (Ks[mm] / 64); if (m == mm && r >= cnt) { r -= cnt; m = mm + 1; } }
        int K = 1024, nkb = 16;
        if (m == 5 || m == 6) { K = 4096; nkb = 64; } else if (m == 9) { K = 2048; nkb = 32; } else if (m == 10) { K = 256; nkb = 4; }
        const int nb = r / nkb, kb = r % nkb, R0 = nb * 32, k0 = kb * 64;
        const float* W; int ldw, col, nvalid = 32; const float* gain = nullptr; bf16* WT;
        if (m == 0) { W = P.in[I_AWIN]; ldw = 1792; gain = P.in[I_NMIX]; WT = (bf16*)(ws + WS_WA);
            const int j = R0 >> 8, p = R0 & 255; col = j < 6 ? (p < 128 ? 128 * j + p : 768 + 128 * j + p - 128) : 1536 + hp(p); }
        else if (m <= 2) { W = P.in[I_WOUT] + (size_t)(m - 1) * D * D; ldw = D; col = R0; WT = (bf16*)(ws + WS_WO) + (size_t)(m - 1) * D * D; }
        else if (m <= 4) { W = P.in[I_WMLPIN] + (size_t)(m - 3) * D * FF; ldw = FF; col = R0; gain = P.in[I_NMLP] + (m - 3) * D; WT = (bf16*)(ws + WS_W1) + (size_t)(m - 3) * D * FF; }
        else if (m <= 6) { W = P.in[I_WMLPOUT] + (size_t)(m - 5) * D * FF; ldw = D; col = R0; WT = (bf16*)(ws + WS_W2) + (size_t)(m - 5) * D * FF; }
        else if (m == 7) { WT = (bf16*)(ws + WS_WB);
            if (R0 < 768) { W = P.in[I_WKV]; ldw = 768; col = (R0 & ~255) + hp(R0 & 255); gain = P.in[I_KVNG]; }
            else { const int uc = R0 - 768, uj = uc >> 8, p = uc & 255; W = P.in[I_BWIN]; ldw = 1060; gain = P.in[I_NMIX] + D; col = uj < 4 ? uj * 256 + hp(p) : 1024 + p;
                   nvalid = 1060 - col; nvalid = nvalid < 0 ? 0 : (nvalid > 32 ? 32 : nvalid); if (nvalid == 0) col = 0; } }
        else if (m == 8) { const int un = R0 >> 8, p = R0 & 255; W = P.in[I_WMEMKV] + (size_t)(un >> 1) * D * 512; ldw = 512; col = (un & 1) * 256 + hp(p); gain = P.in[I_MEMN]; WT = (bf16*)(ws + WS_WM); }
        else if (m == 9) { W = (R0 >> 8) ? P.in[I_W1V] : P.in[I_W1K]; ldw = 256; col = R0 & 255; WT = (bf16*)(ws + WS_W1C) + (size_t)((R0 >> 8) * 4 + (k0 >> 9)) * 256 * 512; }
        else { W = (R0 >> 6) ? P.in[I_W2V] : P.in[I_W2K]; ldw = 64; col = R0 & 63; WT = (bf16*)(ws + WS_W2C); }
        if (m == 9) tr_item(W + (size_t)(k0 & ~511) * ldw, ldw, col, nvalid, gain, WT, 512, R0 & 255, k0 & 511, scr, lane);
        else tr_item(W, ldw, col, nvalid, gain, WT, K, R0, k0, scr, lane);
    }
    for (int r2 = gw; r2 < (S + MEML) / 2; r2 += NGW) { const int r = 2 * r2;
        if (r < S) rms_rows2_to_bf16(P.in[I_X] + (size_t)r * D, (bf16*)(ws + WS_XB) + (size_t)r * D, (float*)(ws + WS_SS) + 3 * S + r, lane);
        else rms_rows2_to_bf16(P.in[I_MEM] + (size_t)(r - S) * D, (bf16*)(ws + WS_MEMB) + (size_t)(r - S) * D, nullptr, lane);
    }
    const int gt = gw * 64 + lane, NGT = NGW * 64;
    for (int i = gt; i < 3 * S; i += NGT) ((float*)(ws + WS_SS))[i] = 0.f;
    for (int i = gt; i < 2 * 64 * 256; i += NGT) { const int type = i >> 14, kc = (i >> 8) & 63, c = i & 255;
        const float* pe = P.in[type ? I_PEV : I_PEK] + kc * 32; const float* w1 = P.in[type ? I_W1V : I_W1K] + (size_t)kc * 32 * 256 + c; float s = 0.f;
#pragma unroll 8
        for (int k = 0; k < 32; ++k) s += pe[k] * w1[(size_t)k * 256];
        ((float*)(ws + WS_BPART))[i] = s; }
}

DI f32x16 mfma32(bf16x8 a, bf16x8 b, f32x16 c) { return __builtin_amdgcn_mfma_f32_32x32x16_bf16(a, b, c, 0, 0, 0); }
DI f32x4 mfma16(bf16x8 a, bf16x8 b, f32x4 c) { return __builtin_amdgcn_mfma_f32_16x16x32_bf16(a, b, c, 0, 0, 0); }
DI float gain_max(const float* g, int lane) { return wave_max(fabsf(g[lane])); }
DI void conv_task(const Params& P, int t0, int lane) {
    const bf16* vg = (const bf16*)(P.ws + WS_VGLU); const float* dw = P.in[I_ADW]; bf16* mix = (bf16*)(P.ws + WS_MIX);
    f32x4 acc[4][3];
#pragma unroll
    for (int i = 0; i < 3; ++i) { const f32x4 b = *(const f32x4*)(P.in[I_ADWB] + 4 * lane + 256 * i);
#pragma unroll
        for (int tt = 0; tt < 4; ++tt) acc[tt][i] = b; }
    f32x4 vr[4][3];
#define CONV_LDROW(dst, rr) do { _Pragma("unroll") for (int i = 0; i < 3; ++i) { u32x2 raw = *(const u32x2*)(vg + (size_t)((rr) >= 0 ? (rr) : 0) * 768 + 4 * lane + 256 * i); if ((rr) < 0) { raw.x = 0u; raw.y = 0u; } \
        dst[i] = (f32x4){__uint_as_float(raw.x << 16), __uint_as_float(raw.x & 0xffff0000u), __uint_as_float(raw.y << 16), __uint_as_float(raw.y & 0xffff0000u)}; } } while (0)
    CONV_LDROW(vr[0], t0 - 30); CONV_LDROW(vr[1], t0 - 29); CONV_LDROW(vr[2], t0 - 28);
#pragma unroll 8
    for (int j = 0; j < 31; ++j) {
        CONV_LDROW(vr[3], t0 - 27 + j);
        f32x4 w[3];
#pragma unroll
        for (int i = 0; i < 3; ++i) w[i] = *(const f32x4*)(dw + (size_t)j * 768 + 4 * lane + 256 * i);
#pragma unroll
        for (int tt = 0; tt < 4; ++tt)
#pragma unroll
            for (int i = 0; i < 3; ++i) acc[tt][i] += vr[tt][i] * w[i];
#pragma unroll
        for (int i = 0; i < 3; ++i) { vr[0][i] = vr[1][i]; vr[1][i] = vr[2][i]; vr[2][i] = vr[3][i]; }
    }
#undef CONV_LDROW
    f32x4 lg[3], lb[3];
#pragma unroll
    for (int i = 0; i < 3; ++i) { lg[i] = *(const f32x4*)(P.in[I_ALNG] + 4 * lane + 256 * i); lb[i] = *(const f32x4*)(P.in[I_ALNB] + 4 * lane + 256 * i); }
#pragma unroll
    for (int tt = 0; tt < 4; ++tt) {
        float s = 0.f;
#pragma unroll
        for (int i = 0; i < 3; ++i) s += (acc[tt][i][0] + acc[tt][i][1]) + (acc[tt][i][2] + acc[tt][i][3]);
        const float mean = wave_sum(s) * (1.0f / 768.0f); float q = 0.f;
#pragma unroll
        for (int i = 0; i < 3; ++i) { const f32x4 d = acc[tt][i] - mean; q += (d[0] * d[0] + d[1] * d[1]) + (d[2] * d[2] + d[3] * d[3]); }
        const float rstd = __builtin_amdgcn_rsqf(wave_sum(q) * (1.0f / 768.0f) + 1e-5f);
#pragma unroll
        for (int i = 0; i < 3; ++i) { f32x4 y = (acc[tt][i] - mean) * rstd * lg[i] + lb[i];
#pragma unroll
            for (int e = 0; e < 4; ++e) y[e] = y[e] * sigmoidf_(y[e]);
            st_bf16x4(mix + (size_t)(t0 + tt) * D + 4 * lane + 256 * i, y); }
    }
}

DI void cmp2_task(const Params& P, int task, int lane) {
    const int r = lane & 31, h = lane >> 5; const int row0 = task * 32; const int type = row0 >> 11, g = (row0 >> 10) & 1, n0 = row0 & 1023;
    const float* part = (const float*)(P.ws + WS_PART) + (size_t)(row0 + r) * 256 + 8 * h; const float* bb = (const float*)(P.ws + WS_BIAS1) + type * 256 + 8 * h;
    const bf16* w2 = (const bf16*)(P.ws + WS_W2C) + (size_t)type * 64 * 256;
    f32x16 O0, O1;
#pragma unroll
    for (int i = 0; i < 16; ++i) { O0[i] = 0.f; O1[i] = 0.f; }
#pragma unroll 4
    for (int s = 0; s < 16; ++s) {
        f32x4 a0 = *(const f32x4*)(bb + 16 * s), a1 = *(const f32x4*)(bb + 16 * s + 4);
#pragma unroll
        for (int kc = 0; kc < 4; ++kc) { a0 += *(const f32x4*)(part + (size_t)kc * 4096 * 256 + 16 * s); a1 += *(const f32x4*)(part + (size_t)kc * 4096 * 256 + 16 * s + 4); }
#pragma unroll
        for (int e = 0; e < 4; ++e) { float x = a0[e]; a0[e] = x * sigmoidf_(1.5957691216f * (x + 0.044715f * x * x * x)); x = a1[e]; a1[e] = x * sigmoidf_(1.5957691216f * (x + 0.044715f * x * x * x)); }
        u32x4 hw; hw.x = pk2(a0[0], a0[1]); hw.y = pk2(a0[2], a0[3]); hw.z = pk2(a1[0], a1[1]); hw.w = pk2(a1[2], a1[3]);
        const bf16x8 hb = __builtin_bit_cast(bf16x8, hw);
        O0 = mfma32(*(const bf16x8*)(w2 + (size_t)r * 256 + 16 * s + 8 * h), hb, O0);
        O1 = mfma32(*(const bf16x8*)(w2 + (size_t)(32 + r) * 256 + 16 * s + 8 * h), hb, O1);
    }
    if (type == 0) {
        float s = 0.f;
#pragma unroll
        for (int i = 0; i < 16; ++i) s += O0[i] * O0[i] + O1[i] * O1[i];
        s += __shfl_xor(s, 32);
        const float rs = __builtin_amdgcn_rsqf(s * (1.0f / 64.0f) + EPS);
        const int nk = n0 + r; bf16* kp = (bf16*)(P.ws + WS_KCMP) + ((size_t)g * 16 + (nk >> 6)) * 4096; const float* kg = P.in[I_KNG] + 4 * h;
#pragma unroll
        for (int q4 = 0; q4 < 4; ++q4) {
            const f32x4 g0 = *(const f32x4*)(kg + 8 * q4), g1 = *(const f32x4*)(kg + 32 + 8 * q4);
            st_bf16x4(kp + kimg(nk & 63, 4 * h + 8 * q4), (f32x4){O0[4 * q4], O0[4 * q4 + 1], O0[4 * q4 + 2], O0[4 * q4 + 3]} * rs * g0);
            st_bf16x4(kp + kimg(nk & 63, 32 + 4 * h + 8 * q4), (f32x4){O1[4 * q4], O1[4 * q4 + 1], O1[4 * q4 + 2], O1[4 * q4 + 3]} * rs * g1);
        }
    } else {
        const int nn = n0 + r; bf16* vp = (bf16*)(P.ws + WS_VTCMP) + ((size_t)g * 16 + (nn >> 6)) * 4096;
#pragma unroll
        for (int i = 0; i < 16; ++i) { const int c = (i & 3) + 8 * (i >> 2) + 4 * h;
            vp[vimg(c, nn & 63)] = (bf16)(pk2(O0[i], 0.f) & 0xffffu); vp[vimg(c + 32, nn & 63)] = (bf16)(pk2(O1[i], 0.f) & 0xffffu); }
    }
}

struct KV32 { bf16x8 k[4]; s16x4 v[8]; };
DI void kv32_load(KV32& d, const bf16* Kb, const bf16* VT, int key0, int r, int h) {
    const int ln = h * 32 + r; const size_t blk = (size_t)(key0 >> 6) * 4096; const int sub = (key0 >> 5) & 1;
    const bf16* kp = Kb + blk + sub * 2048 + ln * 8;
#pragma unroll
    for (int s = 0; s < 4; ++s) d.k[s] = *(const bf16x8*)(kp + s * 512);
    const bf16* vp = VT + blk + sub * 2048 + ln * 8;
#pragma unroll
    for (int i = 0; i < 4; ++i) { const bf16x8 w = *(const bf16x8*)(vp + i * 512); d.v[2 * i] = __builtin_shufflevector(w, w, 0, 1, 2, 3); d.v[2 * i + 1] = __builtin_shufflevector(w, w, 4, 5, 6, 7); }
}
DI float opaque_zero() { float z; asm volatile("v_mov_b32 %0, 0" : "=v"(z)); return z; }
DI f32x16 tile_qk(const KV32& d, const bf16x8 (&qf)[4], float c0) {
    f32x16 sc; const float c = c0 + opaque_zero();
#pragma unroll
    for (int i = 0; i < 16; ++i) sc[i] = c;
#pragma unroll
    for (int s = 0; s < 4; ++s) sc = mfma32(d.k[s], qf[s], sc);
    return sc;
}
DI void tile_pv(const KV32& d, const float (&p)[16], f32x16& O0, f32x16& O1) {
#pragma unroll
    for (int s2 = 0; s2 < 2; ++s2) {
        u32x4 pw; pw.x = pk2(p[8 * s2], p[8 * s2 + 1]); pw.y = pk2(p[8 * s2 + 2], p[8 * s2 + 3]); pw.z = pk2(p[8 * s2 + 4], p[8 * s2 + 5]); pw.w = pk2(p[8 * s2 + 6], p[8 * s2 + 7]);
        const bf16x8 pb = __builtin_bit_cast(bf16x8, pw);
        O0 = mfma32(__builtin_shufflevector(d.v[(s2 * 2) * 2], d.v[(s2 * 2) * 2 + 1], 0, 1, 2, 3, 4, 5, 6, 7), pb, O0);
        O1 = mfma32(__builtin_shufflevector(d.v[(s2 * 2 + 1) * 2], d.v[(s2 * 2 + 1) * 2 + 1], 0, 1, 2, 3, 4, 5, 6, 7), pb, O1);
    }
}
DI void tile_store(bf16* op, const f32x16& O0, const f32x16& O1, float sc) {
#pragma unroll
    for (int q4 = 0; q4 < 4; ++q4) {
        st_bf16x4(op + 8 * q4, (f32x4){O0[4 * q4], O0[4 * q4 + 1], O0[4 * q4 + 2], O0[4 * q4 + 3]} * sc);
        st_bf16x4(op + 32 + 8 * q4, (f32x4){O1[4 * q4], O1[4 * q4 + 1], O1[4 * q4 + 2], O1[4 * q4 + 3]} * sc);
    }
}
DI void mem_attn_task(const bf16* Qm, const bf16* mk, const bf16* mvT, bf16* mix, int t0, int head, float Bq, int lane) {
    const int r = lane & 31, h = lane >> 5;
    bf16x8 qf[4];
#pragma unroll
    for (int s = 0; s < 4; ++s) qf[s] = *(const bf16x8*)(Qm + (size_t)(t0 + r) * 256 + head * 64 + 16 * s + 8 * h);
    const bf16* Kb = mk + (size_t)head * 4 * 4096; const bf16* Vb = mvT + (size_t)head * 4 * 4096;
    f32x16 O0, O1; float l = 0.f;
#pragma unroll
    for (int i = 0; i < 16; ++i) { O0[i] = 0.f; O1[i] = 0.f; }
    KV32 A, B, C;
#define MA_STEP(BUF, st) do { if ((st) < nst) { const f32x16 sc = tile_qk(BUF, qf, -Bq); float p[16]; \
        _Pragma("unroll") for (int i = 0; i < 16; ++i) { p[i] = __builtin_amdgcn_exp2f(sc[i]); l += p[i]; } \
        tile_pv(BUF, p, O0, O1); } { const int _s = (st) + 3 < nst ? (st) + 3 : nst - 1; kv32_load(BUF, Kb, Vb, 32 * _s, r, h); } } while (0)
    const int nst = 8;
    kv32_load(A, Kb, Vb, 0, r, h); kv32_load(B, Kb, Vb, 32, r, h); kv32_load(C, Kb, Vb, 64, r, h);
#pragma unroll 1
    for (int st = 0; st < nst; st += 3) { MA_STEP(A, st); MA_STEP(B, st + 1); MA_STEP(C, st + 2); }
#undef MA_STEP
    l += __shfl_xor(l, 32);
    tile_store(mix + (size_t)(t0 + r) * D + 768 + head * 64 + 4 * h, O0, O1, 1.0f / l);
}
DI void mem_attn_phase(const Params& P, int layer, const bf16* Qm, int gw, int NGW, int lane) {
    if (gw < 0) return;
    const bf16* mk = (const bf16*)(P.ws + WS_MK) + (size_t)layer * 4 * 256 * 64; const bf16* mvT = (const bf16*)(P.ws + WS_MVT) + (size_t)layer * 4 * 64 * 256;
    const float Bq = BNDC * gain_max(P.in[I_MQG] + layer * 64, lane) * gain_max(P.in[I_MKG] + layer * 64, lane) * 1.02f;
    for (int task = gw; task < (S / 32) * 4; task += NGW) mem_attn_task(Qm, mk, mvT, (bf16*)(P.ws + WS_MIX), (task >> 2) * 32, task & 3, Bq, lane);
}

DI void cmp_tile_task(const Params& P, int qt, int g, float Bc, LAS float* wl, LAS bf16x8* qL, int lane) {
    unsigned char* ws = P.ws;
    const int r = lane & 31, h = lane >> 5, t = 32 * qt + r;
    const int nv = t >= 31 ? ((t - 31) >> 4) + 1 : 0;
    const int tl = 32 * qt + 31, nvmax = tl >= 31 ? ((tl - 31) >> 4) + 1 : 0, nsteps = (nvmax + 31) >> 5;
    const int tf = 32 * qt, nvmin = tf >= 31 ? ((tf - 31) >> 4) + 1 : 0;
    const bf16* Kc = (const bf16*)(ws + WS_KCMP) + (size_t)g * 1024 * 64; const bf16* Vc = (const bf16*)(ws + WS_VTCMP) + (size_t)g * 64 * 1024;
    const bf16* qrow = (const bf16*)(ws + WS_Q) + (size_t)t * 768 + g * 384 + 8 * h;
    bf16* oc = (bf16*)(ws + WS_OC) + (size_t)t * 768 + g * 384 + 4 * h;
    const float* gp = (const float*)(ws + WS_GATES) + (size_t)t * 36 + g * 18;
    for (int hh = 0; hh < 6; ++hh) {
        bf16x8 qf[4];
#pragma unroll
        for (int s = 0; s < 4; ++s) qf[s] = *(const bf16x8*)(qrow + hh * 64 + 16 * s);
        f32x16 O0, O1; float l = 0.f;
#pragma unroll
        for (int i = 0; i < 16; ++i) { O0[i] = 0.f; O1[i] = 0.f; }
        KV32 A, B, C;
#define CA_LD(BUF, st) do { const int _s = (st) < nsteps ? (st) : nsteps - 1; kv32_load(BUF, Kc, Vc, 32 * _s, r, h); } while (0)
#define CA_STEP(BUF, st) do { if ((st) < nsteps) { const f32x16 sc = tile_qk(BUF, qf, -Bc); float p[16]; \
        if (32 * (st) + 32 <= nvmin) { _Pragma("unroll") for (int i = 0; i < 16; ++i) { p[i] = __builtin_amdgcn_exp2f(sc[i]); l += p[i]; } } \
        else { _Pragma("unroll") for (int i = 0; i < 16; ++i) { const int key = 32 * (st) + (i & 3) + 8 * (i >> 2) + 4 * h; p[i] = key < nv ? __builtin_amdgcn_exp2f(sc[i]) : 0.f; l += p[i]; } } \
        tile_pv(BUF, p, O0, O1); } CA_LD(BUF, (st) + 3); } while (0)
        if (nsteps > 0) {
        CA_LD(A, 0); CA_LD(B, 1); CA_LD(C, 2);
        for (int st = 0; st < nsteps; st += 3) { CA_STEP(A, st); CA_STEP(B, st + 1); CA_STEP(C, st + 2); }
        }
#undef CA_LD
#undef CA_STEP
        l += __shfl_xor(l, 32);
        const float inv = l > 0.f ? 1.0f / l : 0.f;
        wl[hh * 32 + r] = inv;
        tile_store(oc + hh * 64, O0, O1, inv * gp[hh * 3]);
    }
    LDS_WAIT();
    float* impr = (float*)(ws + WS_IMP) + ((size_t)t * 2 + g) * 256 + h;
    bf16x8 q3[3][4]; float inv6[6];
#pragma unroll
    for (int hh = 0; hh < 6; ++hh) { const float iv = wl[hh * 32 + r]; inv6[hh] = iv > 0.f ? __builtin_amdgcn_logf(iv) - Bc : -1e30f; }
#pragma unroll
    for (int hh = 0; hh < 3; ++hh)
#pragma unroll
        for (int s = 0; s < 4; ++s) { q3[hh][s] = *(const bf16x8*)(qrow + hh * 64 + 16 * s); qL[(hh * 4 + s) * 64] = *(const bf16x8*)(qrow + (3 + hh) * 64 + 16 * s); }
    LDS_WAIT();
    float carry = 0.f;
    bf16x8 kf[4], kn[4];
    { const bf16* kp = Kc + (h * 32 + r) * 8;
#pragma unroll
      for (int s = 0; s < 4; ++s) kf[s] = *(const bf16x8*)(kp + s * 512); }
    for (int st = 0; st < nsteps; ++st) {
        { const int sn = st + 1 < nsteps ? st + 1 : st; const bf16* kp = Kc + (size_t)(sn >> 1) * 4096 + (sn & 1) * 2048 + (h * 32 + r) * 8;
#pragma unroll
            for (int s = 0; s < 4; ++s) kn[s] = *(const bf16x8*)(kp + s * 512); }
        asm volatile("" ::: "memory");
        float Ps[16];
#pragma unroll
        for (int i = 0; i < 16; ++i) Ps[i] = 0.f;
#pragma unroll
        for (int hh = 0; hh < 6; ++hh) {
            f32x16 sc; const float c = inv6[hh] + opaque_zero();
#pragma unroll
            for (int i = 0; i < 16; ++i) sc[i] = c;
            if (hh < 3) {
#pragma unroll
                for (int s = 0; s < 4; ++s) sc = mfma32(kf[s], q3[hh][s], sc);
            } else {
#pragma unroll
                for (int s = 0; s < 4; ++s) sc = mfma32(kf[s], qL[((hh - 3) * 4 + s) * 64], sc);
            }
            if (32 * st + 32 <= nvmin) {
#pragma unroll
                for (int i = 0; i < 16; ++i) Ps[i] += __builtin_amdgcn_exp2f(sc[i]);
            } else {
#pragma unroll
                for (int i = 0; i < 16; ++i) { const int key = 32 * st + (i & 3) + 8 * (i >> 2) + 4 * h; Ps[i] += key < nv ? __builtin_amdgcn_exp2f(sc[i]) : 0.f; }
            }
        }
        float y[4], val[4];
#pragma unroll
        for (int q4 = 0; q4 < 4; ++q4) { y[q4] = __shfl_xor(Ps[4 * q4 + 3], 32); val[q4] = 2.0f * (Ps[4 * q4] + Ps[4 * q4 + 1] + Ps[4 * q4 + 2]) + Ps[4 * q4 + 3]; }
        if (h == 1) {
#pragma unroll
            for (int q4 = 0; q4 < 4; ++q4) val[q4] += y[q4];
        } else { val[0] += carry; val[1] += y[0]; val[2] += y[1]; val[3] += y[2]; }
        carry = y[3];
#pragma unroll
        for (int q4 = 0; q4 < 4; ++q4) impr[8 * st + 2 * q4] = val[q4];
#pragma unroll
        for (int s = 0; s < 4; ++s) kf[s] = kn[s];
    }
    LDS_WAIT();
}
DI void win_tile_task(const Params& P, int qt, int head, float Bw, int lane) {
    unsigned char* ws = P.ws;
    const int r = lane & 31, h = lane >> 5, t0 = 32 * qt, t = t0 + r, g = head / 6;
    const bf16* Kw = (const bf16*)(ws + WS_KWIN) + (size_t)g * S * 64; const bf16* Vw = (const bf16*)(ws + WS_VTWIN) + (size_t)g * 64 * S;
    const int kstart = t0 >= 512 ? t0 - 512 : 0, nsteps = (t0 + 32 - kstart) >> 5;
    bf16x8 qf[4];
#pragma unroll
    for (int s = 0; s < 4; ++s) qf[s] = *(const bf16x8*)((const bf16*)(ws + WS_Q) + (size_t)t * 768 + head * 64 + 16 * s + 8 * h);
    f32x16 O0, O1; float l = 0.f;
#pragma unroll
    for (int i = 0; i < 16; ++i) { O0[i] = 0.f; O1[i] = 0.f; }
    KV32 cur, nxt;
    kv32_load(cur, Kw, Vw, kstart, r, h);
    for (int st = 0; st < nsteps; ++st) {
        { const int sn = st + 1 < nsteps ? st + 1 : st; kv32_load(nxt, Kw, Vw, kstart + 32 * sn, r, h); }
        const f32x16 sc = tile_qk(cur, qf, -Bw); float p[16];
        if (st > 0 && st + 1 < nsteps) {
#pragma unroll
            for (int i = 0; i < 16; ++i) { p[i] = __builtin_amdgcn_exp2f(sc[i]); l += p[i]; }
        } else {
#pragma unroll
            for (int i = 0; i < 16; ++i) { const int kp = kstart + 32 * st + (i & 3) + 8 * (i >> 2) + 4 * h; p[i] = (kp <= t && kp > t - 512) ? __builtin_amdgcn_exp2f(sc[i]) : 0.f; l += p[i]; }
        }
        tile_pv(cur, p, O0, O1);
        cur = nxt;
    }
    l += __shfl_xor(l, 32);
    const float g2 = ((const float*)(ws + WS_GATES))[(size_t)t * 36 + head * 3 + 2];
    tile_store((bf16*)P.out + (size_t)t * 768 + head * 64 + 4 * h, O0, O1, l > 0.f ? g2 / l : 0.f);
}

DI void sel_sub(const KV32& X, int key0, unsigned mb, const bf16x8 (&qa)[4], const LAS bf16x8* qbl, int kl, int tqa, int tqb, float Bs,
                f32x16& Oa0, f32x16& Oa1, f32x16& Ob0, f32x16& Ob1, float& la, float& lb, int h) {
    if (mb & 15u) {
        const bool vr = kl < 4 && ((mb >> kl) & 1u);
        const f32x16 sc = tile_qk(X, qa, vr ? -Bs : -1e30f); float p[16];
#pragma unroll
        for (int i = 0; i < 16; ++i) { const int key = key0 + (i & 3) + 8 * (i >> 2) + 4 * h; p[i] = key <= tqa ? __builtin_amdgcn_exp2f(sc[i]) : 0.f; la += p[i]; }
        tile_pv(X, p, Oa0, Oa1);
    }
    if (mb >> 4) {
        const bool vr = kl < 4 && ((mb >> (4 + kl)) & 1u);
        bf16x8 qb[4];
#pragma unroll
        for (int s = 0; s < 4; ++s) qb[s] = qbl[s * 64];
        const f32x16 sc = tile_qk(X, qb, vr ? -Bs : -1e30f); float p[16];
#pragma unroll
        for (int i = 0; i < 16; ++i) { const int key = key0 + (i & 3) + 8 * (i >> 2) + 4 * h; p[i] = key <= tqb ? __builtin_amdgcn_exp2f(sc[i]) : 0.f; lb += p[i]; }
        tile_pv(X, p, Ob0, Ob1);
    }
}
DI void sel_out(const Params& P, const f32x16& O0, const f32x16& O1, float l, int t, int head, int h) {
    unsigned char* ws = P.ws;
    l += __shfl_xor(l, 32);
    const float g1 = ((const float*)(ws + WS_GATES))[(size_t)t * 36 + head * 3 + 1];
    const float sc = l > 0.f ? g1 / l : 0.f;
    const size_t off = (size_t)t * 768 + head * 64 + 4 * h;
    bf16* op = (bf16*)(ws + WS_MIX) + (size_t)t * D + head * 64 + 4 * h;
    const bf16* oc = (const bf16*)(ws + WS_OC) + off; const bf16* ow = (const bf16*)P.out + off;
#pragma unroll
    for (int q4 = 0; q4 < 4; ++q4) {
        st_bf16x4(op + 8 * q4, (f32x4){O0[4 * q4], O0[4 * q4 + 1], O0[4 * q4 + 2], O0[4 * q4 + 3]} * sc + ld_bf16x4(oc + 8 * q4) + ld_bf16x4(ow + 8 * q4));
        st_bf16x4(op + 32 + 8 * q4, (f32x4){O1[4 * q4], O1[4 * q4 + 1], O1[4 * q4 + 2], O1[4 * q4 + 3]} * sc + ld_bf16x4(oc + 32 + 8 * q4) + ld_bf16x4(ow + 32 + 8 * q4));
    }
}
DI void sel_unit(const Params& P, int tb, int g, float Bs, LAS unsigned char* lds, int tid, int wave, int lane) {
    unsigned char* ws = P.ws;
    LAS unsigned* mask = (LAS unsigned*)lds;
    mask[tid] = 0u;
    __syncthreads();
    if (tb <= 15) { if (tid <= tb) { mask[2 * tid] = 0xffffffffu; mask[2 * tid + 1] = 0xffffffffu; } }
    else {
        if (tid < 3) { const int j = tid == 0 ? 0 : (tid == 1 ? tb - 1 : tb); mask[2 * j] = 0xffffffffu; mask[2 * j + 1] = 0xffffffffu; }
        for (int k = 0; k < 8; ++k) {
            const int q = wave * 8 + k, t = 64 * tb + q;
            const f32x4 a = *(const f32x4*)((const float*)(ws + WS_IMP) + ((size_t)t * 2 + g) * 256 + 4 * lane);
            unsigned key[4];
#pragma unroll
            for (int e = 0; e < 4; ++e) { const int j = 4 * lane + e; key[e] = (j >= 1 && j <= tb - 2) ? __float_as_uint(a[e]) + 1u : 0u; }
            for (int it = 0; it < 13; ++it) {
                unsigned m = key[0] > key[1] ? key[0] : key[1]; const unsigned m2 = key[2] > key[3] ? key[2] : key[3]; m = m > m2 ? m : m2;
                const unsigned wm = wave_max_u32(m);
                const unsigned long long bal = __ballot(m == wm);
                const int src = __ffsll((long long)bal) - 1;
                if (lane == src) {
                    const int e = key[0] == wm ? 0 : (key[1] == wm ? 1 : (key[2] == wm ? 2 : 3));
                    __hip_atomic_fetch_or(mask + 2 * (4 * lane + e) + (q >> 5), 1u << (q & 31), __ATOMIC_RELAXED, __HIP_MEMORY_SCOPE_WORKGROUP);
                    key[0] = e == 0 ? 0u : key[0]; key[1] = e == 1 ? 0u : key[1]; key[2] = e == 2 ? 0u : key[2]; key[3] = e == 3 ? 0u : key[3];
                }
            }
        }
    }
    __syncthreads();
    const int r = lane & 31, h = lane >> 5;
    const int kl = (r * 43) >> 8, hd = r - 6 * kl, klc = kl < 4 ? kl : 0;
    const int tqa = 64 * tb + wave * 8 + klc, tqb = tqa + 4, head = g * 6 + (kl < 4 ? hd : 0);
    const bf16* Ks = (const bf16*)(ws + WS_KSEL) + (size_t)g * S * 64; const bf16* Vs = (const bf16*)(ws + WS_VTSEL) + (size_t)g * 64 * S;
    bf16x8 qa[4]; LAS bf16x8* qb = (LAS bf16x8*)(lds + 16384 + wave * 4096) + lane;
#pragma unroll
    for (int s = 0; s < 4; ++s) { qa[s] = *(const bf16x8*)((const bf16*)(ws + WS_Q) + (size_t)tqa * 768 + head * 64 + 16 * s + 8 * h);
                                  qb[s * 64] = *(const bf16x8*)((const bf16*)(ws + WS_Q) + (size_t)tqb * 768 + head * 64 + 16 * s + 8 * h); }
    LDS_WAIT();
    f32x16 Oa0, Oa1, Ob0, Ob1; float la = 0.f, lb = 0.f;
#pragma unroll
    for (int i = 0; i < 16; ++i) { Oa0[i] = 0.f; Oa1[i] = 0.f; Ob0[i] = 0.f; Ob1[i] = 0.f; }
    LAS unsigned short* wlist = (LAS unsigned short*)(lds + 2048 + wave * 512);
    int n = 0;
#pragma unroll
    for (int i = 0; i < 4; ++i) { const int jj = 64 * i + lane; unsigned bb = 0u;
        if (jj <= tb) bb = (mask[2 * jj + (wave >> 2)] >> (8 * (wave & 3))) & 0xffu;
        const unsigned long long bal = __ballot(bb != 0u); const int pos = n + __popcll(bal & ((1ull << lane) - 1ull));
        if (bb) wlist[pos] = (unsigned short)(jj | (bb << 8));
        n += __popcll(bal); }
    const int n2 = 2 * __builtin_amdgcn_readfirstlane(n);
    LDS_WAIT();
    KV32 A, B, C;
#define SEL_LD(BUF, pos) do { const int _pp = (pos) < n2 ? (pos) : n2 - 1; const int _e = __builtin_amdgcn_readfirstlane((int)wlist[_pp >> 1]); kv32_load(BUF, Ks, Vs, 64 * (_e & 255) + 32 * (_pp & 1), r, h); } while (0)
#define SEL_STEP(BUF, pos) do { if ((pos) < n2) { const int _e = __builtin_amdgcn_readfirstlane((int)wlist[(pos) >> 1]); \
        sel_sub(BUF, 64 * (_e & 255) + 32 * ((pos) & 1), (unsigned)_e >> 8, qa, qb, kl, tqa, tqb, Bs, Oa0, Oa1, Ob0, Ob1, la, lb, h); } SEL_LD(BUF, (pos) + 3); } while (0)
    if (n2 > 0) {
        SEL_LD(A, 0); SEL_LD(B, 1); SEL_LD(C, 2);
        for (int p = 0; p < n2; p += 3) { SEL_STEP(A, p); SEL_STEP(B, p + 1); SEL_STEP(C, p + 2); }
    }
#undef SEL_LD
#undef SEL_STEP
    if (kl < 4) { sel_out(P, Oa0, Oa1, la, tqa, head, h); sel_out(P, Ob0, Ob1, lb, tqb, head, h); }
    __syncthreads();
}

#define XB_TMO      128
#define XB_XCNT(j)  (256  + 64 * (j))
#define XB_XSUB(j)  (1280 + 64 * (j))
#define XB_XGEN(j)  (2304 + 64 * (j))
#define XB_TOP      3328
#define XB_TOPGEN   3392
#define XCD_BAR_WORDS 3456
#define XB_SPIN_CAP (1u << 18)

__device__ __forceinline__ unsigned xb_ld(unsigned* p)              { return __hip_atomic_load(p, __ATOMIC_RELAXED, __HIP_MEMORY_SCOPE_AGENT); }
__device__ __forceinline__ unsigned xb_add(unsigned* p, unsigned v) { return __hip_atomic_fetch_add(p, v, __ATOMIC_RELAXED, __HIP_MEMORY_SCOPE_AGENT); }
__device__ __forceinline__ unsigned xb_xcc_id() { return (unsigned)__builtin_amdgcn_s_getreg((3 << 11) | 20) & 0xFu; }
#define XB_SPIN(cond, bar) do { unsigned _sp = 0; while (cond) { __builtin_amdgcn_s_sleep(1); \
    if ((++_sp & 255u) == 0u) { if (xb_ld(&(bar)[XB_TMO])) break; if (_sp > XB_SPIN_CAP) { atomicAdd(&(bar)[XB_TMO], 1u); break; } } } } while (0)

struct XcdBarrier {
    unsigned* bar; unsigned x;
    volatile LAS unsigned* st;
};

__device__ __forceinline__ XcdBarrier xcd_barrier_post(unsigned* bar, volatile LAS unsigned* st) {
    XcdBarrier b; b.bar = bar; b.x = xb_xcc_id(); b.st = st;
    if (threadIdx.x == 0) (void)xb_add(&bar[XB_XCNT(b.x)], 1u);
    return b;
}
__device__ __forceinline__ void xcd_barrier_complete(unsigned* bar, unsigned x, unsigned& nloc, unsigned& nx) {
    const unsigned G = gridDim.x * gridDim.y * gridDim.z;
    unsigned sum, cnt, mine, sp = 0u;
    for (;;) {
        sum = 0u; cnt = 0u; mine = 0u;
#pragma unroll
        for (unsigned j = 0; j < 16; ++j) { const unsigned c = xb_ld(&bar[XB_XCNT(j)]); sum += c; cnt += (c > 0u) ? 1u : 0u; mine = (j == x) ? c : mine; }
        if (sum == G) break;
        __builtin_amdgcn_s_sleep(1);
        if ((++sp & 255u) == 0u) { if (xb_ld(&bar[XB_TMO])) break; if (sp > XB_SPIN_CAP) { atomicAdd(&bar[XB_TMO], 1u); break; } }
    }
    nloc = mine > 0u ? mine : 1u; nx = cnt > 0u ? cnt : 1u;
}

__device__ __forceinline__ void xcd_barrier(const XcdBarrier& b) {
    asm volatile("s_waitcnt vmcnt(0)" ::: "memory");
    __syncthreads();
    if (threadIdx.x == 0) {
        unsigned* bar = b.bar;
        __builtin_amdgcn_s_waitcnt(0);
        unsigned nloc = b.st[0], nx = b.st[1];
        if (nloc == 0u) { xcd_barrier_complete(bar, b.x, nloc, nx); b.st[0] = nloc; b.st[1] = nx; }
        const unsigned old = xb_add(&bar[XB_XSUB(b.x)], 1u);
        const unsigned gen = old / nloc;
        if (old + 1u == (gen + 1u) * nloc) {
            __builtin_amdgcn_fence(__ATOMIC_RELEASE, "agent");
            asm volatile("s_waitcnt vmcnt(0)" ::: "memory");
            const unsigned og = xb_add(&bar[XB_TOP], 1u);
            const unsigned tg = og / nx;
            if (og + 1u == (tg + 1u) * nx) xb_add(&bar[XB_TOPGEN], 1u);
            else XB_SPIN(xb_ld(&bar[XB_TOPGEN]) == tg, bar);
            __builtin_amdgcn_fence(__ATOMIC_ACQUIRE, "agent");
            xb_add(&bar[XB_XGEN(b.x)], 1u);
            asm volatile("s_waitcnt vmcnt(0)" ::: "memory");
        } else {
            XB_SPIN(xb_ld(&bar[XB_XGEN(b.x)]) == gen, bar);
            __builtin_amdgcn_fence(__ATOMIC_ACQUIRE, "agent");
            asm volatile("s_waitcnt vmcnt(0)" ::: "memory");
        }
    }
    __syncthreads();
}

__global__ void __launch_bounds__(NWAVES * 64, 2) yoco_fwd(Params P) {
    extern __shared__ __attribute__((aligned(16))) unsigned char lds_raw[];
    LAS unsigned char* lds = (LAS unsigned char*)lds_raw;
    const int tid = threadIdx.x, lane = tid & 63, wave = __builtin_amdgcn_readfirstlane(tid >> 6);
    const int G = gridDim.x, bx = blockIdx.x;
    const int gw = bx * NWAVES + wave, NGW = G * NWAVES;
    unsigned char* ws = P.ws;
    const int lo = P.ph_lo, hi = P.ph_hi;
#ifndef PH_MASK
#define PH_MASK 0x3fff
#endif
#define IN(k) (((PH_MASK >> (k)) & 1) && lo <= (k) && (k) < hi)
    volatile LAS unsigned* xst = (volatile LAS unsigned*)(lds + LDS_BYTES - 64);
    if (tid < 2) xst[tid] = 0u;
    __syncthreads();
    const XcdBarrier xbar = xcd_barrier_post((unsigned*)(ws + WS_CNT) + 1024, xst);
#define SEAM(k) do { if (IN(k) && IN((k) + 1)) { { xcd_barrier(xbar); } } } while (0)
    float* ss1 = (float*)(ws + WS_SS); float* ss2 = ss1 + S; float* ss3 = ss2 + S;
    bf16* xb = (bf16*)(ws + WS_XB); bf16* mix = (bf16*)(ws + WS_MIX); bf16* hb = (bf16*)(ws + WS_HB);

    if (IN(0)) { p0_prologue(P, lds, gw, NGW, wave, lane); __syncthreads(); }
    SEAM(0);
    if (IN(1)) {
        { pg8::Gemm g{xb, (const bf16*)(ws + WS_WA), S, 1792, D, D}; pg8::StaticOrder So; So.init(S, 1792, G, bx);
          EpiA E{(bf16*)(ws + WS_VGLU), (bf16*)(ws + WS_QM0), P.in[I_ABGLU], P.in[I_MQG], ss1 + 3 * S};
          pg8::gemm_phase<EpiA, pg8::StaticOrder, true>(lds, g, So, E); }
        { pg8::Gemm g{(const bf16*)(ws + WS_MEMB), (const bf16*)(ws + WS_WM), 256, 1024, D, D};
          const int c = G >= 4 ? bx - (G - 4) : bx; pg8::ListOrder So{4, 4, G >= 4 ? 4 : G, c, 0};
          EpiMem E{(bf16*)(ws + WS_MK), (bf16*)(ws + WS_MVT), P.in[I_MKG]};
          pg8::gemm_phase<EpiMem, pg8::ListOrder, true>(lds, g, So, E); }
    }
    SEAM(1);
    if (IN(2)) {
        for (int task = gw; task < S / 4; task += NGW) conv_task(P, task * 4, lane);
        mem_attn_phase(P, 0, (const bf16*)(ws + WS_QM0), gw, NGW, lane);
        if (bx == 0) { const int i = tid; float s = 0.f; const float* bp = (const float*)(ws + WS_BPART) + (i >> 8) * 64 * 256 + (i & 255);
            for (int kc = 0; kc < 64; ++kc) s += bp[kc * 256];
            ((float*)(ws + WS_BIAS1))[i] = s; }
    }
    SEAM(2);
    if (IN(3)) { pg8::Gemm g{mix, (const bf16*)(ws + WS_WO), S, D, D, D}; pg8::StaticOrder So; So.init(S, D, G, bx);
        EpiRes E{nullptr, xb, nullptr, xb, ss1, 0}; pg8::gemm_phase<EpiRes, pg8::StaticOrder, true>(lds, g, So, E); }
    SEAM(3);
    if (IN(4)) { pg8::Gemm g{xb, (const bf16*)(ws + WS_W1), S, FF, D, D}; pg8::StaticOrder So; So.init(S, FF, G, bx);
        EpiMlpIn E{hb, ss1}; pg8::gemm_phase<EpiMlpIn, pg8::StaticOrder, true>(lds, g, So, E); }
    SEAM(4);
    if (IN(5)) { pg8::Gemm g{hb, (const bf16*)(ws + WS_W2), S, D, FF, FF}; pg8::StaticOrder So; So.init(S, D, G, bx);
        EpiRes E{nullptr, xb, nullptr, xb, ss2, 0}; pg8::gemm_phase<EpiRes, pg8::StaticOrder, true>(lds, g, So, E); }
    SEAM(5);
    if (IN(6)) {
        if (bx == 0 && tid < 512) ((unsigned*)(ws + WS_CBUF + (size_t)4 * S * 64 * 2))[tid] = 0u;
        pg8::Gemm g{xb, (const bf16*)(ws + WS_WB), S, 2048, D, D}; pg8::StaticOrder So; So.init(S, 2048, G, bx);
        EpiB E{ss2, (bf16*)(ws + WS_CBUF), (bf16*)(ws + WS_KSEL), (bf16*)(ws + WS_VTSEL), (bf16*)(ws + WS_KWIN), (bf16*)(ws + WS_VTWIN), (bf16*)(ws + WS_Q), (bf16*)(ws + WS_QM1),
               (float*)(ws + WS_GATES), P.in[I_KNG], P.in[I_BQG], P.in[I_MQG] + 64, P.in[I_BGATEB]};
        pg8::gemm_phase<EpiB, pg8::StaticOrder, true>(lds, g, So, E); }
    SEAM(6);
    if (IN(7)) {
        { pg8::Gemm g{(const bf16*)(ws + WS_CBUF), (const bf16*)(ws + WS_W1C), 4096, 2048, 512, 1024}; pg8::ListOrder So{64, 1, G, bx, 1};
          EpiC E{(float*)(ws + WS_PART)}; pg8::gemm_phase<EpiC, pg8::ListOrder, true>(lds, g, So, E); }
        if (G > 128) mem_attn_phase(P, 1, (const bf16*)(ws + WS_QM1), bx >= 64 ? gw - 64 * NWAVES : -1, NGW - 64 * NWAVES, lane);
        else mem_attn_phase(P, 1, (const bf16*)(ws + WS_QM1), gw, NGW, lane);
    }
    SEAM(7);
    if (IN(8)) { for (int task = gw; task < 128; task += NGW) cmp2_task(P, task, lane); }
    SEAM(8);
    if (IN(9)) {
        const float gq = gain_max(P.in[I_BQG], lane);
        const float Bc = BNDC * gq * gain_max(P.in[I_KNG], lane) * 1.02f, Bw = BNDC * gq * gain_max(P.in[I_KNG] + 128, lane) * 1.02f;
        LAS float* wl = (LAS float*)(lds + wave * 1024);
        unsigned* cq = (unsigned*)(ws + WS_CNT); unsigned* wq = cq + 3;
        volatile LAS unsigned* pflag = (volatile LAS unsigned*)(lds + 120000);
        unsigned idx0 = 0xffffffffu;
        if (wave < 4) { if (lane == 0) idx0 = atomicAdd(cq, 1u); idx0 = (unsigned)__builtin_amdgcn_readfirstlane((int)idx0); if (lane == 0) pflag[wave] = idx0 < 448u ? 1u : 0u; }
        __syncthreads();
        if (wave < 4) {
            if (idx0 < 1024u) cmp_tile_task(P, 511 - (int)(idx0 >> 1), (int)(idx0 & 1u), Bc, wl, (LAS bf16x8*)(lds + 16384 + wave * 12288) + lane, lane);
            if (lane == 0) pflag[wave] = 0u;
        } else {
            while (__builtin_amdgcn_readfirstlane((int)pflag[wave - 4]) != 0) __builtin_amdgcn_s_sleep(32);
        }
        for (int pass = 0; pass < 2; ++pass) {
            const bool do_cmp = (wave < 4) == (pass == 0);
            for (;;) {
                unsigned idx = 0; if (lane == 0) idx = atomicAdd(do_cmp ? cq : wq, 1u); idx = (unsigned)__builtin_amdgcn_readfirstlane((int)idx);
                if (idx >= (do_cmp ? 1024u : 6144u)) break;
                if (do_cmp) cmp_tile_task(P, 511 - (int)(idx >> 1), (int)(idx & 1u), Bc, wl, (LAS bf16x8*)(lds + 16384 + wave * 12288) + lane, lane);
                else win_tile_task(P, (int)(idx / 12u), (int)(idx % 12u), Bw, lane);
            }
        }
        __syncthreads();
    }
    SEAM(9);
    if (IN(10)) {
        const float Bs = BNDC * gain_max(P.in[I_BQG], lane) * gain_max(P.in[I_KNG] + 64, lane) * 1.02f;
        if (G == 256) {
            sel_unit(P, 255 - (bx >> 1), bx & 1, Bs, lds, tid, wave, lane);
            sel_unit(P, bx >> 1, bx & 1, Bs, lds, tid, wave, lane);
        } else {
            for (int i = 0, u = bx; u < 512; ++i, u += G) {
                const int base = i * G, span = (512 - base) < G ? (512 - base) : G;
                const int uu = (i & 1) ? base + span - 1 - (u - base) : u;
                const int v = 511 - uu;
                sel_unit(P, v >> 1, v & 1, Bs, lds, tid, wave, lane);
            }
        }
    }
    SEAM(10);
    if (IN(11)) { pg8::Gemm g{mix, (const bf16*)(ws + WS_WO) + (size_t)D * D, S, D, D, D}; pg8::StaticOrder So; So.init(S, D, G, bx);
        EpiRes E{nullptr, xb, nullptr, xb, ss3, 0}; pg8::gemm_phase<EpiRes, pg8::StaticOrder, true>(lds, g, So, E); }
    SEAM(11);
    if (IN(12)) { pg8::Gemm g{xb, (const bf16*)(ws + WS_W1) + (size_t)D * FF, S, FF, D, D}; pg8::StaticOrder So; So.init(S, FF, G, bx);
        EpiMlpIn E{hb, ss3}; pg8::gemm_phase<EpiMlpIn, pg8::StaticOrder, true>(lds, g, So, E); }
    SEAM(12);
    if (IN(13)) { pg8::Gemm g{hb, (const bf16*)(ws + WS_W2) + (size_t)D * FF, S, D, FF, FF}; pg8::StaticOrder So; So.init(S, D, G, bx);
        EpiRes E{nullptr, xb, P.out, xb, ss3, 1}; pg8::gemm_phase<EpiRes, pg8::StaticOrder, true>(lds, g, So, E); }
    if (P.ph_hi > 1000) cg::this_grid().sync();
#undef IN
#undef SEAM
}

extern "C" void kernel_launch(void* const* d_in, const int* in_sizes, int n_in, void* d_out, int out_size, void* d_ws, size_t ws_size, hipStream_t stream) {
    static int grid = 0;
    if (grid == 0) {
        if (n_in != 29 || out_size != S * D || ws_size < WS_END) { fprintf(stderr, "kernel_launch: unexpected shapes (n_in %d out %d ws %zu)\n", n_in, out_size, ws_size); grid = -1; return; }
        int dev = 0, cus = 0, per_cu = 0;
        hipGetDevice(&dev); hipDeviceGetAttribute(&cus, hipDeviceAttributeMultiprocessorCount, dev);
        hipFuncSetAttribute((const void*)yoco_fwd, hipFuncAttributeMaxDynamicSharedMemorySize, LDS_BYTES);
        hipOccupancyMaxActiveBlocksPerMultiprocessor(&per_cu, (const void*)yoco_fwd, NWAVES * 64, LDS_BYTES);
        if (per_cu < 1) { fprintf(stderr, "kernel_launch: occupancy query reports %d\n", per_cu); per_cu = 1; }
        (void)hipGetLastError();
        grid = cus;
    }
    if (grid < 0) return;
    (void)hipMemsetAsync((char*)d_ws + WS_CNT, 0, 32768, stream);
    Params p{};
    for (int i = 0; i < 29; ++i) p.in[i] = (const float*)d_in[i];
    p.out = (float*)d_out; p.ws = (unsigned char*)d_ws; p.ph_lo = 0; p.ph_hi = 14;
    void* args[] = {&p};
    hipError_t e = hipLaunchCooperativeKernel((const void*)yoco_fwd, dim3(grid), dim3(NWAVES * 64), args, LDS_BYTES, stream);
    if (e != hipSuccess) fprintf(stderr, "cooperative launch failed: %s (grid %d)\n", hipGetErrorString(e), grid);
}
```

```cpp
#include <hip/hip_runtime.h>
#include <hip/hip_cooperative_groups.h>
#include <cstdio>
#include <cstdint>
namespace cg = cooperative_groups;

#define LAS __attribute__((address_space(3)))
typedef unsigned short bf16;
typedef short bf16x8 __attribute__((ext_vector_type(8)));
typedef short s16x4 __attribute__((ext_vector_type(4)));
typedef float f32x2 __attribute__((ext_vector_type(2)));
typedef float f32x4 __attribute__((ext_vector_type(4)));
typedef float f32x16 __attribute__((ext_vector_type(16)));
typedef unsigned u32x2 __attribute__((ext_vector_type(2)));
typedef unsigned u32x4 __attribute__((ext_vector_type(4)));
typedef __bf16 bf16x2_t __attribute__((ext_vector_type(2)));
#define DI __device__ __forceinline__

DI unsigned pk2(float lo, float hi) { f32x2 v = {lo, hi}; bf16x2_t b = __builtin_convertvector(v, bf16x2_t); return __builtin_bit_cast(unsigned, b); }
DI float wave_sum(float v) {
#pragma unroll
    for (int o = 1; o < 64; o <<= 1) v += __shfl_xor(v, o);
    return v;
}
DI float wave_max(float v) {
#pragma unroll
    for (int o = 1; o < 64; o <<= 1) v = fmaxf(v, __shfl_xor(v, o));
    return v;
}
DI unsigned wave_max_u32(unsigned x) {
#define WMX(ctrl, rm) { const unsigned y = (unsigned)__builtin_amdgcn_update_dpp(0, (int)x, ctrl, rm, 0xf, false); x = y > x ? y : x; }
    WMX(0x111, 0xf) WMX(0x112, 0xf) WMX(0x114, 0xf) WMX(0x118, 0xf) WMX(0x142, 0xa) WMX(0x143, 0xc)
#undef WMX
    return (unsigned)__builtin_amdgcn_readlane((int)x, 63);
}
DI float sigmoidf_(float x) { return 1.0f / (1.0f + __expf(-x)); }
#define LDS_WAIT() asm volatile("s_waitcnt lgkmcnt(0)" ::: "memory")

constexpr int S = 16384, D = 1024, FF = 4096, MEML = 256;
constexpr float EPS = 1e-6f;
constexpr float QSCALE = 0.125f * 1.4426950408889634f;
constexpr float BNDC = 64.0f * QSCALE;

namespace pg8 {
#define PG8_LAS __attribute__((address_space(3)))
constexpr int BM = 256, BK = 64, HALF = 128, HTB = HALF * BK * 2, STAGE_BYTES = 8 * HTB, NXCD = 8, WGM = 4;
__host__ __device__ __forceinline__ int lds_byte(int r, int c) { const int st = (r >> 4) * 2 + (c >> 5), rr = r & 15, cc = c & 31, ob = rr * 64 + cc * 2; return st * 1024 + (ob ^ (((ob >> 9) & 1) << 5)); }
__host__ __device__ __forceinline__ void stage_rc(int b, int& R, int& C) { const int st = b / 1024, sb = b % 1024, swz = sb ^ (((sb >> 9) & 1) << 5); R = (st >> 1) * 16 + swz / 64; C = (st & 1) * 32 + (swz % 64) / 2; }
__host__ __device__ __forceinline__ int perm32(int rho) { const int n = rho >> 4, i = rho & 15; return 8 * (i >> 2) + 4 * n + (i & 3); }
struct Unit { int pm, pn; };
struct Gemm { const bf16* A; const bf16* Bt; int M, N, K, lda; };
struct StaticOrder {
    int nM, nN, nwg, G, c;
    __device__ void init(int M, int N, int G_, int c_) { nM = M / BM; nN = N / BM; nwg = nM * nN; G = G_; c = c_; }
    __device__ bool next(int i, Unit& u) const {
        const long L = (long)i * G + c; if (L >= nwg) return false;
        int wgid = (int)L; { const int q = nwg / NXCD, r = nwg % NXCD, xcd = wgid % NXCD, off = wgid / NXCD; wgid = (xcd < r ? xcd * (q + 1) : r * (q + 1) + (xcd - r) * q) + off; }
        const int nig = WGM * nN, gid = wgid / nig, fm = gid * WGM, gsz = (nM - fm) < WGM ? (nM - fm) : WGM;
        u.pm = fm + ((wgid % nig) % gsz); u.pn = (wgid % nig) / gsz; return true;
    }
    __device__ size_t aoff(const Unit&) const { return 0; }
};
struct ListOrder {
    int n, nN, G, c, cmp;
    __device__ bool next(int i, Unit& u) const { const int L = c + i * G; if (c < 0 || L >= n) return false; if (cmp) { u.pm = L >> 2; u.pn = (L >> 5) * 4 + (L & 3); } else { u.pm = L / nN; u.pn = L % nN; } return true; }
    __device__ size_t aoff(const Unit& u) const { return cmp ? (size_t)(u.pn & 3) * 1024 : 0; }
};

template <class Epi, class Sched, bool ALIGN_EPI>
__device__ __forceinline__ void gemm_phase(PG8_LAS unsigned char* lds, const Gemm g, const Sched& S, const Epi& E) {
    const int tid = threadIdx.x, wid = __builtin_amdgcn_readfirstlane(tid >> 6), lane = tid & 63, wr = wid >> 2, wc = wid & 3, fr = lane & 15, fq = lane >> 4;
    const int K = g.K, nt = K / BK, lda = g.lda;
    unsigned voffA[2], voffB[2];
#pragma unroll
    for (int i = 0; i < 2; ++i) { int R, C; stage_rc(tid * 16 + i * 8192, R, C); const int Rb = Epi::PERM ? ((R & ~31) + perm32(R & 31)) : R;
        voffA[i] = (unsigned)(R * lda + C) * 2u; voffB[i] = (unsigned)(Rb * K + C) * 2u; }
    const size_t kstep = (size_t)(BK * 2);
    const size_t hstepA = (size_t)HALF * lda * 2, hstepB = (size_t)HALF * K * 2;
    const size_t tstepA = 2 * hstepA, tstepB = 2 * hstepB;
    const unsigned ldsw = (unsigned)wid * 1024u;
    const int aoff = lds_byte(wr * 64 + fr, fq * 8), boff = lds_byte(wc * 32 + fr, fq * 8);
#define PG8_SA(b, h) (((b) * 2 + (h)) * HTB)
#define PG8_SB(b, h) ((4 + (b) * 2 + (h)) * HTB)
#define PG8_STAGE(bufoff, gbase, voff) do { _Pragma("unroll") for (int _i = 0; _i < 2; ++_i) \
        __builtin_amdgcn_global_load_lds((const unsigned*)((const char*)(gbase) + (voff)[_i]), (PG8_LAS unsigned*)(lds + (bufoff) + ldsw + _i * 8192), 16, 0, 0); } while (0)
#define PG8_LDA(dst, b, h) do { _Pragma("unroll") for (int m = 0; m < 4; ++m) _Pragma("unroll") for (int k = 0; k < 2; ++k) dst[m][k] = *(const PG8_LAS bf16x8*)(lds + PG8_SA(b, h) + aoff + m * 2048 + k * 1024); } while (0)
#define PG8_LDB(dst, b, h) do { _Pragma("unroll") for (int n = 0; n < 2; ++n) _Pragma("unroll") for (int k = 0; k < 2; ++k) dst[n][k] = *(const PG8_LAS bf16x8*)(lds + PG8_SB(b, h) + boff + n * 2048 + k * 1024); } while (0)
#define PG8_MMA(ai, bj, At, Bt) do { __builtin_amdgcn_s_setprio(1); _Pragma("unroll") for (int m = 0; m < 4; ++m) _Pragma("unroll") for (int n = 0; n < 2; ++n) _Pragma("unroll") for (int k = 0; k < 2; ++k) \
        acc[ai][bj][m][n] = __builtin_amdgcn_mfma_f32_16x16x32_bf16(Bt[n][k], At[m][k], acc[ai][bj][m][n], 0, 0, 0); __builtin_amdgcn_s_setprio(0); } while (0)
#define PG8_WAIT_V(n) asm volatile("s_waitcnt vmcnt(" #n ")" ::: "memory")
#define PG8_WAIT_L(n) asm volatile("s_waitcnt lgkmcnt(" #n ")" ::: "memory")
#define PG8_BAR __builtin_amdgcn_s_barrier()
#define PG8_SCHED __builtin_amdgcn_sched_barrier(0)
    Unit cur, nxt; int ui = 0;
    if (!S.next(0, cur)) return;
    f32x4 acc[2][2][4][2];
#pragma unroll
    for (int a = 0; a < 2; ++a)
#pragma unroll
        for (int b = 0; b < 2; ++b)
#pragma unroll
            for (int m = 0; m < 4; ++m)
#pragma unroll
                for (int n = 0; n < 2; ++n) acc[a][b][m][n] = (f32x4){0.f, 0.f, 0.f, 0.f};
    bf16x8 At[4][2], B0[2][2], B1[2][2];
    const char* cA = (const char*)g.A + (size_t)cur.pm * tstepA + S.aoff(cur); const char* cB = (const char*)g.Bt + (size_t)cur.pn * tstepB;
    PG8_STAGE(PG8_SB(0, 0), cB, voffB); PG8_STAGE(PG8_SB(0, 1), cB + hstepB, voffB); PG8_STAGE(PG8_SA(0, 0), cA, voffA); PG8_STAGE(PG8_SA(0, 1), cA + hstepA, voffA);
    if (wr == 1) PG8_BAR;
    PG8_WAIT_V(2); PG8_BAR;
    PG8_STAGE(PG8_SB(1, 0), cB + kstep, voffB); PG8_STAGE(PG8_SA(1, 0), cA + kstep, voffA); PG8_STAGE(PG8_SB(1, 1), cB + hstepB + kstep, voffB);
    PG8_WAIT_V(6); PG8_BAR;
    for (;;) {
        const bool has_next = S.next(ui + 1, nxt);
        const char* nA = has_next ? (const char*)g.A + (size_t)nxt.pm * tstepA + S.aoff(nxt) : cA; const char* nB = has_next ? (const char*)g.Bt + (size_t)nxt.pn * tstepB : cB;
        for (int t = 0; t < nt; t += 2) {
            const bool last = (t == nt - 2);
            const char* a1 = cA + (size_t)(t + 1) * kstep;
            const char* a2 = last ? nA : cA + (size_t)(t + 2) * kstep; const char* b2 = last ? nB : cB + (size_t)(t + 2) * kstep;
            const char* a3 = a2 + kstep; const char* b3 = b2 + kstep;
            PG8_LDB(B0, 0, 0); PG8_LDB(B1, 0, 1); PG8_SCHED; PG8_LDA(At, 0, 0); PG8_STAGE(PG8_SA(1, 1), a1 + hstepA, voffA);
            PG8_WAIT_V(8); PG8_WAIT_L(0); PG8_BAR; PG8_MMA(0, 0, At, B0); PG8_MMA(0, 1, At, B1); PG8_BAR; PG8_SCHED;
            PG8_LDA(At, 0, 1); PG8_STAGE(PG8_SB(0, 0), b2, voffB); PG8_STAGE(PG8_SB(0, 1), b2 + hstepB, voffB); PG8_STAGE(PG8_SA(0, 0), a2, voffA);
            PG8_WAIT_V(8); PG8_WAIT_L(0); PG8_BAR; PG8_MMA(1, 0, At, B0); PG8_MMA(1, 1, At, B1); PG8_BAR; PG8_SCHED;
            PG8_LDB(B0, 1, 0); PG8_LDB(B1, 1, 1); PG8_SCHED; PG8_LDA(At, 1, 0); PG8_STAGE(PG8_SA(0, 1), a2 + hstepA, voffA);
            PG8_WAIT_V(8); PG8_WAIT_L(0); PG8_BAR; PG8_MMA(0, 0, At, B0); PG8_MMA(0, 1, At, B1); PG8_BAR; PG8_SCHED;
            PG8_LDA(At, 1, 1); PG8_STAGE(PG8_SB(1, 0), b3, voffB); PG8_STAGE(PG8_SB(1, 1), b3 + hstepB, voffB); PG8_STAGE(PG8_SA(1, 0), a3, voffA);
            PG8_WAIT_V(8); PG8_WAIT_L(0); PG8_BAR; PG8_MMA(1, 0, At, B0); PG8_MMA(1, 1, At, B1); PG8_BAR; PG8_SCHED;
        }
        if constexpr (ALIGN_EPI) { if (wr == 0) PG8_BAR; }
        E(acc, cur, wr, wc, fr, fq);
        if (!has_next) break;
#pragma unroll
        for (int a = 0; a < 2; ++a)
#pragma unroll
            for (int b = 0; b < 2; ++b)
#pragma unroll
                for (int m = 0; m < 4; ++m)
#pragma unroll
                    for (int n = 0; n < 2; ++n) acc[a][b][m][n] = (f32x4){0.f, 0.f, 0.f, 0.f};
        cur = nxt; cA = nA; cB = nB; ++ui;
        if constexpr (ALIGN_EPI) { if (wr == 1) PG8_BAR; }
    }
    PG8_WAIT_V(0);
    if constexpr (!ALIGN_EPI) { if (wr == 0) PG8_BAR; }
    PG8_BAR;
#undef PG8_SA
#undef PG8_SB
#undef PG8_STAGE
#undef PG8_LDA
#undef PG8_LDB
#undef PG8_MMA
#undef PG8_WAIT_V
#undef PG8_WAIT_L
#undef PG8_BAR
#undef PG8_SCHED
}
}
using pg8::Unit; using pg8::HALF; using pg8::BM;

typedef f32x4 Acc[2][2][4][2];

DI int kimg(int key, int dim) { return ((((key >> 5) & 1) * 4 + (dim >> 4)) * 64 + ((dim >> 3) & 1) * 32 + (key & 31)) * 8 + (dim & 7); }
DI int vimg(int dim, int key) { return (((((key >> 5) & 1) * 2 + ((key >> 4) & 1)) * 2 + (dim >> 5)) * 64 + ((key >> 2) & 1) * 32 + (dim & 31)) * 8 + ((key >> 3) & 1) * 4 + (key & 3); }
DI f32x4 ld_bf16x4(const bf16* p) { const u32x2 raw = *(const u32x2*)p; return (f32x4){__uint_as_float(raw.x << 16), __uint_as_float(raw.x & 0xffff0000u), __uint_as_float(raw.y << 16), __uint_as_float(raw.y & 0xffff0000u)}; }
DI void st_bf16x4(bf16* p, f32x4 v) { u32x2 w; w.x = pk2(v[0], v[1]); w.y = pk2(v[2], v[3]); *(u32x2*)p = w; }

DI float head_rs(const Acc& acc, int ai, int m, float pre) {
    float s = 0.f;
#pragma unroll
    for (int bj = 0; bj < 2; ++bj)
#pragma unroll
        for (int n = 0; n < 2; ++n) { const f32x4 x = acc[ai][bj][m][n] * pre; s += (x[0] * x[0] + x[1] * x[1]) + (x[2] * x[2] + x[3] * x[3]); }
    s += __shfl_xor(s, 16); s += __shfl_xor(s, 32);
    return __builtin_amdgcn_rsqf(s * (1.0f / 64.0f) + EPS);
}

struct EpiA {
    static constexpr bool PERM = true;
    bf16* vglu; bf16* qm; const float* b_glu; const float* qg; const float* ss0;
    DI void operator()(const Acc& acc, const Unit& u, int wr, int wc, int fr, int fq) const {
        const int row0 = u.pm * BM + wr * 64 + fr;
        if (u.pn < 6) {
            const int ch0 = 128 * u.pn + 32 * wc + 8 * fq;
            const f32x4 ba0 = *(const f32x4*)(b_glu + ch0), ba1 = *(const f32x4*)(b_glu + ch0 + 4), bg0 = *(const f32x4*)(b_glu + 768 + ch0), bg1 = *(const f32x4*)(b_glu + 768 + ch0 + 4);
#pragma unroll
            for (int ai = 0; ai < 2; ++ai)
#pragma unroll
                for (int m = 0; m < 4; ++m) {
                    const float rs = __builtin_amdgcn_rsqf(ss0[row0 + ai * HALF + m * 16] * (1.0f / D) + EPS);
                    const f32x4 a0 = acc[ai][0][m][0] * rs + ba0, a1 = acc[ai][0][m][1] * rs + ba1, g0 = acc[ai][1][m][0] * rs + bg0, g1 = acc[ai][1][m][1] * rs + bg1; f32x4 v0, v1;
#pragma unroll
                    for (int e = 0; e < 4; ++e) { v0[e] = a0[e] * sigmoidf_(g0[e]); v1[e] = a1[e] * sigmoidf_(g1[e]); }
                    u32x4 w; w.x = pk2(v0[0], v0[1]); w.y = pk2(v0[2], v0[3]); w.z = pk2(v1[0], v1[1]); w.w = pk2(v1[2], v1[3]);
                    *(u32x4*)(vglu + (size_t)(row0 + ai * HALF + m * 16) * 768 + ch0) = w;
                }
        } else {
#pragma unroll
            for (int ai = 0; ai < 2; ++ai)
#pragma unroll
                for (int m = 0; m < 4; ++m) {
                    const float rs = __builtin_amdgcn_rsqf(ss0[row0 + ai * HALF + m * 16] * (1.0f / D) + EPS);
                    const float r = head_rs(acc, ai, m, rs) * rs * QSCALE;
#pragma unroll
                    for (int bj = 0; bj < 2; ++bj) { const int d0 = 32 * bj + 8 * fq; const f32x4 g0 = *(const f32x4*)(qg + d0), g1 = *(const f32x4*)(qg + d0 + 4);
                        const f32x4 v0 = acc[ai][bj][m][0] * r * g0, v1 = acc[ai][bj][m][1] * r * g1;
                        u32x4 w; w.x = pk2(v0[0], v0[1]); w.y = pk2(v0[2], v0[3]); w.z = pk2(v1[0], v1[1]); w.w = pk2(v1[2], v1[3]);
                        *(u32x4*)(qm + (size_t)(row0 + ai * HALF + m * 16) * 256 + wc * 64 + d0) = w; }
                }
        }
    }
};
struct EpiMem {
    static constexpr bool PERM = false;
    bf16* mk; bf16* mvT; const float* kg;
    DI void operator()(const Acc& acc, const Unit& u, int wr, int wc, int fr, int fq) const {
        const int l = u.pn >> 1, kv = u.pn & 1, row0 = wr * 64 + fr;
#pragma unroll
        for (int ai = 0; ai < 2; ++ai)
#pragma unroll
            for (int m = 0; m < 4; ++m) {
                const int row = row0 + ai * HALF + m * 16;
                if (kv == 0) {
                    const float r = head_rs(acc, ai, m, 1.0f);
#pragma unroll
                    for (int bj = 0; bj < 2; ++bj)
#pragma unroll
                        for (int n = 0; n < 2; ++n) { const int d0 = 32 * bj + 16 * n + 4 * fq; const f32x4 g4 = *(const f32x4*)(kg + l * 64 + d0);
                            st_bf16x4(mk + ((size_t)((l * 4 + wc) * 4 + (row >> 6))) * 4096 + ((row >> 5) & 1) * 2048 + (row & 31) * 8 + (2 * bj + n) * 512 + (fq >> 1) * 256 + 4 * (fq & 1), acc[ai][bj][m][n] * r * g4); }
                } else {
#pragma unroll
                    for (int bj = 0; bj < 2; ++bj)
#pragma unroll
                        for (int n = 0; n < 2; ++n) { const int d0 = 32 * bj + 16 * n + 4 * fq; const f32x4 v = acc[ai][bj][m][n];
#pragma unroll
                            for (int e = 0; e < 4; ++e) mvT[((size_t)((l * 4 + wc) * 4 + (row >> 6))) * 4096 + vimg(0, row & 63) + bj * 512 + (16 * n + 4 * fq + e) * 8] = (bf16)(pk2(v[e], 0.f) & 0xffffu); }
                }
            }
    }
};
struct EpiRes {
    static constexpr bool PERM = true;
    const float* bf; const bf16* bb; float* out; bf16* xb; float* ss; int last;
    DI void operator()(const Acc& acc, const Unit& u, int wr, int wc, int fr, int fq) const {
        const int row0 = u.pm * BM + wr * 64 + fr, col0 = u.pn * BM + wc * 32 + 8 * fq;
#pragma unroll
        for (int ai = 0; ai < 2; ++ai)
#pragma unroll
            for (int m = 0; m < 4; ++m) {
                const int row = row0 + ai * HALF + m * 16; const size_t p = (size_t)row * D + col0; float s = 0.f;
#pragma unroll
                for (int bj = 0; bj < 2; ++bj) { const size_t off = p + bj * HALF;
                    const u32x4 raw = *(const u32x4*)(bb + off);
                    const f32x4 v0 = (f32x4){__uint_as_float(raw.x << 16), __uint_as_float(raw.x & 0xffff0000u), __uint_as_float(raw.y << 16), __uint_as_float(raw.y & 0xffff0000u)} + acc[ai][bj][m][0];
                    const f32x4 v1 = (f32x4){__uint_as_float(raw.z << 16), __uint_as_float(raw.z & 0xffff0000u), __uint_as_float(raw.w << 16), __uint_as_float(raw.w & 0xffff0000u)} + acc[ai][bj][m][1];
                    if (out) { __builtin_nontemporal_store(v0, (f32x4*)(out + off)); __builtin_nontemporal_store(v1, (f32x4*)(out + off + 4)); }
                    if (!last) { u32x4 w; w.x = pk2(v0[0], v0[1]); w.y = pk2(v0[2], v0[3]); w.z = pk2(v1[0], v1[1]); w.w = pk2(v1[2], v1[3]); *(u32x4*)(xb + off) = w;
                        s += (v0[0] * v0[0] + v0[1] * v0[1]) + (v0[2] * v0[2] + v0[3] * v0[3]) + (v1[0] * v1[0] + v1[1] * v1[1]) + (v1[2] * v1[2] + v1[3] * v1[3]); } }
                if (!last) { s += __shfl_xor(s, 16); s += __shfl_xor(s, 32); if (fq == 0) unsafeAtomicAdd(ss + row, s); }
            }
    }
};
struct EpiMlpIn {
    static constexpr bool PERM = true;
    bf16* hb; const float* ss;
    DI void operator()(const Acc& acc, const Unit& u, int wr, int wc, int fr, int fq) const {
        const int row0 = u.pm * BM + wr * 64 + fr, col0 = u.pn * BM + wc * 32 + 8 * fq;
#pragma unroll
        for (int ai = 0; ai < 2; ++ai)
#pragma unroll
            for (int m = 0; m < 4; ++m) {
                const int row = row0 + ai * HALF + m * 16; const float rs = __builtin_amdgcn_rsqf(ss[row] * (1.0f / D) + EPS);
#pragma unroll
                for (int bj = 0; bj < 2; ++bj) { f32x4 v0 = acc[ai][bj][m][0] * rs, v1 = acc[ai][bj][m][1] * rs;
#pragma unroll
                    for (int e = 0; e < 4; ++e) { const float a = fmaxf(v0[e], 0.f), b = fmaxf(v1[e], 0.f); v0[e] = a * a; v1[e] = b * b; }
                    u32x4 w; w.x = pk2(v0[0], v0[1]); w.y = pk2(v0[2], v0[3]); w.z = pk2(v1[0], v1[1]); w.w = pk2(v1[2], v1[3]);
                    *(u32x4*)(hb + (size_t)row * FF + col0 + bj * HALF) = w; }
            }
    }
};
struct EpiB {
    static constexpr bool PERM = false;
    const float* ss; bf16* cbuf; bf16* ksel; bf16* vTsel; bf16* kwin; bf16* vTwin; bf16* q; bf16* qm; float* gates;
    const float* kng; const float* qng; const float* mqg; const float* gate_b;
    DI void operator()(const Acc& acc, const Unit& u, int wr, int wc, int fr, int fq) const {
        const int row0 = u.pm * BM + wr * 64 + fr; const int pn = u.pn;
#pragma unroll
        for (int ai = 0; ai < 2; ++ai)
#pragma unroll
            for (int m = 0; m < 4; ++m) {
                const int row = row0 + ai * HALF + m * 16; const float rs = __builtin_amdgcn_rsqf(ss[row] * (1.0f / D) + EPS);
                if (pn == 0) {
#pragma unroll
                    for (int bj = 0; bj < 2; ++bj)
#pragma unroll
                        for (int n = 0; n < 2; ++n) { const int d0 = 32 * bj + 16 * n + 4 * fq; st_bf16x4(cbuf + ((size_t)wc * S + row) * 64 + d0, acc[ai][bj][m][n] * rs); }
                } else if (pn <= 2) {
                    bf16* kd = pn == 1 ? ksel : kwin; bf16* vd = pn == 1 ? vTsel : vTwin; const float* g = kng + pn * 64;
                    if (wc < 2) {
                        const float r = head_rs(acc, ai, m, rs) * rs;
#pragma unroll
                        for (int bj = 0; bj < 2; ++bj)
#pragma unroll
                            for (int n = 0; n < 2; ++n) { const int d0 = 32 * bj + 16 * n + 4 * fq; const f32x4 g4 = *(const f32x4*)(g + d0);
                                st_bf16x4(kd + ((size_t)wc * (S / 64) + (row >> 6)) * 4096 + ((row >> 5) & 1) * 2048 + (row & 31) * 8 + (2 * bj + n) * 512 + (fq >> 1) * 256 + 4 * (fq & 1), acc[ai][bj][m][n] * r * g4); }
                    } else {
#pragma unroll
                        for (int bj = 0; bj < 2; ++bj)
#pragma unroll
                            for (int n = 0; n < 2; ++n) { const int d0 = 32 * bj + 16 * n + 4 * fq; const f32x4 v = acc[ai][bj][m][n] * rs;
#pragma unroll
                                for (int e = 0; e < 4; ++e) vd[((size_t)(wc - 2) * (S / 64) + (row >> 6)) * 4096 + vimg(0, row & 63) + bj * 512 + (16 * n + 4 * fq + e) * 8] = (bf16)(pk2(v[e], 0.f) & 0xffffu); }
                    }
                } else if (pn <= 6) {
                    const float r = head_rs(acc, ai, m, rs) * rs * QSCALE; const float* g = pn == 6 ? mqg : qng;
                    bf16* dst = pn == 6 ? qm + (size_t)row * 256 + wc * 64 : q + (size_t)row * 768 + ((pn - 3) * 4 + wc) * 64;
#pragma unroll
                    for (int bj = 0; bj < 2; ++bj)
#pragma unroll
                        for (int n = 0; n < 2; ++n) { const int d0 = 32 * bj + 16 * n + 4 * fq; const f32x4 g4 = *(const f32x4*)(g + d0);
                            st_bf16x4(dst + d0, acc[ai][bj][m][n] * r * g4); }
                } else {
                    if (wc < 2) {
#pragma unroll
                        for (int n = 0; n < 2; ++n) { const int p0 = 32 * wc + 16 * n + 4 * fq;
                            if (p0 < 36) { const f32x4 v = acc[ai][0][m][n] * rs;
#pragma unroll
                                for (int e = 0; e < 4; ++e) gates[(size_t)row * 36 + p0 + e] = sigmoidf_(v[e] + gate_b[p0 + e]); } }
                    }
                }
            }
    }
};
struct EpiC {
    static constexpr bool PERM = false;
    float* part;
    DI void operator()(const Acc& acc, const Unit& u, int wr, int wc, int fr, int fq) const {
        const int row0 = u.pm * BM + wr * 64 + fr, col0 = wc * 32 + 4 * fq; float* pb = part + (size_t)(u.pn & 3) * 4096 * 256;
#pragma unroll
        for (int ai = 0; ai < 2; ++ai)
#pragma unroll
            for (int m = 0; m < 4; ++m) { float* rowp = pb + (size_t)(row0 + ai * HALF + m * 16) * 256 + col0;
#pragma unroll
                for (int bj = 0; bj < 2; ++bj)
#pragma unroll
                    for (int n = 0; n < 2; ++n) *(f32x4*)(rowp + bj * HALF + n * 16) = acc[ai][bj][m][n]; }
    }
};

constexpr size_t MiB = 1u << 20;
constexpr size_t WS_SS = 0;
constexpr size_t WS_BPART = 256 * 1024;
constexpr size_t WS_BIAS1 = 400 * 1024;
constexpr size_t WS_MK = 512 * 1024;
constexpr size_t WS_MVT = 768 * 1024;
constexpr size_t WS_KCMP = 1 * MiB;
constexpr size_t WS_VTCMP = 1 * MiB + 256 * 1024;
constexpr size_t WS_MEMB = 1 * MiB + 512 * 1024;
constexpr size_t WS_W = 8 * MiB;
constexpr size_t WS_WA = WS_W;
constexpr size_t WS_WO = WS_WA + 1792 * 1024 * 2;
constexpr size_t WS_W1 = WS_WO + 2 * 1024 * 1024 * 2;
constexpr size_t WS_W2 = WS_W1 + 2 * 4096 * 1024 * 2;
constexpr size_t WS_WB = WS_W2 + 2 * 4096 * 1024 * 2;
constexpr size_t WS_WM = WS_WB + 2048 * 1024 * 2;
constexpr size_t WS_W1C = WS_WM + 1024 * 1024 * 2;
constexpr size_t WS_W2C = WS_W1C + 512 * 2048 * 2;
constexpr size_t WS_WEND = WS_W2C + 2 * 64 * 256 * 2;
constexpr size_t WS_XB = 58 * MiB;
constexpr size_t WS_MIX = 90 * MiB;
constexpr size_t WS_HB = 122 * MiB;
constexpr size_t WS_END = 250 * MiB;
static_assert(WS_WEND <= WS_XB, "weights fit");
constexpr size_t WS_VGLU = WS_HB;
constexpr size_t WS_QM0 = WS_HB + 24 * MiB;
constexpr size_t WS_CBUF = WS_HB;
constexpr size_t WS_KSEL = WS_HB + 10 * MiB;
constexpr size_t WS_VTSEL = WS_HB + 14 * MiB;
constexpr size_t WS_KWIN = WS_HB + 18 * MiB;
constexpr size_t WS_VTWIN = WS_HB + 22 * MiB;
constexpr size_t WS_Q = WS_HB + 26 * MiB;
constexpr size_t WS_QM1 = WS_HB + 50 * MiB;
constexpr size_t WS_GATES = WS_HB + 58 * MiB;
constexpr size_t WS_IMP = WS_HB + 64 * MiB;
constexpr size_t WS_PART = WS_IMP;
constexpr size_t WS_OC = WS_HB + 96 * MiB;
constexpr size_t WS_CNT = 448 * 1024;

constexpr int LDS_BYTES = 147456;
constexpr int NWAVES = 8;

struct Params { const float* in[29]; float* out; unsigned char* ws; int ph_lo, ph_hi; };
enum { I_X = 0, I_MEM, I_NMIX, I_NMLP, I_MEMN, I_WMEMKV, I_MQG, I_MKG, I_WOUT, I_WMLPIN, I_WMLPOUT, I_AWIN, I_ABGLU, I_ADW, I_ADWB, I_ALNG, I_ALNB,
       I_BWIN, I_BGATEB, I_BQG, I_KVNG, I_WKV, I_KNG, I_PEK, I_PEV, I_W1K, I_W2K, I_W1V, I_W2V };

DI int hp(int p) { return 64 * ((p >> 5) & 3) + 32 * (p >> 7) + (p & 31); }
DI void tr_item(const float* __restrict__ W, int ldw, int src_col0, int nvalid, const float* __restrict__ gain, bf16* WT, int K, int dst_row0, int k0, LAS float* scr, int lane) {
    const int cc = lane & 31; const bool ok = cc < nvalid;
    const float* wp = W + (size_t)(k0 + (lane >> 5)) * ldw + src_col0 + (ok ? cc : 0);
    float v[32];
#pragma unroll
    for (int i = 0; i < 32; ++i) v[i] = __builtin_nontemporal_load(wp + (size_t)(2 * i) * ldw);
    const int c = lane & 7;
    f32x4 g0 = {1.f, 1.f, 1.f, 1.f}, g1 = {1.f, 1.f, 1.f, 1.f};
    if (gain) { g0 = *(const f32x4*)(gain + k0 + 8 * c); g1 = *(const f32x4*)(gain + k0 + 8 * c + 4); }
#pragma unroll
    for (int i = 0; i < 32; ++i) scr[(2 * i + (lane >> 5)) * 33 + cc] = ok ? v[i] : 0.f;
    LDS_WAIT();
#pragma unroll
    for (int j = 0; j < 4; ++j) { const int n = (lane >> 3) + 8 * j; const LAS float* s = scr + (8 * c) * 33 + n;
        u32x4 o; o.x = pk2(s[0 * 33] * g0[0], s[1 * 33] * g0[1]); o.y = pk2(s[2 * 33] * g0[2], s[3 * 33] * g0[3]); o.z = pk2(s[4 * 33] * g1[0], s[5 * 33] * g1[1]); o.w = pk2(s[6 * 33] * g1[2], s[7 * 33] * g1[3]);
        *(u32x4*)(WT + (size_t)(dst_row0 + n) * K + k0 + 8 * c) = o; }
    LDS_WAIT();
}
DI void rms_rows2_to_bf16(const float* xrow, bf16* orow, float* ssq, int lane) {
    const f32x4* xr = (const f32x4*)xrow + lane; f32x4 v[8]; float s0 = 0.f, s1 = 0.f;
#pragma unroll
    for (int j = 0; j < 8; ++j) v[j] = __builtin_nontemporal_load(xr + 64 * j);
#pragma unroll
    for (int j = 0; j < 4; ++j) { s0 += (v[j][0] * v[j][0] + v[j][1] * v[j][1]) + (v[j][2] * v[j][2] + v[j][3] * v[j][3]);
                                  s1 += (v[4 + j][0] * v[4 + j][0] + v[4 + j][1] * v[4 + j][1]) + (v[4 + j][2] * v[4 + j][2] + v[4 + j][3] * v[4 + j][3]); }
    s0 = wave_sum(s0); s1 = wave_sum(s1);
    float r0 = __builtin_amdgcn_rsqf(s0 * (1.0f / D) + EPS), r1 = __builtin_amdgcn_rsqf(s1 * (1.0f / D) + EPS);
    if (ssq) { if (lane == 0) { ssq[0] = s0; ssq[1] = s1; } r0 = 1.0f; r1 = 1.0f; }
    u32x2* o8 = (u32x2*)orow + lane;
#pragma unroll
    for (int j = 0; j < 8; ++j) { const float r = j < 4 ? r0 : r1; u32x2 w; w.x = pk2(v[j][0] * r, v[j][1] * r); w.y = pk2(v[j][2] * r, v[j][3] * r); o8[64 * j] = w; }
}
DI void p0_prologue(const Params& P, LAS unsigned char* lds, int gw, int NGW, int wave, int lane) {
    unsigned char* ws = P.ws;
    LAS float* scr = (LAS float*)(lds + wave * 16384);
    constexpr int NM = 11;
    const int rows[NM] = {1792, 1024, 1024, 4096, 4096, 1024, 1024, 2048, 1024, 512, 128};
    const int Ks[NM]   = {1024, 1024, 1024, 1024, 1024, 4096, 4096, 1024, 1024, 2048, 256};
    int total = 0;
#pragma unroll
    for (int m = 0; m < NM; ++m) total += (rows[m] / 32) * (Ks[m] / 64);
    for (int it = gw; it < total; it += NGW) {
        int r = it, m = 0;
#pragma unroll
        for (int mm = 0; mm < NM; ++mm) { const int cnt = (rows[mm] / 32) * (Ks[mm] / 64); if (m == mm && r >= cnt) { r -= cnt; m = mm + 1; } }
        int K = 1024, nkb = 16;
        if (m == 5 || m == 6) { K = 4096; nkb = 64; } else if (m == 9) { K = 2048; nkb = 32; } else if (m == 10) { K = 256; nkb = 4; }
        const int nb = r / nkb, kb = r % nkb, R0 = nb * 32, k0 = kb * 64;
        const float* W; int ldw, col, nvalid = 32; const float* gain = nullptr; bf16* WT;
        if (m == 0) { W = P.in[I_AWIN]; ldw = 1792; gain = P.in[I_NMIX]; WT = (bf16*)(ws + WS_WA);
            const int j = R0 >> 8, p = R0 & 255; col = j < 6 ? (p < 128 ? 128 * j + p : 768 + 128 * j + p - 128) : 1536 + hp(p); }
        else if (m <= 2) { W = P.in[I_WOUT] + (size_t)(m - 1) * D * D; ldw = D; col = R0; WT = (bf16*)(ws + WS_WO) + (size_t)(m - 1) * D * D; }
        else if (m <= 4) { W = P.in[I_WMLPIN] + (size_t)(m - 3) * D * FF; ldw = FF; col = R0; gain = P.in[I_NMLP] + (m - 3) * D; WT = (bf16*)(ws + WS_W1) + (size_t)(m - 3) * D * FF; }
        else if (m <= 6) { W = P.in[I_WMLPOUT] + (size_t)(m - 5) * D * FF; ldw = D; col = R0; WT = (bf16*)(ws + WS_W2) + (size_t)(m - 5) * D * FF; }
        else if (m == 7) { WT = (bf16*)(ws + WS_WB);
            if (R0 < 768) { W = P.in[I_WKV]; ldw = 768; col = (R0 & ~255) + hp(R0 & 255); gain = P.in[I_KVNG]; }
            else { const int uc = R0 - 768, uj = uc >> 8, p = uc & 255; W = P.in[I_BWIN]; ldw = 1060; gain = P.in[I_NMIX] + D; col = uj < 4 ? uj * 256 + hp(p) : 1024 + p;
                   nvalid = 1060 - col; nvalid = nvalid < 0 ? 0 : (nvalid > 32 ? 32 : nvalid); if (nvalid == 0) col = 0; } }
        else if (m == 8) { const int un = R0 >> 8, p = R0 & 255; W = P.in[I_WMEMKV] + (size_t)(un >> 1) * D * 512; ldw = 512; col = (un & 1) * 256 + hp(p); gain = P.in[I_MEMN]; WT = (bf16*)(ws + WS_WM); }
        else if (m == 9) { W = (R0 >> 8) ? P.in[I_W1V] : P.in[I_W1K]; ldw = 256; col = R0 & 255; WT = (bf16*)(ws + WS_W1C) + (size_t)((R0 >> 8) * 4 + (k0 >> 9)) * 256 * 512; }
        else { W = (R0 >> 6) ? P.in[I_W2V] : P.in[I_W2K]; ldw = 64; col = R0 & 63; WT = (bf16*)(ws + WS_W2C); }
        if (m == 9) tr_item(W + (size_t)(k0 & ~511) * ldw, ldw, col, nvalid, gain, WT, 512, R0 & 255, k0 & 511, scr, lane);
        else tr_item(W, ldw, col, nvalid, gain, WT, K, R0, k0, scr, lane);
    }
    for (int r2 = gw; r2 < (S + MEML) / 2; r2 += NGW) { const int r = 2 * r2;
        if (r < S) rms_rows2_to_bf16(P.in[I_X] + (size_t)r * D, (bf16*)(ws + WS_XB) + (size_t)r * D, (float*)(ws + WS_SS) + 3 * S + r, lane);
        else rms_rows2_to_bf16(P.in[I_MEM] + (size_t)(r - S) * D, (bf16*)(ws + WS_MEMB) + (size_t)(r - S) * D, nullptr, lane);
    }
    const int gt = gw * 64 + lane, NGT = NGW * 64;
    for (int i = gt; i < 3 * S; i += NGT) ((float*)(ws + WS_SS))[i] = 0.f;
    for (int i = gt; i < 2 * 64 * 256; i += NGT) { const int type = i >> 14, kc = (i >> 8) & 63, c = i & 255;
        const float* pe = P.in[type ? I_PEV : I_PEK] + kc * 32; const float* w1 = P.in[type ? I_W1V : I_W1K] + (size_t)kc * 32 * 256 + c; float s = 0.f;
#pragma unroll 8
        for (int k = 0; k < 32; ++k) s += pe[k] * w1[(size_t)k * 256];
        ((float*)(ws + WS_BPART))[i] = s; }
}

DI f32x16 mfma32(bf16x8 a, bf16x8 b, f32x16 c) { return __builtin_amdgcn_mfma_f32_32x32x16_bf16(a, b, c, 0, 0, 0); }
DI f32x4 mfma16(bf16x8 a, bf16x8 b, f32x4 c) { return __builtin_amdgcn_mfma_f32_16x16x32_bf16(a, b, c, 0, 0, 0); }
DI float gain_max(const float* g, int lane) { return wave_max(fabsf(g[lane])); }
DI void conv_task(const Params& P, int t0, int lane) {
    const bf16* vg = (const bf16*)(P.ws + WS_VGLU); const float* dw = P.in[I_ADW]; bf16* mix = (bf16*)(P.ws + WS_MIX);
    f32x4 acc[4][3];
#pragma unroll
    for (int i = 0; i < 3; ++i) { const f32x4 b = *(const f32x4*)(P.in[I_ADWB] + 4 * lane + 256 * i);
#pragma unroll
        for (int tt = 0; tt < 4; ++tt) acc[tt][i] = b; }
    f32x4 vr[4][3];
#define CONV_LDROW(dst, rr) do { _Pragma("unroll") for (int i = 0; i < 3; ++i) { u32x2 raw = *(const u32x2*)(vg + (size_t)((rr) >= 0 ? (rr) : 0) * 768 + 4 * lane + 256 * i); if ((rr) < 0) { raw.x = 0u; raw.y = 0u; } \
        dst[i] = (f32x4){__uint_as_float(raw.x << 16), __uint_as_float(raw.x & 0xffff0000u), __uint_as_float(raw.y << 16), __uint_as_float(raw.y & 0xffff0000u)}; } } while (0)
    CONV_LDROW(vr[0], t0 - 30); CONV_LDROW(vr[1], t0 - 29); CONV_LDROW(vr[2], t0 - 28);
#pragma unroll 8
    for (int j = 0; j < 31; ++j) {
        CONV_LDROW(vr[3], t0 - 27 + j);
        f32x4 w[3];
#pragma unroll
        for (int i = 0; i < 3; ++i) w[i] = *(const f32x4*)(dw + (size_t)j * 768 + 4 * lane + 256 * i);
#pragma unroll
        for (int tt = 0; tt < 4; ++tt)
#pragma unroll
            for (int i = 0; i < 3; ++i) acc[tt][i] += vr[tt][i] * w[i];
#pragma unroll
        for (int i = 0; i < 3; ++i) { vr[0][i] = vr[1][i]; vr[1][i] = vr[2][i]; vr[2][i] = vr[3][i]; }
    }
#undef CONV_LDROW
    f32x4 lg[3], lb[3];
#pragma unroll
    for (int i = 0; i < 3; ++i) { lg[i] = *(const f32x4*)(P.in[I_ALNG] + 4 * lane + 256 * i); lb[i] = *(const f32x4*)(P.in[I_ALNB] + 4 * lane + 256 * i); }
#pragma unroll
    for (int tt = 0; tt < 4; ++tt) {
        float s = 0.f;
#pragma unroll
        for (int i = 0; i < 3; ++i) s += (acc[tt][i][0] + acc[tt][i][1]) + (acc[tt][i][2] + acc[tt][i][3]);
        const float mean = wave_sum(s) * (1.0f / 768.0f); float q = 0.f;
#pragma unroll
        for (int i = 0; i < 3; ++i) { const f32x4 d = acc[tt][i] - mean; q += (d[0] * d[0] + d[1] * d[1]) + (d[2] * d[2] + d[3] * d[3]); }
        const float rstd = __builtin_amdgcn_rsqf(wave_sum(q) * (1.0f / 768.0f) + 1e-5f);
#pragma unroll
        for (int i = 0; i < 3; ++i) { f32x4 y = (acc[tt][i] - mean) * rstd * lg[i] + lb[i];
#pragma unroll
            for (int e = 0; e < 4; ++e) y[e] = y[e] * sigmoidf_(y[e]);
            st_bf16x4(mix + (size_t)(t0 + tt) * D + 4 * lane + 256 * i, y); }
    }
}

DI void cmp2_task(const Params& P, int task, int lane) {
    const int r = lane & 31, h = lane >> 5; const int row0 = task * 32; const int type = row0 >> 11, g = (row0 >> 10) & 1, n0 = row0 & 1023;
    const float* part = (const float*)(P.ws + WS_PART) + (size_t)(row0 + r) * 256 + 8 * h; const float* bb = (const float*)(P.ws + WS_BIAS1) + type * 256 + 8 * h;
    const bf16* w2 = (const bf16*)(P.ws + WS_W2C) + (size_t)type * 64 * 256;
    f32x16 O0, O1;
#pragma unroll
    for (int i = 0; i < 16; ++i) { O0[i] = 0.f; O1[i] = 0.f; }
#pragma unroll 4
    for (int s = 0; s < 16; ++s) {
        f32x4 a0 = *(const f32x4*)(bb + 16 * s), a1 = *(const f32x4*)(bb + 16 * s + 4);
#pragma unroll
        for (int kc = 0; kc < 4; ++kc) { a0 += *(const f32x4*)(part + (size_t)kc * 4096 * 256 + 16 * s); a1 += *(const f32x4*)(part + (size_t)kc * 4096 * 256 + 16 * s + 4); }
#pragma unroll
        for (int e = 0; e < 4; ++e) { float x = a0[e]; a0[e] = x * sigmoidf_(1.5957691216f * (x + 0.044715f * x * x * x)); x = a1[e]; a1[e] = x * sigmoidf_(1.5957691216f * (x + 0.044715f * x * x * x)); }
        u32x4 hw; hw.x = pk2(a0[0], a0[1]); hw.y = pk2(a0[2], a0[3]); hw.z = pk2(a1[0], a1[1]); hw.w = pk2(a1[2], a1[3]);
        const bf16x8 hb = __builtin_bit_cast(bf16x8, hw);
        O0 = mfma32(*(const bf16x8*)(w2 + (size_t)r * 256 + 16 * s + 8 * h), hb, O0);
        O1 = mfma32(*(const bf16x8*)(w2 + (size_t)(32 + r) * 256 + 16 * s + 8 * h), hb, O1);
    }
    if (type == 0) {
        float s = 0.f;
#pragma unroll
        for (int i = 0; i < 16; ++i) s += O0[i] * O0[i] + O1[i] * O1[i];
        s += __shfl_xor(s, 32);
        const float rs = __builtin_amdgcn_rsqf(s * (1.0f / 64.0f) + EPS);
        const int nk = n0 + r; bf16* kp = (bf16*)(P.ws + WS_KCMP) + ((size_t)g * 16 + (nk >> 6)) * 4096; const float* kg = P.in[I_KNG] + 4 * h;
#pragma unroll
        for (int q4 = 0; q4 < 4; ++q4) {
            const f32x4 g0 = *(const f32x4*)(kg + 8 * q4), g1 = *(const f32x4*)(kg + 32 + 8 * q4);
            st_bf16x4(kp + kimg(nk & 63, 4 * h + 8 * q4), (f32x4){O0[4 * q4], O0[4 * q4 + 1], O0[4 * q4 + 2], O0[4 * q4 + 3]} * rs * g0);
            st_bf16x4(kp + kimg(nk & 63, 32 + 4 * h + 8 * q4), (f32x4){O1[4 * q4], O1[4 * q4 + 1], O1[4 * q4 + 2], O1[4 * q4 + 3]} * rs * g1);
        }
    } else {
        const int nn = n0 + r; bf16* vp = (bf16*)(P.ws + WS_VTCMP) + ((size_t)g * 16 + (nn >> 6)) * 4096;
#pragma unroll
        for (int i = 0; i < 16; ++i) { const int c = (i & 3) + 8 * (i >> 2) + 4 * h;
            vp[vimg(c, nn & 63)] = (bf16)(pk2(O0[i], 0.f) & 0xffffu); vp[vimg(c + 32, nn & 63)] = (bf16)(pk2(O1[i], 0.f) & 0xffffu); }
    }
}

struct KV32 { bf16x8 k[4]; s16x4 v[8]; };
DI void kv32_load(KV32& d, const bf16* Kb, const bf16* VT, int key0, int r, int h) {
    const int ln = h * 32 + r; const size_t blk = (size_t)(key0 >> 6) * 4096; const int sub = (key0 >> 5) & 1;
    const bf16* kp = Kb + blk + sub * 2048 + ln * 8;
#pragma unroll
    for (int s = 0; s < 4; ++s) d.k[s] = *(const bf16x8*)(kp + s * 512);
    const bf16* vp = VT + blk + sub * 2048 + ln * 8;
#pragma unroll
    for (int i = 0; i < 4; ++i) { const bf16x8 w = *(const bf16x8*)(vp + i * 512); d.v[2 * i] = __builtin_shufflevector(w, w, 0, 1, 2, 3); d.v[2 * i + 1] = __builtin_shufflevector(w, w, 4, 5, 6, 7); }
}
DI float opaque_zero() { float z; asm volatile("v_mov_b32 %0, 0" : "=v"(z)); return z; }
DI f32x16 tile_qk(const KV32& d, const bf16x8 (&qf)[4], float c0) {
    f32x16 sc; const float c = c0 + opaque_zero();
#pragma unroll
    for (int i = 0; i < 16; ++i) sc[i] = c;
#pragma unroll
    for (int s = 0; s < 4; ++s) sc = mfma32(d.k[s], qf[s], sc);
    return sc;
}
DI void tile_pv(const KV32& d, const float (&p)[16], f32x16& O0, f32x16& O1) {
#pragma unroll
    for (int s2 = 0; s2 < 2; ++s2) {
        u32x4 pw; pw.x = pk2(p[8 * s2], p[8 * s2 + 1]); pw.y = pk2(p[8 * s2 + 2], p[8 * s2 + 3]); pw.z = pk2(p[8 * s2 + 4], p[8 * s2 + 5]); pw.w = pk2(p[8 * s2 + 6], p[8 * s2 + 7]);
        const bf16x8 pb = __builtin_bit_cast(bf16x8, pw);
        O0 = mfma32(__builtin_shufflevector(d.v[(s2 * 2) * 2], d.v[(s2 * 2) * 2 + 1], 0, 1, 2, 3, 4, 5, 6, 7), pb, O0);
        O1 = mfma32(__builtin_shufflevector(d.v[(s2 * 2 + 1) * 2], d.v[(s2 * 2 + 1) * 2 + 1], 0, 1, 2, 3, 4, 5, 6, 7), pb, O1);
    }
}
DI void tile_store(bf16* op, const f32x16& O0, const f32x16& O1, float sc) {
#pragma unroll
    for (int q4 = 0; q4 < 4; ++q4) {
        st_bf16x4(op + 8 * q4, (f32x4){O0[4 * q4], O0[4 * q4 + 1], O0[4 * q4 + 2], O0[4 * q4 + 3]} * sc);
        st_bf16x4(op + 32 + 8 * q4, (f32x4){O1[4 * q4], O1[4 * q4 + 1], O1[4 * q4 + 2], O1[4 * q4 + 3]} * sc);
    }
}
DI void mem_attn_task(const bf16* Qm, const bf16* mk, const bf16* mvT, bf16* mix, int t0, int head, float Bq, int lane) {
    const int r = lane & 31, h = lane >> 5;
    bf16x8 qf[4];
#pragma unroll
    for (int s = 0; s < 4; ++s) qf[s] = *(const bf16x8*)(Qm + (size_t)(t0 + r) * 256 + head * 64 + 16 * s + 8 * h);
    const bf16* Kb = mk + (size_t)head * 4 * 4096; const bf16* Vb = mvT + (size_t)head * 4 * 4096;
    f32x16 O0, O1; float l = 0.f;
#pragma unroll
    for (int i = 0; i < 16; ++i) { O0[i] = 0.f; O1[i] = 0.f; }
    KV32 A, B, C;
#define MA_STEP(BUF, st) do { if ((st) < nst) { const f32x16 sc = tile_qk(BUF, qf, -Bq); float p[16]; \
        _Pragma("unroll") for (int i = 0; i < 16; ++i) { p[i] = __builtin_amdgcn_exp2f(sc[i]); l += p[i]; } \
        tile_pv(BUF, p, O0, O1); } { const int _s = (st) + 3 < nst ? (st) + 3 : nst - 1; kv32_load(BUF, Kb, Vb, 32 * _s, r, h); } } while (0)
    const int nst = 8;
    kv32_load(A, Kb, Vb, 0, r, h); kv32_load(B, Kb, Vb, 32, r, h); kv32_load(C, Kb, Vb, 64, r, h);
#pragma unroll 1
    for (int st = 0; st < nst; st += 3) { MA_STEP(A, st); MA_STEP(B, st + 1); MA_STEP(C, st + 2); }
#undef MA_STEP
    l += __shfl_xor(l, 32);
    tile_store(mix + (size_t)(t0 + r) * D + 768 + head * 64 + 4 * h, O0, O1, 1.0f / l);
}
DI void mem_attn_phase(const Params& P, int layer, const bf16* Qm, int gw, int NGW, int lane) {
    if (gw < 0) return;
    const bf16* mk = (const bf16*)(P.ws + WS_MK) + (size_t)layer * 4 * 256 * 64; const bf16* mvT = (const bf16*)(P.ws + WS_MVT) + (size_t)layer * 4 * 64 * 256;
    const float Bq = BNDC * gain_max(P.in[I_MQG] + layer * 64, lane) * gain_max(P.in[I_MKG] + layer * 64, lane) * 1.02f;
    for (int task = gw; task < (S / 32) * 4; task += NGW) mem_attn_task(Qm, mk, mvT, (bf16*)(P.ws + WS_MIX), (task >> 2) * 32, task & 3, Bq, lane);
}

DI void cmp_tile_task(const Params& P, int qt, int g, float Bc, LAS float* wl, LAS bf16x8* qL, int lane) {
    unsigned char* ws = P.ws;
    const int r = lane & 31, h = lane >> 5, t = 32 * qt + r;
    const int nv = t >= 31 ? ((t - 31) >> 4) + 1 : 0;
    const int tl = 32 * qt + 31, nvmax = tl >= 31 ? ((tl - 31) >> 4) + 1 : 0, nsteps = (nvmax + 31) >> 5;
    const int tf = 32 * qt, nvmin = tf >= 31 ? ((tf - 31) >> 4) + 1 : 0;
    const bf16* Kc = (const bf16*)(ws + WS_KCMP) + (size_t)g * 1024 * 64; const bf16* Vc = (const bf16*)(ws + WS_VTCMP) + (size_t)g * 64 * 1024;
    const bf16* qrow = (const bf16*)(ws + WS_Q) + (size_t)t * 768 + g * 384 + 8 * h;
    bf16* oc = (bf16*)(ws + WS_OC) + (size_t)t * 768 + g * 384 + 4 * h;
    const float* gp = (const float*)(ws + WS_GATES) + (size_t)t * 36 + g * 18;
    for (int hh = 0; hh < 6; ++hh) {
        bf16x8 qf[4];
#pragma unroll
        for (int s = 0; s < 4; ++s) qf[s] = *(const bf16x8*)(qrow + hh * 64 + 16 * s);
        f32x16 O0, O1; float l = 0.f;
#pragma unroll
        for (int i = 0; i < 16; ++i) { O0[i] = 0.f; O1[i] = 0.f; }
        KV32 A, B, C;
#define CA_LD(BUF, st) do { const int _s = (st) < nsteps ? (st) : nsteps - 1; kv32_load(BUF, Kc, Vc, 32 * _s, r, h); } while (0)
#define CA_STEP(BUF, st) do { if ((st) < nsteps) { const f32x16 sc = tile_qk(BUF, qf, -Bc); float p[16]; \
        if (32 * (st) + 32 <= nvmin) { _Pragma("unroll") for (int i = 0; i < 16; ++i) { p[i] = __builtin_amdgcn_exp2f(sc[i]); l += p[i]; } } \
        else { _Pragma("unroll") for (int i = 0; i < 16; ++i) { const int key = 32 * (st) + (i & 3) + 8 * (i >> 2) + 4 * h; p[i] = key < nv ? __builtin_amdgcn_exp2f(sc[i]) : 0.f; l += p[i]; } } \
        tile_pv(BUF, p, O0, O1); } CA_LD(BUF, (st) + 3); } while (0)
        if (nsteps > 0) {
        CA_LD(A, 0); CA_LD(B, 1); CA_LD(C, 2);
        for (int st = 0; st < nsteps; st += 3) { CA_STEP(A, st); CA_STEP(B, st + 1); CA_STEP(C, st + 2); }
        }
#undef CA_LD
#undef CA_STEP
        l += __shfl_xor(l, 32);
        const float inv = l > 0.f ? 1.0f / l : 0.f;
        wl[hh * 32 + r] = inv;
        tile_store(oc + hh * 64, O0, O1, inv * gp[hh * 3]);
    }
    LDS_WAIT();
    float* impr = (float*)(ws + WS_IMP) + ((size_t)t * 2 + g) * 256 + h;
    bf16x8 q3[3][4]; float inv6[6];
#pragma unroll
    for (int hh = 0; hh < 6; ++hh) { const float iv = wl[hh * 32 + r]; inv6[hh] = iv > 0.f ? __builtin_amdgcn_logf(iv) - Bc : -1e30f; }
#pragma unroll
    for (int hh = 0; hh < 3; ++hh)
#pragma unroll
        for (int s = 0; s < 4; ++s) { q3[hh][s] = *(const bf16x8*)(qrow + hh * 64 + 16 * s); qL[(hh * 4 + s) * 64] = *(const bf16x8*)(qrow + (3 + hh) * 64 + 16 * s); }
    LDS_WAIT();
    float carry = 0.f;
    bf16x8 kf[4], kn[4];
    { const bf16* kp = Kc + (h * 32 + r) * 8;
#pragma unroll
      for (int s = 0; s < 4; ++s) kf[s] = *(const bf16x8*)(kp + s * 512); }
    for (int st = 0; st < nsteps; ++st) {
        { const int sn = st + 1 < nsteps ? st + 1 : st; const bf16* kp = Kc + (size_t)(sn >> 1) * 4096 + (sn & 1) * 2048 + (h * 32 + r) * 8;
#pragma unroll
            for (int s = 0; s < 4; ++s) kn[s] = *(const bf16x8*)(kp + s * 512); }
        asm volatile("" ::: "memory");
        float Ps[16];
#pragma unroll
        for (int i = 0; i < 16; ++i) Ps[i] = 0.f;
#pragma unroll
        for (int hh = 0; hh < 6; ++hh) {
            f32x16 sc; const float c = inv6[hh] + opaque_zero();
#pragma unroll
            for (int i = 0; i < 16; ++i) sc[i] = c;
            if (hh < 3) {
#pragma unroll
                for (int s = 0; s < 4; ++s) sc = mfma32(kf[s], q3[hh][s], sc);
            } else {
#pragma unroll
                for (int s = 0; s < 4; ++s) sc = mfma32(kf[s], qL[((hh - 3) * 4 + s) * 64], sc);
            }
            if (32 * st + 32 <= nvmin) {
#pragma unroll
                for (int i = 0; i < 16; ++i) Ps[i] += __builtin_amdgcn_exp2f(sc[i]);
            } else {
#pragma unroll
                for (int i = 0; i < 16; ++i) { const int key = 32 * st + (i & 3) + 8 * (i >> 2) + 4 * h; Ps[i] += key < nv ? __builtin_amdgcn_exp2f(sc[i]) : 0.f; }
            }
        }
        float y[4], val[4];
#pragma unroll
        for (int q4 = 0; q4 < 4; ++q4) { y[q4] = __shfl_xor(Ps[4 * q4 + 3], 32); val[q4] = 2.0f * (Ps[4 * q4] + Ps[4 * q4 + 1] + Ps[4 * q4 + 2]) + Ps[4 * q4 + 3]; }
        if (h == 1) {
#pragma unroll
            for (int q4 = 0; q4 < 4; ++q4) val[q4] += y[q4];
        } else { val[0] += carry; val[1] += y[0]; val[2] += y[1]; val[3] += y[2]; }
        carry = y[3];
#pragma unroll
        for (int q4 = 0; q4 < 4; ++q4) impr[8 * st + 2 * q4] = val[q4];
#pragma unroll
        for (int s = 0; s < 4; ++s) kf[s] = kn[s];
    }
    LDS_WAIT();
}
DI void win_tile_task(const Params& P, int qt, int head, float Bw, int lane) {
    unsigned char* ws = P.ws;
    const int r = lane & 31, h = lane >> 5, t0 = 32 * qt, t = t0 + r, g = head / 6;
    const bf16* Kw = (const bf16*)(ws + WS_KWIN) + (size_t)g * S * 64; const bf16* Vw = (const bf16*)(ws + WS_VTWIN) + (size_t)g * 64 * S;
    const int kstart = t0 >= 512 ? t0 - 512 : 0, nsteps = (t0 + 32 - kstart) >> 5;
    bf16x8 qf[4];
#pragma unroll
    for (int s = 0; s < 4; ++s) qf[s] = *(const bf16x8*)((const bf16*)(ws + WS_Q) + (size_t)t * 768 + head * 64 + 16 * s + 8 * h);
    f32x16 O0, O1; float l = 0.f;
#pragma unroll
    for (int i = 0; i < 16; ++i) { O0[i] = 0.f; O1[i] = 0.f; }
    KV32 cur, nxt;
    kv32_load(cur, Kw, Vw, kstart, r, h);
    for (int st = 0; st < nsteps; ++st) {
        { const int sn = st + 1 < nsteps ? st + 1 : st; kv32_load(nxt, Kw, Vw, kstart + 32 * sn, r, h); }
        const f32x16 sc = tile_qk(cur, qf, -Bw); float p[16];
        if (st > 0 && st + 1 < nsteps) {
#pragma unroll
            for (int i = 0; i < 16; ++i) { p[i] = __builtin_amdgcn_exp2f(sc[i]); l += p[i]; }
        } else {
#pragma unroll
            for (int i = 0; i < 16; ++i) { const int kp = kstart + 32 * st + (i & 3) + 8 * (i >> 2) + 4 * h; p[i] = (kp <= t && kp > t - 512) ? __builtin_amdgcn_exp2f(sc[i]) : 0.f; l += p[i]; }
        }
        tile_pv(cur, p, O0, O1);
        cur = nxt;
    }
    l += __shfl_xor(l, 32);
    const float g2 = ((const float*)(ws + WS_GATES))[(size_t)t * 36 + head * 3 + 2];
    tile_store((bf16*)P.out + (size_t)t * 768 + head * 64 + 4 * h, O0, O1, l > 0.f ? g2 / l : 0.f);
}

DI void sel_sub(const KV32& X, int key0, unsigned mb, const bf16x8 (&qa)[4], const LAS bf16x8* qbl, int kl, int tqa, int tqb, float Bs,
                f32x16& Oa0, f32x16& Oa1, f32x16& Ob0, f32x16& Ob1, float& la, float& lb, int h) {
    if (mb & 15u) {
        const bool vr = kl < 4 && ((mb >> kl) & 1u);
        const f32x16 sc = tile_qk(X, qa, vr ? -Bs : -1e30f); float p[16];
#pragma unroll
        for (int i = 0; i < 16; ++i) { const int key = key0 + (i & 3) + 8 * (i >> 2) + 4 * h; p[i] = key <= tqa ? __builtin_amdgcn_exp2f(sc[i]) : 0.f; la += p[i]; }
        tile_pv(X, p, Oa0, Oa1);
    }
    if (mb >> 4) {
        const bool vr = kl < 4 && ((mb >> (4 + kl)) & 1u);
        bf16x8 qb[4];
#pragma unroll
        for (int s = 0; s < 4; ++s) qb[s] = qbl[s * 64];
        const f32x16 sc = tile_qk(X, qb, vr ? -Bs : -1e30f); float p[16];
#pragma unroll
        for (int i = 0; i < 16; ++i) { const int key = key0 + (i & 3) + 8 * (i >> 2) + 4 * h; p[i] = key <= tqb ? __builtin_amdgcn_exp2f(sc[i]) : 0.f; lb += p[i]; }
        tile_pv(X, p, Ob0, Ob1);
    }
}
DI void sel_out(const Params& P, const f32x16& O0, const f32x16& O1, float l, int t, int head, int h) {
    unsigned char* ws = P.ws;
    l += __shfl_xor(l, 32);
    const float g1 = ((const float*)(ws + WS_GATES))[(size_t)t * 36 + head * 3 + 1];
    const float sc = l > 0.f ? g1 / l : 0.f;
    const size_t off = (size_t)t * 768 + head * 64 + 4 * h;
    bf16* op = (bf16*)(ws + WS_MIX) + (size_t)t * D + head * 64 + 4 * h;
    const bf16* oc = (const bf16*)(ws + WS_OC) + off; const bf16* ow = (const bf16*)P.out + off;
#pragma unroll
    for (int q4 = 0; q4 < 4; ++q4) {
        st_bf16x4(op + 8 * q4, (f32x4){O0[4 * q4], O0[4 * q4 + 1], O0[4 * q4 + 2], O0[4 * q4 + 3]} * sc + ld_bf16x4(oc + 8 * q4) + ld_bf16x4(ow + 8 * q4));
        st_bf16x4(op + 32 + 8 * q4, (f32x4){O1[4 * q4], O1[4 * q4 + 1], O1[4 * q4 + 2], O1[4 * q4 + 3]} * sc + ld_bf16x4(oc + 32 + 8 * q4) + ld_bf16x4(ow + 32 + 8 * q4));
    }
}
DI void sel_unit(const Params& P, int tb, int g, float Bs, LAS unsigned char* lds, int tid, int wave, int lane) {
    unsigned char* ws = P.ws;
    LAS unsigned* mask = (LAS unsigned*)lds;
    mask[tid] = 0u;
    __syncthreads();
    if (tb <= 15) { if (tid <= tb) { mask[2 * tid] = 0xffffffffu; mask[2 * tid + 1] = 0xffffffffu; } }
    else {
        if (tid < 3) { const int j = tid == 0 ? 0 : (tid == 1 ? tb - 1 : tb); mask[2 * j] = 0xffffffffu; mask[2 * j + 1] = 0xffffffffu; }
        for (int k = 0; k < 8; ++k) {
            const int q = wave * 8 + k, t = 64 * tb + q;
            const f32x4 a = *(const f32x4*)((const float*)(ws + WS_IMP) + ((size_t)t * 2 + g) * 256 + 4 * lane);
            unsigned key[4];
#pragma unroll
            for (int e = 0; e < 4; ++e) { const int j = 4 * lane + e; key[e] = (j >= 1 && j <= tb - 2) ? __float_as_uint(a[e]) + 1u : 0u; }
            for (int it = 0; it < 13; ++it) {
                unsigned m = key[0] > key[1] ? key[0] : key[1]; const unsigned m2 = key[2] > key[3] ? key[2] : key[3]; m = m > m2 ? m : m2;
                const unsigned wm = wave_max_u32(m);
                const unsigned long long bal = __ballot(m == wm);
                const int src = __ffsll((long long)bal) - 1;
                if (lane == src) {
                    const int e = key[0] == wm ? 0 : (key[1] == wm ? 1 : (key[2] == wm ? 2 : 3));
                    __hip_atomic_fetch_or(mask + 2 * (4 * lane + e) + (q >> 5), 1u << (q & 31), __ATOMIC_RELAXED, __HIP_MEMORY_SCOPE_WORKGROUP);
                    key[0] = e == 0 ? 0u : key[0]; key[1] = e == 1 ? 0u : key[1]; key[2] = e == 2 ? 0u : key[2]; key[3] = e == 3 ? 0u : key[3];
                }
            }
        }
    }
    __syncthreads();
    const int r = lane & 31, h = lane >> 5;
    const int kl = (r * 43) >> 8, hd = r - 6 * kl, klc = kl < 4 ? kl : 0;
    const int tqa = 64 * tb + wave * 8 + klc, tqb = tqa + 4, head = g * 6 + (kl < 4 ? hd : 0);
    const bf16* Ks = (const bf16*)(ws + WS_KSEL) + (size_t)g * S * 64; const bf16* Vs = (const bf16*)(ws + WS_VTSEL) + (size_t)g * 64 * S;
    bf16x8 qa[4]; LAS bf16x8* qb = (LAS bf16x8*)(lds + 16384 + wave * 4096) + lane;
#pragma unroll
    for (int s = 0; s < 4; ++s) { qa[s] = *(const bf16x8*)((const bf16*)(ws + WS_Q) + (size_t)tqa * 768 + head * 64 + 16 * s + 8 * h);
                                  qb[s * 64] = *(const bf16x8*)((const bf16*)(ws + WS_Q) + (size_t)tqb * 768 + head * 64 + 16 * s + 8 * h); }
    LDS_WAIT();
    f32x16 Oa0, Oa1, Ob0, Ob1; float la = 0.f, lb = 0.f;
#pragma unroll
    for (int i = 0; i < 16; ++i) { Oa0[i] = 0.f; Oa1[i] = 0.f; Ob0[i] = 0.f; Ob1[i] = 0.f; }
    LAS unsigned short* wlist = (LAS unsigned short*)(lds + 2048 + wave * 512);
    int n = 0;
#pragma unroll
    for (int i = 0; i < 4; ++i) { const int jj = 64 * i + lane; unsigned bb = 0u;
        if (jj <= tb) bb = (mask[2 * jj + (wave >> 2)] >> (8 * (wave & 3))) & 0xffu;
        const unsigned long long bal = __ballot(bb != 0u); const int pos = n + __popcll(bal & ((1ull << lane) - 1ull));
        if (bb) wlist[pos] = (unsigned short)(jj | (bb << 8));
        n += __popcll(bal); }
    const int n2 = 2 * __builtin_amdgcn_readfirstlane(n);
    LDS_WAIT();
    KV32 A, B, C;
#define SEL_LD(BUF, pos) do { const int _pp = (pos) < n2 ? (pos) : n2 - 1; const int _e = __builtin_amdgcn_readfirstlane((int)wlist[_pp >> 1]); kv32_load(BUF, Ks, Vs, 64 * (_e & 255) + 32 * (_pp & 1), r, h); } while (0)
#define SEL_STEP(BUF, pos) do { if ((pos) < n2) { const int _e = __builtin_amdgcn_readfirstlane((int)wlist[(pos) >> 1]); \
        sel_sub(BUF, 64 * (_e & 255) + 32 * ((pos) & 1), (unsigned)_e >> 8, qa, qb, kl, tqa, tqb, Bs, Oa0, Oa1, Ob0, Ob1, la, lb, h); } SEL_LD(BUF, (pos) + 3); } while (0)
    if (n2 > 0) {
        SEL_LD(A, 0); SEL_LD(B, 1); SEL_LD(C, 2);
        for (int p = 0; p < n2; p += 3) { SEL_STEP(A, p); SEL_STEP(B, p + 1); SEL_STEP(C, p + 2); }
    }
#undef SEL_LD
#undef SEL_STEP
    if (kl < 4) { sel_out(P, Oa0, Oa1, la, tqa, head, h); sel_out(P, Ob0, Ob1, lb, tqb, head, h); }
    __syncthreads();
}

#define XB_TMO      128
#define XB_XCNT(j)  (256  + 64 * (j))
#define XB_XSUB(j)  (1280 + 64 * (j))
#define XB_XGEN(j)  (2304 + 64 * (j))
#define XB_TOP      3328
#define XB_TOPGEN   3392
#define XCD_BAR_WORDS 3456
#define XB_SPIN_CAP (1u << 18)

__device__ __forceinline__ unsigned xb_ld(unsigned* p)              { return __hip_atomic_load(p, __ATOMIC_RELAXED, __HIP_MEMORY_SCOPE_AGENT); }
__device__ __forceinline__ unsigned xb_add(unsigned* p, unsigned v) { return __hip_atomic_fetch_add(p, v, __ATOMIC_RELAXED, __HIP_MEMORY_SCOPE_AGENT); }
__device__ __forceinline__ unsigned xb_xcc_id() { return (unsigned)__builtin_amdgcn_s_getreg((3 << 11) | 20) & 0xFu; }
#define XB_SPIN(cond, bar) do { unsigned _sp = 0; while (cond) { __builtin_amdgcn_s_sleep(1); \
    if ((++_sp & 255u) == 0u) { if (xb_ld(&(bar)[XB_TMO])) break; if (_sp > XB_SPIN_CAP) { atomicAdd(&(bar)[XB_TMO], 1u); break; } } } } while (0)

struct XcdBarrier {
    unsigned* bar; unsigned x;
    volatile LAS unsigned* st;
};

__device__ __forceinline__ XcdBarrier xcd_barrier_post(unsigned* bar, volatile LAS unsigned* st) {
    XcdBarrier b; b.bar = bar; b.x = xb_xcc_id(); b.st = st;
    if (threadIdx.x == 0) (void)xb_add(&bar[XB_XCNT(b.x)], 1u);
    return b;
}
__device__ __forceinline__ void xcd_barrier_complete(unsigned* bar, unsigned x, unsigned& nloc, unsigned& nx) {
    const unsigned G = gridDim.x * gridDim.y * gridDim.z;
    unsigned sum, cnt, mine, sp = 0u;
    for (;;) {
        sum = 0u; cnt = 0u; mine = 0u;
#pragma unroll
        for (unsigned j = 0; j < 16; ++j) { const unsigned c = xb_ld(&bar[XB_XCNT(j)]); sum += c; cnt += (c > 0u) ? 1u : 0u; mine = (j == x) ? c : mine; }
        if (sum == G) break;
        __builtin_amdgcn_s_sleep(1);
        if ((++sp & 255u) == 0u) { if (xb_ld(&bar[XB_TMO])) break; if (sp > XB_SPIN_CAP) { atomicAdd(&bar[XB_TMO], 1u); break; } }
    }
    nloc = mine > 0u ? mine : 1u; nx = cnt > 0u ? cnt : 1u;
}

__device__ __forceinline__ void xcd_barrier(const XcdBarrier& b) {
    asm volatile("s_waitcnt vmcnt(0)" ::: "memory");
    __syncthreads();
    if (threadIdx.x == 0) {
        unsigned* bar = b.bar;
        __builtin_amdgcn_s_waitcnt(0);
        unsigned nloc = b.st[0], nx = b.st[1];
        if (nloc == 0u) { xcd_barrier_complete(bar, b.x, nloc, nx); b.st[0] = nloc; b.st[1] = nx; }
        const unsigned old = xb_add(&bar[XB_XSUB(b.x)], 1u);
        const unsigned gen = old / nloc;
        if (old + 1u == (gen + 1u) * nloc) {
            __builtin_amdgcn_fence(__ATOMIC_RELEASE, "agent");
            asm volatile("s_waitcnt vmcnt(0)" ::: "memory");
            const unsigned og = xb_add(&bar[XB_TOP], 1u);
            const unsigned tg = og / nx;
            if (og + 1u == (tg + 1u) * nx) xb_add(&bar[XB_TOPGEN], 1u);
            else XB_SPIN(xb_ld(&bar[XB_TOPGEN]) == tg, bar);
            __builtin_amdgcn_fence(__ATOMIC_ACQUIRE, "agent");
            xb_add(&bar[XB_XGEN(b.x)], 1u);
            asm volatile("s_waitcnt vmcnt(0)" ::: "memory");
        } else {
            XB_SPIN(xb_ld(&bar[XB_XGEN(b.x)]) == gen, bar);
            __builtin_amdgcn_fence(__ATOMIC_ACQUIRE, "agent");
            asm volatile("s_waitcnt vmcnt(0)" ::: "memory");
        }
    }
    __syncthreads();
}

__global__ void __launch_bounds__(NWAVES * 64, 2) yoco_fwd(Params P) {
    extern __shared__ __attribute__((aligned(16))) unsigned char lds_raw[];
    LAS unsigned char* lds = (LAS unsigned char*)lds_raw;
    const int tid = threadIdx.x, lane = tid & 63, wave = __builtin_amdgcn_readfirstlane(tid >> 6);
    const int G = gridDim.x, bx = blockIdx.x;
    const int gw = bx * NWAVES + wave, NGW = G * NWAVES;
    unsigned char* ws = P.ws;
    const int lo = P.ph_lo, hi = P.ph_hi;
#ifndef PH_MASK
#define PH_MASK 0x3fff
#endif
#define IN(k) (((PH_MASK >> (k)) & 1) && lo <= (k) && (k) < hi)
    volatile LAS unsigned* xst = (volatile LAS unsigned*)(lds + LDS_BYTES - 64);
    if (tid < 2) xst[tid] = 0u;
    __syncthreads();
    const XcdBarrier xbar = xcd_barrier_post((unsigned*)(ws + WS_CNT) + 1024, xst);
#define SEAM(k) do { if (IN(k) && IN((k) + 1)) { { xcd_barrier(xbar); } } } while (0)
    float* ss1 = (float*)(ws + WS_SS); float* ss2 = ss1 + S; float* ss3 = ss2 + S;
    bf16* xb = (bf16*)(ws + WS_XB); bf16* mix = (bf16*)(ws + WS_MIX); bf16* hb = (bf16*)(ws + WS_HB);

    if (IN(0)) { p0_prologue(P, lds, gw, NGW, wave, lane); __syncthreads(); }
    SEAM(0);
    if (IN(1)) {
        { pg8::Gemm g{xb, (const bf16*)(ws + WS_WA), S, 1792, D, D}; pg8::StaticOrder So; So.init(S, 1792, G, bx);
          EpiA E{(bf16*)(ws + WS_VGLU), (bf16*)(ws + WS_QM0), P.in[I_ABGLU], P.in[I_MQG], ss1 + 3 * S};
          pg8::gemm_phase<EpiA, pg8::StaticOrder, true>(lds, g, So, E); }
        { pg8::Gemm g{(const bf16*)(ws + WS_MEMB), (const bf16*)(ws + WS_WM), 256, 1024, D, D};
          const int c = G >= 4 ? bx - (G - 4) : bx; pg8::ListOrder So{4, 4, G >= 4 ? 4 : G, c, 0};
          EpiMem E{(bf16*)(ws + WS_MK), (bf16*)(ws + WS_MVT), P.in[I_MKG]};
          pg8::gemm_phase<EpiMem, pg8::ListOrder, true>(lds, g, So, E); }
    }
    SEAM(1);
    if (IN(2)) {
        for (int task = gw; task < S / 4; task += NGW) conv_task(P, task * 4, lane);
        mem_attn_phase(P, 0, (const bf16*)(ws + WS_QM0), gw, NGW, lane);
        if (bx == 0) { const int i = tid; float s = 0.f; const float* bp = (const float*)(ws + WS_BPART) + (i >> 8) * 64 * 256 + (i & 255);
            for (int kc = 0; kc < 64; ++kc) s += bp[kc * 256];
            ((float*)(ws + WS_BIAS1))[i] = s; }
    }
    SEAM(2);
    if (IN(3)) { pg8::Gemm g{mix, (const bf16*)(ws + WS_WO), S, D, D, D}; pg8::StaticOrder So; So.init(S, D, G, bx);
        EpiRes E{nullptr, xb, nullptr, xb, ss1, 0}; pg8::gemm_phase<EpiRes, pg8::StaticOrder, true>(lds, g, So, E); }
    SEAM(3);
    if (IN(4)) { pg8::Gemm g{xb, (const bf16*)(ws + WS_W1), S, FF, D, D}; pg8::StaticOrder So; So.init(S, FF, G, bx);
        EpiMlpIn E{hb, ss1}; pg8::gemm_phase<EpiMlpIn, pg8::StaticOrder, true>(lds, g, So, E); }
    SEAM(4);
    if (IN(5)) { pg8::Gemm g{hb, (const bf16*)(ws + WS_W2), S, D, FF, FF}; pg8::StaticOrder So; So.init(S, D, G, bx);
        EpiRes E{nullptr, xb, nullptr, xb, ss2, 0}; pg8::gemm_phase<EpiRes, pg8::StaticOrder, true>(lds, g, So, E); }
    SEAM(5);
    if (IN(6)) {
        if (bx == 0 && tid < 512) ((unsigned*)(ws + WS_CBUF + (size_t)4 * S * 64 * 2))[tid] = 0u;
        pg8::Gemm g{xb, (const bf16*)(ws + WS_WB), S, 2048, D, D}; pg8::StaticOrder So; So.init(S, 2048, G, bx);
        EpiB E{ss2, (bf16*)(ws + WS_CBUF), (bf16*)(ws + WS_KSEL), (bf16*)(ws + WS_VTSEL), (bf16*)(ws + WS_KWIN), (bf16*)(ws + WS_VTWIN), (bf16*)(ws + WS_Q), (bf16*)(ws + WS_QM1),
               (float*)(ws + WS_GATES), P.in[I_KNG], P.in[I_BQG], P.in[I_MQG] + 64, P.in[I_BGATEB]};
        pg8::gemm_phase<EpiB, pg8::StaticOrder, true>(lds, g, So, E); }
    SEAM(6);
    if (IN(7)) {
        { pg8::Gemm g{(const bf16*)(ws + WS_CBUF), (const bf16*)(ws + WS_W1C), 4096, 2048, 512, 1024}; pg8::ListOrder So{64, 1, G, bx, 1};
          EpiC E{(float*)(ws + WS_PART)}; pg8::gemm_phase<EpiC, pg8::ListOrder, true>(lds, g, So, E); }
        if (G > 128) mem_attn_phase(P, 1, (const bf16*)(ws + WS_QM1), bx >= 64 ? gw - 64 * NWAVES : -1, NGW - 64 * NWAVES, lane);
        else mem_attn_phase(P, 1, (const bf16*)(ws + WS_QM1), gw, NGW, lane);
    }
    SEAM(7);
    if (IN(8)) { for (int task = gw; task < 128; task += NGW) cmp2_task(P, task, lane); }
    SEAM(8);
    if (IN(9)) {
        const float gq = gain_max(P.in[I_BQG], lane);
        const float Bc = BNDC * gq * gain_max(P.in[I_KNG], lane) * 1.02f, Bw = BNDC * gq * gain_max(P.in[I_KNG] + 128, lane) * 1.02f;
        LAS float* wl = (LAS float*)(lds + wave * 1024);
        unsigned* cq = (unsigned*)(ws + WS_CNT); unsigned* wq = cq + 3;
        volatile LAS unsigned* pflag = (volatile LAS unsigned*)(lds + 120000);
        unsigned idx0 = 0xffffffffu;
        if (wave < 4) { if (lane == 0) idx0 = atomicAdd(cq, 1u); idx0 = (unsigned)__builtin_amdgcn_readfirstlane((int)idx0); if (lane == 0) pflag[wave] = idx0 < 448u ? 1u : 0u; }
        __syncthreads();
        if (wave < 4) {
            if (idx0 < 1024u) cmp_tile_task(P, 511 - (int)(idx0 >> 1), (int)(idx0 & 1u), Bc, wl, (LAS bf16x8*)(lds + 16384 + wave * 12288) + lane, lane);
            if (lane == 0) pflag[wave] = 0u;
        } else {
            while (__builtin_amdgcn_readfirstlane((int)pflag[wave - 4]) != 0) __builtin_amdgcn_s_sleep(32);
        }
        for (int pass = 0; pass < 2; ++pass) {
            const bool do_cmp = (wave < 4) == (pass == 0);
            for (;;) {
                unsigned idx = 0; if (lane == 0) idx = atomicAdd(do_cmp ? cq : wq, 1u); idx = (unsigned)__builtin_amdgcn_readfirstlane((int)idx);
                if (idx >= (do_cmp ? 1024u : 6144u)) break;
                if (do_cmp) cmp_tile_task(P, 511 - (int)(idx >> 1), (int)(idx & 1u), Bc, wl, (LAS bf16x8*)(lds + 16384 + wave * 12288) + lane, lane);
                else win_tile_task(P, (int)(idx / 12u), (int)(idx % 12u), Bw, lane);
            }
        }
        __syncthreads();
    }
    SEAM(9);
    if (IN(10)) {
        const float Bs = BNDC * gain_max(P.in[I_BQG], lane) * gain_max(P.in[I_KNG] + 64, lane) * 1.02f;
        if (G == 256) {
            sel_unit(P, 255 - (bx >> 1), bx & 1, Bs, lds, tid, wave, lane);
            sel_unit(P, bx >> 1, bx & 1, Bs, lds, tid, wave, lane);
        } else {
            for (int i = 0, u = bx; u < 512; ++i, u += G) {
                const int base = i * G, span = (512 - base) < G ? (512 - base) : G;
                const int uu = (i & 1) ? base + span - 1 - (u - base) : u;
                const int v = 511 - uu;
                sel_unit(P, v >> 1, v & 1, Bs, lds, tid, wave, lane);
            }
        }
    }
    SEAM(10);
    if (IN(11)) { pg8::Gemm g{mix, (const bf16*)(ws + WS_WO) + (size_t)D * D, S, D, D, D}; pg8::StaticOrder So; So.init(S, D, G, bx);
        EpiRes E{nullptr, xb, nullptr, xb, ss3, 0}; pg8::gemm_phase<EpiRes, pg8::StaticOrder, true>(lds, g, So, E); }
    SEAM(11);
    if (IN(12)) { pg8::Gemm g{xb, (const bf16*)(ws + WS_W1) + (size_t)D * FF, S, FF, D, D}; pg8::StaticOrder So; So.init(S, FF, G, bx);
        EpiMlpIn E{hb, ss3}; pg8::gemm_phase<EpiMlpIn, pg8::StaticOrder, true>(lds, g, So, E); }
    SEAM(12);
    if (IN(13)) { pg8::Gemm g{hb, (const bf16*)(ws + WS_W2) + (size_t)D * FF, S, D, FF, FF}; pg8::StaticOrder So; So.init(S, D, G, bx);
        EpiRes E{nullptr, xb, P.out, xb, ss3, 1}; pg8::gemm_phase<EpiRes, pg8::StaticOrder, true>(lds, g, So, E); }
    if (P.ph_hi > 1000) cg::this_grid().sync();
#undef IN
#undef SEAM
}

extern "C" void kernel_launch(void* const* d_in, const int* in_sizes, int n_in, void* d_out, int out_size, void* d_ws, size_t ws_size, hipStream_t stream) {
    static int grid = 0;
    if (grid == 0) {
        if (n_in != 29 || out_size != S * D || ws_size < WS_END) { fprintf(stderr, "kernel_launch: unexpected shapes (n_in %d out %d ws %zu)\n", n_in, out_size, ws_size); grid = -1; return; }
        int dev = 0, cus = 0, per_cu = 0;
        hipGetDevice(&dev); hipDeviceGetAttribute(&cus, hipDeviceAttributeMultiprocessorCount, dev);
        hipFuncSetAttribute((const void*)yoco_fwd, hipFuncAttributeMaxDynamicSharedMemorySize, LDS_BYTES);
        hipOccupancyMaxActiveBlocksPerMultiprocessor(&per_cu, (const void*)yoco_fwd, NWAVES * 64, LDS_BYTES);
        if (per_cu < 1) { fprintf(stderr, "kernel_launch: occupancy query reports %d\n", per_cu); per_cu = 1; }
        (void)hipGetLastError();
        grid = cus;
    }
    if (grid < 0) return;
    (void)hipMemsetAsync((char*)d_ws + WS_CNT, 0, 32768, stream);
    Params p{};
    for (int i = 0; i < 29; ++i) p.in[i] = (const float*)d_in[i];
    p.out = (float*)d_out; p.ws = (unsigned char*)d_ws; p.ph_lo = 0; p.ph_hi = 14;
    void* args[] = {&p};
    hipError_t e = hipLaunchCooperativeKernel((const void*)yoco_fwd, dim3(grid), dim3(NWAVES * 64), args, LDS_BYTES, stream);
    if (e != hipSuccess) fprintf(stderr, "cooperative launch failed: %s (grid %d)\n", hipGetErrorString(e), grid);
}
```

```cpp
#include <hip/hip_runtime.h>
#include <hip/hip_cooperative_groups.h>
#include <cstdio>
#include <cstdint>
namespace cg = cooperative_groups;

#define LAS __attribute__((address_space(3)))
typedef unsigned short bf16;
typedef short bf16x8 __attribute__((ext_vector_type(8)));
typedef short s16x4 __attribute__((ext_vector_type(4)));
typedef float f32x2 __attribute__((ext_vector_type(2)));
typedef float f32x4 __attribute__((ext_vector_type(4)));
typedef float f32x16 __attribute__((ext_vector_type(16)));
typedef unsigned u32x2 __attribute__((ext_vector_type(2)));
typedef unsigned u32x4 __attribute__((ext_vector_type(4)));
typedef __bf16 bf16x2_t __attribute__((ext_vector_type(2)));
#define DI __device__ __forceinline__

DI unsigned pk2(float lo, float hi) { f32x2 v = {lo, hi}; bf16x2_t b = __builtin_convertvector(v, bf16x2_t); return __builtin_bit_cast(unsigned, b); }
DI float wave_sum(float v) {
#pragma unroll
    for (int o = 1; o < 64; o <<= 1) v += __shfl_xor(v, o);
    return v;
}
DI float wave_max(float v) {
#pragma unroll
    for (int o = 1; o < 64; o <<= 1) v = fmaxf(v, __shfl_xor(v, o));
    return v;
}
DI unsigned wave_max_u32(unsigned x) {
#define WMX(ctrl, rm) { const unsigned y = (unsigned)__builtin_amdgcn_update_dpp(0, (int)x, ctrl, rm, 0xf, false); x = y > x ? y : x; }
    WMX(0x111, 0xf) WMX(0x112, 0xf) WMX(0x114, 0xf) WMX(0x118, 0xf) WMX(0x142, 0xa) WMX(0x143, 0xc)
#undef WMX
    return (unsigned)__builtin_amdgcn_readlane((int)x, 63);
}
DI float sigmoidf_(float x) { return 1.0f / (1.0f + __expf(-x)); }
#define LDS_WAIT() asm volatile("s_waitcnt lgkmcnt(0)" ::: "memory")

constexpr int S = 16384, D = 1024, FF = 4096, MEML = 256;
constexpr float EPS = 1e-6f;
constexpr float QSCALE = 0.125f * 1.4426950408889634f;
constexpr float BNDC = 64.0f * QSCALE;

namespace pg8 {
#define PG8_LAS __attribute__((address_space(3)))
constexpr int BM = 256, BK = 64, HALF = 128, HTB = HALF * BK * 2, STAGE_BYTES = 8 * HTB, NXCD = 8, WGM = 4;
__host__ __device__ __forceinline__ int lds_byte(int r, int c) { const int st = (r >> 4) * 2 + (c >> 5), rr = r & 15, cc = c & 31, ob = rr * 64 + cc * 2; return st * 1024 + (ob ^ (((ob >> 9) & 1) << 5)); }
__host__ __device__ __forceinline__ void stage_rc(int b, int& R, int& C) { const int st = b / 1024, sb = b % 1024, swz = sb ^ (((sb >> 9) & 1) << 5); R = (st >> 1) * 16 + swz / 64; C = (st & 1) * 32 + (swz % 64) / 2; }
__host__ __device__ __forceinline__ int perm32(int rho) { const int n = rho >> 4, i = rho & 15; return 8 * (i >> 2) + 4 * n + (i & 3); }
struct Unit { int pm, pn; };
struct Gemm { const bf16* A; const bf16* Bt; int M, N, K, lda; };
struct StaticOrder {
    int nM, nN, nwg, G, c;
    __device__ void init(int M, int N, int G_, int c_) { nM = M / BM; nN = N / BM; nwg = nM * nN; G = G_; c = c_; }
    __device__ bool next(int i, Unit& u) const {
        const long L = (long)i * G + c; if (L >= nwg) return false;
        int wgid = (int)L; { const int q = nwg / NXCD, r = nwg % NXCD, xcd = wgid % NXCD, off = wgid / NXCD; wgid = (xcd < r ? xcd * (q + 1) : r * (q + 1) + (xcd - r) * q) + off; }
        const int nig = WGM * nN, gid = wgid / nig, fm = gid * WGM, gsz = (nM - fm) < WGM ? (nM - fm) : WGM;
        u.pm = fm + ((wgid % nig) % gsz); u.pn = (wgid % nig) / gsz; return true;
    }
    __device__ size_t aoff(const Unit&) const { return 0; }
};
struct ListOrder {
    int n, nN, G, c, cmp;
    __device__ bool next(int i, Unit& u) const { const int L = c + i * G; if (c < 0 || L >= n) return false; if (cmp) { u.pm = L >> 2; u.pn = (L >> 5) * 4 + (L & 3); } else { u.pm = L / nN; u.pn = L % nN; } return true; }
    __device__ size_t aoff(const Unit& u) const { return cmp ? (size_t)(u.pn & 3) * 1024 : 0; }
};

template <class Epi, class Sched, bool ALIGN_EPI>
__device__ __forceinline__ void gemm_phase(PG8_LAS unsigned char* lds, const Gemm g, const Sched& S, const Epi& E) {
    const int tid = threadIdx.x, wid = __builtin_amdgcn_readfirstlane(tid >> 6), lane = tid & 63, wr = wid >> 2, wc = wid & 3, fr = lane & 15, fq = lane >> 4;
    const int K = g.K, nt = K / BK, lda = g.lda;
    unsigned voffA[2], voffB[2];
#pragma unroll
    for (int i = 0; i < 2; ++i) { int R, C; stage_rc(tid * 16 + i * 8192, R, C); const int Rb = Epi::PERM ? ((R & ~31) + perm32(R & 31)) : R;
        voffA[i] = (unsigned)(R * lda + C) * 2u; voffB[i] = (unsigned)(Rb * K + C) * 2u; }
    const size_t kstep = (size_t)(BK * 2);
    const size_t hstepA = (size_t)HALF * lda * 2, hstepB = (size_t)HALF * K * 2;
    const size_t tstepA = 2 * hstepA, tstepB = 2 * hstepB;
    const unsigned ldsw = (unsigned)wid * 1024u;
    const int aoff = lds_byte(wr * 64 + fr, fq * 8), boff = lds_byte(wc * 32 + fr, fq * 8);
#define PG8_SA(b, h) (((b) * 2 + (h)) * HTB)
#define PG8_SB(b, h) ((4 + (b) * 2 + (h)) * HTB)
#define PG8_STAGE(bufoff, gbase, voff) do { _Pragma("unroll") for (int _i = 0; _i < 2; ++_i) \
        __builtin_amdgcn_global_load_lds((const unsigned*)((const char*)(gbase) + (voff)[_i]), (PG8_LAS unsigned*)(lds + (bufoff) + ldsw + _i * 8192), 16, 0, 0); } while (0)
#define PG8_LDA(dst, b, h) do { _Pragma("unroll") for (int m = 0; m < 4; ++m) _Pragma("unroll") for (int k = 0; k < 2; ++k) dst[m][k] = *(const PG8_LAS bf16x8*)(lds + PG8_SA(b, h) + aoff + m * 2048 + k * 1024); } while (0)
#define PG8_LDB(dst, b, h) do { _Pragma("unroll") for (int n = 0; n < 2; ++n) _Pragma("unroll") for (int k = 0; k < 2; ++k) dst[n][k] = *(const PG8_LAS bf16x8*)(lds + PG8_SB(b, h) + boff + n * 2048 + k * 1024); } while (0)
#define PG8_MMA(ai, bj, At, Bt) do { __builtin_amdgcn_s_setprio(1); _Pragma("unroll") for (int m = 0; m < 4; ++m) _Pragma("unroll") for (int n = 0; n < 2; ++n) _Pragma("unroll") for (int k = 0; k < 2; ++k) \
        acc[ai][bj][m][n] = __builtin_amdgcn_mfma_f32_16x16x32_bf16(Bt[n][k], At[m][k], acc[ai][bj][m][n], 0, 0, 0); __builtin_amdgcn_s_setprio(0); } while (0)
#define PG8_WAIT_V(n) asm volatile("s_waitcnt vmcnt(" #n ")" ::: "memory")
#define PG8_WAIT_L(n) asm volatile("s_waitcnt lgkmcnt(" #n ")" ::: "memory")
#define PG8_BAR __builtin_amdgcn_s_barrier()
#define PG8_SCHED __builtin_amdgcn_sched_barrier(0)
    Unit cur, nxt; int ui = 0;
    if (!S.next(0, cur)) return;
    f32x4 acc[2][2][4][2];
#pragma unroll
    for (int a = 0; a < 2; ++a)
#pragma unroll
        for (int b = 0; b < 2; ++b)
#pragma unroll
            for (int m = 0; m < 4; ++m)
#pragma unroll
                for (int n = 0; n < 2; ++n) acc[a][b][m][n] = (f32x4){0.f, 0.f, 0.f, 0.f};
    bf16x8 At[4][2], B0[2][2], B1[2][2];
    const char* cA = (const char*)g.A + (size_t)cur.pm * tstepA + S.aoff(cur); const char* cB = (const char*)g.Bt + (size_t)cur.pn * tstepB;
    PG8_STAGE(PG8_SB(0, 0), cB, voffB); PG8_STAGE(PG8_SB(0, 1), cB + hstepB, voffB); PG8_STAGE(PG8_SA(0, 0), cA, voffA); PG8_STAGE(PG8_SA(0, 1), cA + hstepA, voffA);
    if (wr == 1) PG8_BAR;
    PG8_WAIT_V(2); PG8_BAR;
    PG8_STAGE(PG8_SB(1, 0), cB + kstep, voffB); PG8_STAGE(PG8_SA(1, 0), cA + kstep, voffA); PG8_STAGE(PG8_SB(1, 1), cB + hstepB + kstep, voffB);
    PG8_WAIT_V(6); PG8_BAR;
    for (;;) {
        const bool has_next = S.next(ui + 1, nxt);
        const char* nA = has_next ? (const char*)g.A + (size_t)nxt.pm * tstepA + S.aoff(nxt) : cA; const char* nB = has_next ? (const char*)g.Bt + (size_t)nxt.pn * tstepB : cB;
        for (int t = 0; t < nt; t += 2) {
            const bool last = (t == nt - 2);
            const char* a1 = cA + (size_t)(t + 1) * kstep;
            const char* a2 = last ? nA : cA + (size_t)(t + 2) * kstep; const char* b2 = last ? nB : cB + (size_t)(t + 2) * kstep;
            const char* a3 = a2 + kstep; const char* b3 = b2 + kstep;
            PG8_LDB(B0, 0, 0); PG8_LDB(B1, 0, 1); PG8_SCHED; PG8_LDA(At, 0, 0); PG8_STAGE(PG8_SA(1, 1), a1 + hstepA, voffA);
            PG8_WAIT_V(8); PG8_WAIT_L(0); PG8_BAR; PG8_MMA(0, 0, At, B0); PG8_MMA(0, 1, At, B1); PG8_BAR; PG8_SCHED;
            PG8_LDA(At, 0, 1); PG8_STAGE(PG8_SB(0, 0), b2, voffB); PG8_STAGE(PG8_SB(0, 1), b2 + hstepB, voffB); PG8_STAGE(PG8_SA(0, 0), a2, voffA);
            PG8_WAIT_V(8); PG8_WAIT_L(0); PG8_BAR; PG8_MMA(1, 0, At, B0); PG8_MMA(1, 1, At, B1); PG8_BAR; PG8_SCHED;
            PG8_LDB(B0, 1, 0); PG8_LDB(B1, 1, 1); PG8_SCHED; PG8_LDA(At, 1, 0); PG8_STAGE(PG8_SA(0, 1), a2 + hstepA, voffA);
            PG8_WAIT_V(8); PG8_WAIT_L(0); PG8_BAR; PG8_MMA(0, 0, At, B0); PG8_MMA(0, 1, At, B1); PG8_BAR; PG8_SCHED;
            PG8_LDA(At, 1, 1); PG8_STAGE(PG8_SB(1, 0), b3, voffB); PG8_STAGE(PG8_SB(1, 1), b3 + hstepB, voffB); PG8_STAGE(PG8_SA(1, 0), a3, voffA);
            PG8_WAIT_V(8); PG8_WAIT_L(0); PG8_BAR; PG8_MMA(1, 0, At, B0); PG8_MMA(1, 1, At, B1); PG8_BAR; PG8_SCHED;
        }
        if constexpr (ALIGN_EPI) { if (wr == 0) PG8_BAR; }
        E(acc, cur, wr, wc, fr, fq);
        if (!has_next) break;
#pragma unroll
        for (int a = 0; a < 2; ++a)
#pragma unroll
            for (int b = 0; b < 2; ++b)
#pragma unroll
                for (int m = 0; m < 4; ++m)
#pragma unroll
                    for (int n = 0; n < 2; ++n) acc[a][b][m][n] = (f32x4){0.f, 0.f, 0.f, 0.f};
        cur = nxt; cA = nA; cB = nB; ++ui;
        if constexpr (ALIGN_EPI) { if (wr == 1) PG8_BAR; }
    }
    PG8_WAIT_V(0);
    if constexpr (!ALIGN_EPI) { if (wr == 0) PG8_BAR; }
    PG8_BAR;
#undef PG8_SA
#undef PG8_SB
#undef PG8_STAGE
#undef PG8_LDA
#undef PG8_LDB
#undef PG8_MMA
#undef PG8_WAIT_V
#undef PG8_WAIT_L
#undef PG8_BAR
#undef PG8_SCHED
}
}
using pg8::Unit; using pg8::HALF; using pg8::BM;

typedef f32x4 Acc[2][2][4][2];

DI int kimg(int key, int dim) { return ((((key >> 5) & 1) * 4 + (dim >> 4)) * 64 + ((dim >> 3) & 1) * 32 + (key & 31)) * 8 + (dim & 7); }
DI int vimg(int dim, int key) { return (((((key >> 5) & 1) * 2 + ((key >> 4) & 1)) * 2 + (dim >> 5)) * 64 + ((key >> 2) & 1) * 32 + (dim & 31)) * 8 + ((key >> 3) & 1) * 4 + (key & 3); }
DI f32x4 ld_bf16x4(const bf16* p) { const u32x2 raw = *(const u32x2*)p; return (f32x4){__uint_as_float(raw.x << 16), __uint_as_float(raw.x & 0xffff0000u), __uint_as_float(raw.y << 16), __uint_as_float(raw.y & 0xffff0000u)}; }
DI void st_bf16x4(bf16* p, f32x4 v) { u32x2 w; w.x = pk2(v[0], v[1]); w.y = pk2(v[2], v[3]); *(u32x2*)p = w; }

DI float head_rs(const Acc& acc, int ai, int m, float pre) {
    float s = 0.f;
#pragma unroll
    for (int bj = 0; bj < 2; ++bj)
#pragma unroll
        for (int n = 0; n < 2; ++n) { const f32x4 x = acc[ai][bj][m][n] * pre; s += (x[0] * x[0] + x[1] * x[1]) + (x[2] * x[2] + x[3] * x[3]); }
    s += __shfl_xor(s, 16); s += __shfl_xor(s, 32);
    return __builtin_amdgcn_rsqf(s * (1.0f / 64.0f) + EPS);
}

struct EpiA {
    static constexpr bool PERM = true;
    bf16* vglu; bf16* qm; const float* b_glu; const float* qg; const float* ss0;
    DI void operator()(const Acc& acc, const Unit& u, int wr, int wc, int fr, int fq) const {
        const int row0 = u.pm * BM + wr * 64 + fr;
        if (u.pn < 6) {
            const int ch0 = 128 * u.pn + 32 * wc + 8 * fq;
            const f32x4 ba0 = *(const f32x4*)(b_glu + ch0), ba1 = *(const f32x4*)(b_glu + ch0 + 4), bg0 = *(const f32x4*)(b_glu + 768 + ch0), bg1 = *(const f32x4*)(b_glu + 768 + ch0 + 4);
#pragma unroll
            for (int ai = 0; ai < 2; ++ai)
#pragma unroll
                for (int m = 0; m < 4; ++m) {
                    const float rs = __builtin_amdgcn_rsqf(ss0[row0 + ai * HALF + m * 16] * (1.0f / D) + EPS);
                    const f32x4 a0 = acc[ai][0][m][0] * rs + ba0, a1 = acc[ai][0][m][1] * rs + ba1, g0 = acc[ai][1][m][0] * rs + bg0, g1 = acc[ai][1][m][1] * rs + bg1; f32x4 v0, v1;
#pragma unroll
                    for (int e = 0; e < 4; ++e) { v0[e] = a0[e] * sigmoidf_(g0[e]); v1[e] = a1[e] * sigmoidf_(g1[e]); }
                    u32x4 w; w.x = pk2(v0[0], v0[1]); w.y = pk2(v0[2], v0[3]); w.z = pk2(v1[0], v1[1]); w.w = pk2(v1[2], v1[3]);
                    *(u32x4*)(vglu + (size_t)(row0 + ai * HALF + m * 16) * 768 + ch0) = w;
                }
        } else {
#pragma unroll
            for (int ai = 0; ai < 2; ++ai)
#pragma unroll
                for (int m = 0; m < 4; ++m) {
                    const float rs = __builtin_amdgcn_rsqf(ss0[row0 + ai * HALF + m * 16] * (1.0f / D) + EPS);
                    const float r = head_rs(acc, ai, m, rs) * rs * QSCALE;
#pragma unroll
                    for (int bj = 0; bj < 2; ++bj) { const int d0 = 32 * bj + 8 * fq; const f32x4 g0 = *(const f32x4*)(qg + d0), g1 = *(const f32x4*)(qg + d0 + 4);
                        const f32x4 v0 = acc[ai][bj][m][0] * r * g0, v1 = acc[ai][bj][m][1] * r * g1;
                        u32x4 w; w.x = pk2(v0[0], v0[1]); w.y = pk2(v0[2], v0[3]); w.z = pk2(v1[0], v1[1]); w.w = pk2(v1[2], v1[3]);
                        *(u32x4*)(qm + (size_t)(row0 + ai * HALF + m * 16) * 256 + wc * 64 + d0) = w; }
                }
        }
    }
};
struct EpiMem {
    static constexpr bool PERM = false;
    bf16* mk; bf16* mvT; const float* kg;
    DI void operator()(const Acc& acc, const Unit& u, int wr, int wc, int fr, int fq) const {
        const int l = u.pn >> 1, kv = u.pn & 1, row0 = wr * 64 + fr;
#pragma unroll
        for (int ai = 0; ai < 2; ++ai)
#pragma unroll
            for (int m = 0; m < 4; ++m) {
                const int row = row0 + ai * HALF + m * 16;
                if (kv == 0) {
                    const float r = head_rs(acc, ai, m, 1.0f);
#pragma unroll
                    for (int bj = 0; bj < 2; ++bj)
#pragma unroll
                        for (int n = 0; n < 2; ++n) { const int d0 = 32 * bj + 16 * n + 4 * fq; const f32x4 g4 = *(const f32x4*)(kg + l * 64 + d0);
                            st_bf16x4(mk + ((size_t)((l * 4 + wc) * 4 + (row >> 6))) * 4096 + ((row >> 5) & 1) * 2048 + (row & 31) * 8 + (2 * bj + n) * 512 + (fq >> 1) * 256 + 4 * (fq & 1), acc[ai][bj][m][n] * r * g4); }
                } else {
#pragma unroll
                    for (int bj = 0; bj < 2; ++bj)
#pragma unroll
                        for (int n = 0; n < 2; ++n) { const int d0 = 32 * bj + 16 * n + 4 * fq; const f32x4 v = acc[ai][bj][m][n];
#pragma unroll
                            for (int e = 0; e < 4; ++e) mvT[((size_t)((l * 4 + wc) * 4 + (row >> 6))) * 4096 + vimg(0, row & 63) + bj * 512 + (16 * n + 4 * fq + e) * 8] = (bf16)(pk2(v[e], 0.f) & 0xffffu); }
                }
            }
    }
};
struct EpiRes {
    static constexpr bool PERM = true;
    const float* bf; const bf16* bb; float* out; bf16* xb; float* ss; int last;
    DI void operator()(const Acc& acc, const Unit& u, int wr, int wc, int fr, int fq) const {
        const int row0 = u.pm * BM + wr * 64 + fr, col0 = u.pn * BM + wc * 32 + 8 * fq;
#pragma unroll
        for (int ai = 0; ai < 2; ++ai)
#pragma unroll
            for (int m = 0; m < 4; ++m) {
                const int row = row0 + ai * HALF + m * 16; const size_t p = (size_t)row * D + col0; float s = 0.f;
#pragma unroll
                for (int bj = 0; bj < 2; ++bj) { const size_t off = p + bj * HALF;
                    const u32x4 raw = *(const u32x4*)(bb + off);
                    const f32x4 v0 = (f32x4){__uint_as_float(raw.x << 16), __uint_as_float(raw.x & 0xffff0000u), __uint_as_float(raw.y << 16), __uint_as_float(raw.y & 0xffff0000u)} + acc[ai][bj][m][0];
                    const f32x4 v1 = (f32x4){__uint_as_float(raw.z << 16), __uint_as_float(raw.z & 0xffff0000u), __uint_as_float(raw.w << 16), __uint_as_float(raw.w & 0xffff0000u)} + acc[ai][bj][m][1];
                    if (out) { __builtin_nontemporal_store(v0, (f32x4*)(out + off)); __builtin_nontemporal_store(v1, (f32x4*)(out + off + 4)); }
                    if (!last) { u32x4 w; w.x = pk2(v0[0], v0[1]); w.y = pk2(v0[2], v0[3]); w.z = pk2(v1[0], v1[1]); w.w = pk2(v1[2], v1[3]); *(u32x4*)(xb + off) = w;
                        s += (v0[0] * v0[0] + v0[1] * v0[1]) + (v0[2] * v0[2] + v0[3] * v0[3]) + (v1[0] * v1[0] + v1[1] * v1[1]) + (v1[2] * v1[2] + v1[3] * v1[3]); } }
                if (!last) { s += __shfl_xor(s, 16); s += __shfl_xor(s, 32); if (fq == 0) unsafeAtomicAdd(ss + row, s); }
            }
    }
};
struct EpiMlpIn {
    static constexpr bool PERM = true;
    bf16* hb; const float* ss;
    DI void operator()(const Acc& acc, const Unit& u, int wr, int wc, int fr, int fq) const {
        const int row0 = u.pm * BM + wr * 64 + fr, col0 = u.pn * BM + wc * 32 + 8 * fq;
#pragma unroll
        for (int ai = 0; ai < 2; ++ai)
#pragma unroll
            for (int m = 0; m < 4; ++m) {
                const int row = row0 + ai * HALF + m * 16; const float rs = __builtin_amdgcn_rsqf(ss[row] * (1.0f / D) + EPS);
#pragma unroll
                for (int bj = 0; bj < 2; ++bj) { f32x4 v0 = acc[ai][bj][m][0] * rs, v1 = acc[ai][bj][m][1] * rs;
#pragma unroll
                    for (int e = 0; e < 4; ++e) { const float a = fmaxf(v0[e], 0.f), b = fmaxf(v1[e], 0.f); v0[e] = a * a; v1[e] = b * b; }
                    u32x4 w; w.x = pk2(v0[0], v0[1]); w.y = pk2(v0[2], v0[3]); w.z = pk2(v1[0], v1[1]); w.w = pk2(v1[2], v1[3]);
                    *(u32x4*)(hb + (size_t)row * FF + col0 + bj * HALF) = w; }
            }
    }
};
struct EpiB {
    static constexpr bool PERM = true;
    const float* ss; bf16* cbuf; bf16* ksel; bf16* vTsel; bf16* kwin; bf16* vTwin; bf16* q; bf16* qm; float* gates;
    const float* kng; const float* qng; const float* mqg; const float* gate_b;
    DI void operator()(const Acc& acc, const Unit& u, int wr, int wc, int fr, int fq) const {
        const int row0 = u.pm * BM + wr * 64 + fr; const int pn = u.pn;
#pragma unroll
        for (int ai = 0; ai < 2; ++ai)
#pragma unroll
            for (int m = 0; m < 4; ++m) {
                const int row = row0 + ai * HALF + m * 16; const float rs = __builtin_amdgcn_rsqf(ss[row] * (1.0f / D) + EPS);
                if (pn == 0) {
#pragma unroll
                    for (int bj = 0; bj < 2; ++bj) { const f32x4 v0 = acc[ai][bj][m][0] * rs, v1 = acc[ai][bj][m][1] * rs;
                        u32x4 w; w.x = pk2(v0[0], v0[1]); w.y = pk2(v0[2], v0[3]); w.z = pk2(v1[0], v1[1]); w.w = pk2(v1[2], v1[3]);
                        *(u32x4*)(cbuf + ((size_t)wc * S + row) * 64 + 32 * bj + 8 * fq) = w; }
                } else if (pn <= 2) {
                    bf16* kd = pn == 1 ? ksel : kwin; bf16* vd = pn == 1 ? vTsel : vTwin; const float* g = kng + pn * 64;
                    if (wc < 2) {
                        const float r = head_rs(acc, ai, m, rs) * rs;
#pragma unroll
                        for (int bj = 0; bj < 2; ++bj) { const int d0 = 32 * bj + 8 * fq; const f32x4 g0 = *(const f32x4*)(g + d0), g1 = *(const f32x4*)(g + d0 + 4);
                            const f32x4 v0 = acc[ai][bj][m][0] * r * g0, v1 = acc[ai][bj][m][1] * r * g1;
                            u32x4 w; w.x = pk2(v0[0], v0[1]); w.y = pk2(v0[2], v0[3]); w.z = pk2(v1[0], v1[1]); w.w = pk2(v1[2], v1[3]);
                            *(u32x4*)(kd + ((size_t)wc * (S / 64) + (row >> 6)) * 4096 + ((row >> 5) & 1) * 2048 + (2 * bj + (fq >> 1)) * 512 + (fq & 1) * 256 + (row & 31) * 8) = w; }
                    } else {
#pragma unroll
                        for (int bj = 0; bj < 2; ++bj)
#pragma unroll
                            for (int n = 0; n < 2; ++n) { const f32x4 v = acc[ai][bj][m][n] * rs;
#pragma unroll
                                for (int e = 0; e < 4; ++e) vd[((size_t)(wc - 2) * (S / 64) + (row >> 6)) * 4096 + vimg(0, row & 63) + bj * 512 + (8 * fq + 4 * n + e) * 8] = (bf16)(pk2(v[e], 0.f) & 0xffffu); }
                    }
                } else if (pn <= 6) {
                    const float r = head_rs(acc, ai, m, rs) * rs * QSCALE; const float* g = pn == 6 ? mqg : qng;
                    bf16* dst = pn == 6 ? qm + (size_t)row * 256 + wc * 64 : q + (size_t)row * 768 + ((pn - 3) * 4 + wc) * 64;
#pragma unroll
                    for (int bj = 0; bj < 2; ++bj) { const int d0 = 32 * bj + 8 * fq; const f32x4 g0 = *(const f32x4*)(g + d0), g1 = *(const f32x4*)(g + d0 + 4);
                        const f32x4 v0 = acc[ai][bj][m][0] * r * g0, v1 = acc[ai][bj][m][1] * r * g1;
                        u32x4 w; w.x = pk2(v0[0], v0[1]); w.y = pk2(v0[2], v0[3]); w.z = pk2(v1[0], v1[1]); w.w = pk2(v1[2], v1[3]);
                        *(u32x4*)(dst + d0) = w; }
                } else {
                    if (wc < 2) {
#pragma unroll
                        for (int n = 0; n < 2; ++n) { const int p0 = 32 * wc + 8 * fq + 4 * n;
                            if (p0 < 36) { const f32x4 v = acc[ai][0][m][n] * rs;
#pragma unroll
                                for (int e = 0; e < 4; ++e) gates[(size_t)row * 36 + p0 + e] = sigmoidf_(v[e] + gate_b[p0 + e]); } }
                    }
                }
            }
    }
};
struct EpiC {
    static constexpr bool PERM = false;
    float* part;
    DI void operator()(const Acc& acc, const Unit& u, int wr, int wc, int fr, int fq) const {
        const int row0 = u.pm * BM + wr * 64 + fr, col0 = wc * 32 + 4 * fq; float* pb = part + (size_t)(u.pn & 3) * 4096 * 256;
#pragma unroll
        for (int ai = 0; ai < 2; ++ai)
#pragma unroll
            for (int m = 0; m < 4; ++m) { float* rowp = pb + (size_t)(row0 + ai * HALF + m * 16) * 256 + col0;
#pragma unroll
                for (int bj = 0; bj < 2; ++bj)
#pragma unroll
                    for (int n = 0; n < 2; ++n) *(f32x4*)(rowp + bj * HALF + n * 16) = acc[ai][bj][m][n]; }
    }
};

constexpr size_t MiB = 1u << 20;
constexpr size_t WS_SS = 0;
constexpr size_t WS_BPART = 256 * 1024;
constexpr size_t WS_BIAS1 = 400 * 1024;
constexpr size_t WS_MK = 512 * 1024;
constexpr size_t WS_MVT = 768 * 1024;
constexpr size_t WS_KCMP = 1 * MiB;
constexpr size_t WS_VTCMP = 1 * MiB + 256 * 1024;
constexpr size_t WS_MEMB = 1 * MiB + 512 * 1024;
constexpr size_t WS_W = 8 * MiB;
constexpr size_t WS_WA = WS_W;
constexpr size_t WS_WO = WS_WA + 1792 * 1024 * 2;
constexpr size_t WS_W1 = WS_WO + 2 * 1024 * 1024 * 2;
constexpr size_t WS_W2 = WS_W1 + 2 * 4096 * 1024 * 2;
constexpr size_t WS_WB = WS_W2 + 2 * 4096 * 1024 * 2;
constexpr size_t WS_WM = WS_WB + 2048 * 1024 * 2;
constexpr size_t WS_W1C = WS_WM + 1024 * 1024 * 2;
constexpr size_t WS_W2C = WS_W1C + 512 * 2048 * 2;
constexpr size_t WS_WEND = WS_W2C + 2 * 64 * 256 * 2;
constexpr size_t WS_XB = 58 * MiB;
constexpr size_t WS_MIX = 90 * MiB;
constexpr size_t WS_HB = 122 * MiB;
constexpr size_t WS_END = 250 * MiB;
static_assert(WS_WEND <= WS_XB, "weights fit");
constexpr size_t WS_VGLU = WS_HB;
constexpr size_t WS_QM0 = WS_HB + 24 * MiB;
constexpr size_t WS_CBUF = WS_HB;
constexpr size_t WS_KSEL = WS_HB + 10 * MiB;
constexpr size_t WS_VTSEL = WS_HB + 14 * MiB;
constexpr size_t WS_KWIN = WS_HB + 18 * MiB;
constexpr size_t WS_VTWIN = WS_HB + 22 * MiB;
constexpr size_t WS_Q = WS_HB + 26 * MiB;
constexpr size_t WS_QM1 = WS_HB + 50 * MiB;
constexpr size_t WS_GATES = WS_HB + 58 * MiB;
constexpr size_t WS_IMP = WS_HB + 64 * MiB;
constexpr size_t WS_PART = WS_IMP;
constexpr size_t WS_OC = WS_HB + 96 * MiB;
constexpr size_t WS_CNT = 448 * 1024;

constexpr int LDS_BYTES = 147456;
constexpr int NWAVES = 8;

struct Params { const float* in[29]; float* out; unsigned char* ws; int ph_lo, ph_hi; };
enum { I_X = 0, I_MEM, I_NMIX, I_NMLP, I_MEMN, I_WMEMKV, I_MQG, I_MKG, I_WOUT, I_WMLPIN, I_WMLPOUT, I_AWIN, I_ABGLU, I_ADW, I_ADWB, I_ALNG, I_ALNB,
       I_BWIN, I_BGATEB, I_BQG, I_KVNG, I_WKV, I_KNG, I_PEK, I_PEV, I_W1K, I_W2K, I_W1V, I_W2V };

DI int hp(int p) { return 64 * ((p >> 5) & 3) + 32 * (p >> 7) + (p & 31); }
DI void tr_item(const float* __restrict__ W, int ldw, int src_col0, int nvalid, const float* __restrict__ gain, bf16* WT, int K, int dst_row0, int k0, LAS float* scr, int lane) {
    const int cc = lane & 31; const bool ok = cc < nvalid;
    const float* wp = W + (size_t)(k0 + (lane >> 5)) * ldw + src_col0 + (ok ? cc : 0);
    float v[32];
#pragma unroll
    for (int i = 0; i < 32; ++i) v[i] = __builtin_nontemporal_load(wp + (size_t)(2 * i) * ldw);
    const int c = lane & 7;
    f32x4 g0 = {1.f, 1.f, 1.f, 1.f}, g1 = {1.f, 1.f, 1.f, 1.f};
    if (gain) { g0 = *(const f32x4*)(gain + k0 + 8 * c); g1 = *(const f32x4*)(gain + k0 + 8 * c + 4); }
#pragma unroll
    for (int i = 0; i < 32; ++i) scr[(2 * i + (lane >> 5)) * 33 + cc] = ok ? v[i] : 0.f;
    LDS_WAIT();
#pragma unroll
    for (int j = 0; j < 4; ++j) { const int n = (lane >> 3) + 8 * j; const LAS float* s = scr + (8 * c) * 33 + n;
        u32x4 o; o.x = pk2(s[0 * 33] * g0[0], s[1 * 33] * g0[1]); o.y = pk2(s[2 * 33] * g0[2], s[3 * 33] * g0[3]); o.z = pk2(s[4 * 33] * g1[0], s[5 * 33] * g1[1]); o.w = pk2(s[6 * 33] * g1[2], s[7 * 33] * g1[3]);
        *(u32x4*)(WT + (size_t)(dst_row0 + n) * K + k0 + 8 * c) = o; }
    LDS_WAIT();
}
DI void rms_rows2_to_bf16(const float* xrow, bf16* orow, float* ssq, int lane) {
    const f32x4* xr = (const f32x4*)xrow + lane; f32x4 v[8]; float s0 = 0.f, s1 = 0.f;
#pragma unroll
    for (int j = 0; j < 8; ++j) v[j] = __builtin_nontemporal_load(xr + 64 * j);
#pragma unroll
    for (int j = 0; j < 4; ++j) { s0 += (v[j][0] * v[j][0] + v[j][1] * v[j][1]) + (v[j][2] * v[j][2] + v[j][3] * v[j][3]);
                                  s1 += (v[4 + j][0] * v[4 + j][0] + v[4 + j][1] * v[4 + j][1]) + (v[4 + j][2] * v[4 + j][2] + v[4 + j][3] * v[4 + j][3]); }
    s0 = wave_sum(s0); s1 = wave_sum(s1);
    float r0 = __builtin_amdgcn_rsqf(s0 * (1.0f / D) + EPS), r1 = __builtin_amdgcn_rsqf(s1 * (1.0f / D) + EPS);
    if (ssq) { if (lane == 0) { ssq[0] = s0; ssq[1] = s1; } r0 = 1.0f; r1 = 1.0f; }
    u32x2* o8 = (u32x2*)orow + lane;
#pragma unroll
    for (int j = 0; j < 8; ++j) { const float r = j < 4 ? r0 : r1; u32x2 w; w.x = pk2(v[j][0] * r, v[j][1] * r); w.y = pk2(v[j][2] * r, v[j][3] * r); o8[64 * j] = w; }
}
DI void p0_prologue(const Params& P, LAS unsigned char* lds, int gw, int NGW, int wave, int lane) {
    unsigned char* ws = P.ws;
    LAS float* scr = (LAS float*)(lds + wave * 16384);
    constexpr int NM = 11;
    const int rows[NM] = {1792, 1024, 1024, 4096, 4096, 1024, 1024, 2048, 1024, 512, 128};
    const int Ks[NM]   = {1024, 1024, 1024, 1024, 1024, 4096, 4096, 1024, 1024, 2048, 256};
    int total = 0;
#pragma unroll
    for (int m = 0; m < NM; ++m) total += (rows[m] / 32) * (Ks[m] / 64);
    for (int it = gw; it < total; it += NGW) {
        int r = it, m = 0;
#pragma unroll
        for (int mm = 0; mm < NM; ++mm) { const int cnt = (rows[mm] / 32) * (Ks[mm] / 64); if (m == mm && r >= cnt) { r -= cnt; m = mm + 1; } }
        int K = 1024, nkb = 16;
        if (m == 5 || m == 6) { K = 4096; nkb = 64; } else if (m == 9) { K = 2048; nkb = 32; } else if (m == 10) { K = 256; nkb = 4; }
        const int nb = r / nkb, kb = r % nkb, R0 = nb * 32, k0 = kb * 64;
        const float* W; int ldw, col, nvalid = 32; const float* gain = nullptr; bf16* WT;
        if (m == 0) { W = P.in[I_AWIN]; ldw = 1792; gain = P.in[I_NMIX]; WT = (bf16*)(ws + WS_WA);
            const int j = R0 >> 8, p = R0 & 255; col = j < 6 ? (p < 128 ? 128 * j + p : 768 + 128 * j + p - 128) : 1536 + hp(p); }
        else if (m <= 2) { W = P.in[I_WOUT] + (size_t)(m - 1) * D * D; ldw = D; col = R0; WT = (bf16*)(ws + WS_WO) + (size_t)(m - 1) * D * D; }
        else if (m <= 4) { W = P.in[I_WMLPIN] + (size_t)(m - 3) * D * FF; ldw = FF; col = R0; gain = P.in[I_NMLP] + (m - 3) * D; WT = (bf16*)(ws + WS_W1) + (size_t)(m - 3) * D * FF; }
        else if (m <= 6) { W = P.in[I_WMLPOUT] + (size_t)(m - 5) * D * FF; ldw = D; col = R0; WT = (bf16*)(ws + WS_W2) + (size_t)(m - 5) * D * FF; }
        else if (m == 7) { WT = (bf16*)(ws + WS_WB);
            if (R0 < 768) { W = P.in[I_WKV]; ldw = 768; col = (R0 & ~255) + hp(R0 & 255); gain = P.in[I_KVNG]; }
            else { const int uc = R0 - 768, uj = uc >> 8, p = uc & 255; W = P.in[I_BWIN]; ldw = 1060; gain = P.in[I_NMIX] + D; col = uj < 4 ? uj * 256 + hp(p) : 1024 + p;
                   nvalid = 1060 - col; nvalid = nvalid < 0 ? 0 : (nvalid > 32 ? 32 : nvalid); if (nvalid == 0) col = 0; } }
        else if (m == 8) { const int un = R0 >> 8, p = R0 & 255; W = P.in[I_WMEMKV] + (size_t)(un >> 1) * D * 512; ldw = 512; col = (un & 1) * 256 + hp(p); gain = P.in[I_MEMN]; WT = (bf16*)(ws + WS_WM); }
        else if (m == 9) { W = (R0 >> 8) ? P.in[I_W1V] : P.in[I_W1K]; ldw = 256; col = R0 & 255; WT = (bf16*)(ws + WS_W1C) + (size_t)((R0 >> 8) * 4 + (k0 >> 9)) * 256 * 512; }
        else { W = (R0 >> 6) ? P.in[I_W2V] : P.in[I_W2K]; ldw = 64; col = R0 & 63; WT = (bf16*)(ws + WS_W2C); }
        if (m == 9) tr_item(W + (size_t)(k0 & ~511) * ldw, ldw, col, nvalid, gain, WT, 512, R0 & 255, k0 & 511, scr, lane);
        else tr_item(W, ldw, col, nvalid, gain, WT, K, R0, k0, scr, lane);
    }
    for (int r2 = gw; r2 < (S + MEML) / 2; r2 += NGW) { const int r = 2 * r2;
        if (r < S) rms_rows2_to_bf16(P.in[I_X] + (size_t)r * D, (bf16*)(ws + WS_XB) + (size_t)r * D, (float*)(ws + WS_SS) + 3 * S + r, lane);
        else rms_rows2_to_bf16(P.in[I_MEM] + (size_t)(r - S) * D, (bf16*)(ws + WS_MEMB) + (size_t)(r - S) * D, nullptr, lane);
    }
    const int gt = gw * 64 + lane, NGT = NGW * 64;
    for (int i = gt; i < 3 * S; i += NGT) ((float*)(ws + WS_SS))[i] = 0.f;
    for (int i = gt; i < 2 * 64 * 256; i += NGT) { const int type = i >> 14, kc = (i >> 8) & 63, c = i & 255;
        const float* pe = P.in[type ? I_PEV : I_PEK] + kc * 32; const float* w1 = P.in[type ? I_W1V : I_W1K] + (size_t)kc * 32 * 256 + c; float s = 0.f;
#pragma unroll 8
        for (int k = 0; k < 32; ++k) s += pe[k] * w1[(size_t)k * 256];
        ((float*)(ws + WS_BPART))[i] = s; }
}

DI f32x16 mfma32(bf16x8 a, bf16x8 b, f32x16 c) { return __builtin_amdgcn_mfma_f32_32x32x16_bf16(a, b, c, 0, 0, 0); }
DI f32x4 mfma16(bf16x8 a, bf16x8 b, f32x4 c) { return __builtin_amdgcn_mfma_f32_16x16x32_bf16(a, b, c, 0, 0, 0); }
DI float gain_max(const float* g, int lane) { return wave_max(fabsf(g[lane])); }
DI void conv_task(const Params& P, int t0, int lane) {
    const bf16* vg = (const bf16*)(P.ws + WS_VGLU); const float* dw = P.in[I_ADW]; bf16* mix = (bf16*)(P.ws + WS_MIX);
    f32x4 acc[4][3];
#pragma unroll
    for (int i = 0; i < 3; ++i) { const f32x4 b = *(const f32x4*)(P.in[I_ADWB] + 4 * lane + 256 * i);
#pragma unroll
        for (int tt = 0; tt < 4; ++tt) acc[tt][i] = b; }
    f32x4 vr[4][3];
#define CONV_LDROW(dst, rr) do { _Pragma("unroll") for (int i = 0; i < 3; ++i) { u32x2 raw = *(const u32x2*)(vg + (size_t)((rr) >= 0 ? (rr) : 0) * 768 + 4 * lane + 256 * i); if ((rr) < 0) { raw.x = 0u; raw.y = 0u; } \
        dst[i] = (f32x4){__uint_as_float(raw.x << 16), __uint_as_float(raw.x & 0xffff0000u), __uint_as_float(raw.y << 16), __uint_as_float(raw.y & 0xffff0000u)}; } } while (0)
    CONV_LDROW(vr[0], t0 - 30); CONV_LDROW(vr[1], t0 - 29); CONV_LDROW(vr[2], t0 - 28);
#pragma unroll 8
    for (int j = 0; j < 31; ++j) {
        CONV_LDROW(vr[3], t0 - 27 + j);
        f32x4 w[3];
#pragma unroll
        for (int i = 0; i < 3; ++i) w[i] = *(const f32x4*)(dw + (size_t)j * 768 + 4 * lane + 256 * i);
#pragma unroll
        for (int tt = 0; tt < 4; ++tt)
#pragma unroll
            for (int i = 0; i < 3; ++i) acc[tt][i] += vr[tt][i] * w[i];
#pragma unroll
        for (int i = 0; i < 3; ++i) { vr[0][i] = vr[1][i]; vr[1][i] = vr[2][i]; vr[2][i] = vr[3][i]; }
    }
#undef CONV_LDROW
    f32x4 lg[3], lb[3];
#pragma unroll
    for (int i = 0; i < 3; ++i) { lg[i] = *(const f32x4*)(P.in[I_ALNG] + 4 * lane + 256 * i); lb[i] = *(const f32x4*)(P.in[I_ALNB] + 4 * lane + 256 * i); }
#pragma unroll
    for (int tt = 0; tt < 4; ++tt) {
        float s = 0.f;
#pragma unroll
        for (int i = 0; i < 3; ++i) s += (acc[tt][i][0] + acc[tt][i][1]) + (acc[tt][i][2] + acc[tt][i][3]);
        const float mean = wave_sum(s) * (1.0f / 768.0f); float q = 0.f;
#pragma unroll
        for (int i = 0; i < 3; ++i) { const f32x4 d = acc[tt][i] - mean; q += (d[0] * d[0] + d[1] * d[1]) + (d[2] * d[2] + d[3] * d[3]); }
        const float rstd = __builtin_amdgcn_rsqf(wave_sum(q) * (1.0f / 768.0f) + 1e-5f);
#pragma unroll
        for (int i = 0; i < 3; ++i) { f32x4 y = (acc[tt][i] - mean) * rstd * lg[i] + lb[i];
#pragma unroll
            for (int e = 0; e < 4; ++e) y[e] = y[e] * sigmoidf_(y[e]);
            st_bf16x4(mix + (size_t)(t0 + tt) * D + 4 * lane + 256 * i, y); }
    }
}

DI void cmp2_task(const Params& P, int task, int lane) {
    const int r = lane & 31, h = lane >> 5; const int row0 = task * 32; const int type = row0 >> 11, g = (row0 >> 10) & 1, n0 = row0 & 1023;
    const float* part = (const float*)(P.ws + WS_PART) + (size_t)(row0 + r) * 256 + 8 * h; const float* bb = (const float*)(P.ws + WS_BIAS1) + type * 256 + 8 * h;
    const bf16* w2 = (const bf16*)(P.ws + WS_W2C) + (size_t)type * 64 * 256;
    f32x16 O0, O1;
#pragma unroll
    for (int i = 0; i < 16; ++i) { O0[i] = 0.f; O1[i] = 0.f; }
#pragma unroll 4
    for (int s = 0; s < 16; ++s) {
        f32x4 a0 = *(const f32x4*)(bb + 16 * s), a1 = *(const f32x4*)(bb + 16 * s + 4);
#pragma unroll
        for (int kc = 0; kc < 4; ++kc) { a0 += *(const f32x4*)(part + (size_t)kc * 4096 * 256 + 16 * s); a1 += *(const f32x4*)(part + (size_t)kc * 4096 * 256 + 16 * s + 4); }
#pragma unroll
        for (int e = 0; e < 4; ++e) { float x = a0[e]; a0[e] = x * sigmoidf_(1.5957691216f * (x + 0.044715f * x * x * x)); x = a1[e]; a1[e] = x * sigmoidf_(1.5957691216f * (x + 0.044715f * x * x * x)); }
        u32x4 hw; hw.x = pk2(a0[0], a0[1]); hw.y = pk2(a0[2], a0[3]); hw.z = pk2(a1[0], a1[1]); hw.w = pk2(a1[2], a1[3]);
        const bf16x8 hb = __builtin_bit_cast(bf16x8, hw);
        O0 = mfma32(*(const bf16x8*)(w2 + (size_t)r * 256 + 16 * s + 8 * h), hb, O0);
        O1 = mfma32(*(const bf16x8*)(w2 + (size_t)(32 + r) * 256 + 16 * s + 8 * h), hb, O1);
    }
    if (type == 0) {
        float s = 0.f;
#pragma unroll
        for (int i = 0; i < 16; ++i) s += O0[i] * O0[i] + O1[i] * O1[i];
        s += __shfl_xor(s, 32);
        const float rs = __builtin_amdgcn_rsqf(s * (1.0f / 64.0f) + EPS);
        const int nk = n0 + r; bf16* kp = (bf16*)(P.ws + WS_KCMP) + ((size_t)g * 16 + (nk >> 6)) * 4096; const float* kg = P.in[I_KNG] + 4 * h;
#pragma unroll
        for (int q4 = 0; q4 < 4; ++q4) {
            const f32x4 g0 = *(const f32x4*)(kg + 8 * q4), g1 = *(const f32x4*)(kg + 32 + 8 * q4);
            st_bf16x4(kp + kimg(nk & 63, 4 * h + 8 * q4), (f32x4){O0[4 * q4], O0[4 * q4 + 1], O0[4 * q4 + 2], O0[4 * q4 + 3]} * rs * g0);
            st_bf16x4(kp + kimg(nk & 63, 32 + 4 * h + 8 * q4), (f32x4){O1[4 * q4], O1[4 * q4 + 1], O1[4 * q4 + 2], O1[4 * q4 + 3]} * rs * g1);
        }
    } else {
        const int nn = n0 + r; bf16* vp = (bf16*)(P.ws + WS_VTCMP) + ((size_t)g * 16 + (nn >> 6)) * 4096;
#pragma unroll
        for (int i = 0; i < 16; ++i) { const int c = (i & 3) + 8 * (i >> 2) + 4 * h;
            vp[vimg(c, nn & 63)] = (bf16)(pk2(O0[i], 0.f) & 0xffffu); vp[vimg(c + 32, nn & 63)] = (bf16)(pk2(O1[i], 0.f) & 0xffffu); }
    }
}

struct KV32 { bf16x8 k[4]; s16x4 v[8]; };
DI void kv32_load(KV32& d, const bf16* Kb, const bf16* VT, int key0, int r, int h) {
    const int ln = h * 32 + r; const size_t blk = (size_t)(key0 >> 6) * 4096; const int sub = (key0 >> 5) & 1;
    const bf16* kp = Kb + blk + sub * 2048 + ln * 8;
#pragma unroll
    for (int s = 0; s < 4; ++s) d.k[s] = *(const bf16x8*)(kp + s * 512);
    const bf16* vp = VT + blk + sub * 2048 + ln * 8;
#pragma unroll
    for (int i = 0; i < 4; ++i) { const bf16x8 w = *(const bf16x8*)(vp + i * 512); d.v[2 * i] = __builtin_shufflevector(w, w, 0, 1, 2, 3); d.v[2 * i + 1] = __builtin_shufflevector(w, w, 4, 5, 6, 7); }
}
DI float opaque_zero() { float z; asm volatile("v_mov_b32 %0, 0" : "=v"(z)); return z; }
DI f32x16 tile_qk(const KV32& d, const bf16x8 (&qf)[4], float c0) {
    f32x16 sc; const float c = c0 + opaque_zero();
#pragma unroll
    for (int i = 0; i < 16; ++i) sc[i] = c;
#pragma unroll
    for (int s = 0; s < 4; ++s) sc = mfma32(d.k[s], qf[s], sc);
    return sc;
}
DI void tile_pv(const KV32& d, const float (&p)[16], f32x16& O0, f32x16& O1) {
#pragma unroll
    for (int s2 = 0; s2 < 2; ++s2) {
        u32x4 pw; pw.x = pk2(p[8 * s2], p[8 * s2 + 1]); pw.y = pk2(p[8 * s2 + 2], p[8 * s2 + 3]); pw.z = pk2(p[8 * s2 + 4], p[8 * s2 + 5]); pw.w = pk2(p[8 * s2 + 6], p[8 * s2 + 7]);
        const bf16x8 pb = __builtin_bit_cast(bf16x8, pw);
        O0 = mfma32(__builtin_shufflevector(d.v[(s2 * 2) * 2], d.v[(s2 * 2) * 2 + 1], 0, 1, 2, 3, 4, 5, 6, 7), pb, O0);
        O1 = mfma32(__builtin_shufflevector(d.v[(s2 * 2 + 1) * 2], d.v[(s2 * 2 + 1) * 2 + 1], 0, 1, 2, 3, 4, 5, 6, 7), pb, O1);
    }
}
DI void tile_store(bf16* op, const f32x16& O0, const f32x16& O1, float sc) {
#pragma unroll
    for (int q4 = 0; q4 < 4; ++q4) {
        st_bf16x4(op + 8 * q4, (f32x4){O0[4 * q4], O0[4 * q4 + 1], O0[4 * q4 + 2], O0[4 * q4 + 3]} * sc);
        st_bf16x4(op + 32 + 8 * q4, (f32x4){O1[4 * q4], O1[4 * q4 + 1], O1[4 * q4 + 2], O1[4 * q4 + 3]} * sc);
    }
}
DI void mem_attn_task(const bf16* Qm, const bf16* mk, const bf16* mvT, bf16* mix, int t0, int head, float Bq, int lane) {
    const int r = lane & 31, h = lane >> 5;
    bf16x8 qf[4];
#pragma unroll
    for (int s = 0; s < 4; ++s) qf[s] = *(const bf16x8*)(Qm + (size_t)(t0 + r) * 256 + head * 64 + 16 * s + 8 * h);
    const bf16* Kb = mk + (size_t)head * 4 * 4096; const bf16* Vb = mvT + (size_t)head * 4 * 4096;
    f32x16 O0, O1; float l = 0.f;
#pragma unroll
    for (int i = 0; i < 16; ++i) { O0[i] = 0.f; O1[i] = 0.f; }
    KV32 A, B, C;
#define MA_STEP(BUF, st) do { if ((st) < nst) { const f32x16 sc = tile_qk(BUF, qf, -Bq); float p[16]; \
        _Pragma("unroll") for (int i = 0; i < 16; ++i) { p[i] = __builtin_amdgcn_exp2f(sc[i]); l += p[i]; } \
        tile_pv(BUF, p, O0, O1); } { const int _s = (st) + 3 < nst ? (st) + 3 : nst - 1; kv32_load(BUF, Kb, Vb, 32 * _s, r, h); } } while (0)
    const int nst = 8;
    kv32_load(A, Kb, Vb, 0, r, h); kv32_load(B, Kb, Vb, 32, r, h); kv32_load(C, Kb, Vb, 64, r, h);
#pragma unroll 1
    for (int st = 0; st < nst; st += 3) { MA_STEP(A, st); MA_STEP(B, st + 1); MA_STEP(C, st + 2); }
#undef MA_STEP
    l += __shfl_xor(l, 32);
    tile_store(mix + (size_t)(t0 + r) * D + 768 + head * 64 + 4 * h, O0, O1, 1.0f / l);
}
DI void mem_attn_phase(const Params& P, int layer, const bf16* Qm, int gw, int NGW, int lane) {
    if (gw < 0) return;
    const bf16* mk = (const bf16*)(P.ws + WS_MK) + (size_t)layer * 4 * 256 * 64; const bf16* mvT = (const bf16*)(P.ws + WS_MVT) + (size_t)layer * 4 * 64 * 256;
    const float Bq = BNDC * gain_max(P.in[I_MQG] + layer * 64, lane) * gain_max(P.in[I_MKG] + layer * 64, lane) * 1.02f;
    for (int task = gw; task < (S / 32) * 4; task += NGW) mem_attn_task(Qm, mk, mvT, (bf16*)(P.ws + WS_MIX), (task >> 2) * 32, task & 3, Bq, lane);
}

DI void cmp_tile_task(const Params& P, int qt, int g, float Bc, LAS float* wl, LAS bf16x8* qL, int lane) {
    unsigned char* ws = P.ws;
    const int r = lane & 31, h = lane >> 5, t = 32 * qt + r;
    const int nv = t >= 31 ? ((t - 31) >> 4) + 1 : 0;
    const int tl = 32 * qt + 31, nvmax = tl >= 31 ? ((tl - 31) >> 4) + 1 : 0, nsteps = (nvmax + 31) >> 5;
    const int tf = 32 * qt, nvmin = tf >= 31 ? ((tf - 31) >> 4) + 1 : 0;
    const bf16* Kc = (const bf16*)(ws + WS_KCMP) + (size_t)g * 1024 * 64; const bf16* Vc = (const bf16*)(ws + WS_VTCMP) + (size_t)g * 64 * 1024;
    const bf16* qrow = (const bf16*)(ws + WS_Q) + (size_t)t * 768 + g * 384 + 8 * h;
    bf16* oc = (bf16*)(ws + WS_OC) + (size_t)t * 768 + g * 384 + 4 * h;
    const float* gp = (const float*)(ws + WS_GATES) + (size_t)t * 36 + g * 18;
    for (int hh = 0; hh < 6; ++hh) {
        bf16x8 qf[4];
#pragma unroll
        for (int s = 0; s < 4; ++s) qf[s] = *(const bf16x8*)(qrow + hh * 64 + 16 * s);
        f32x16 O0, O1; float l = 0.f;
#pragma unroll
        for (int i = 0; i < 16; ++i) { O0[i] = 0.f; O1[i] = 0.f; }
        KV32 A, B, C;
#define CA_LD(BUF, st) do { const int _s = (st) < nsteps ? (st) : nsteps - 1; kv32_load(BUF, Kc, Vc, 32 * _s, r, h); } while (0)
#define CA_STEP(BUF, st) do { if ((st) < nsteps) { const f32x16 sc = tile_qk(BUF, qf, -Bc); float p[16]; \
        if (32 * (st) + 32 <= nvmin) { _Pragma("unroll") for (int i = 0; i < 16; ++i) { p[i] = __builtin_amdgcn_exp2f(sc[i]); l += p[i]; } } \
        else { _Pragma("unroll") for (int i = 0; i < 16; ++i) { const int key = 32 * (st) + (i & 3) + 8 * (i >> 2) + 4 * h; p[i] = key < nv ? __builtin_amdgcn_exp2f(sc[i]) : 0.f; l += p[i]; } } \
        tile_pv(BUF, p, O0, O1); } CA_LD(BUF, (st) + 3); } while (0)
        if (nsteps > 0) {
        CA_LD(A, 0); CA_LD(B, 1); CA_LD(C, 2);
        for (int st = 0; st < nsteps; st += 3) { CA_STEP(A, st); CA_STEP(B, st + 1); CA_STEP(C, st + 2); }
        }
#undef CA_LD
#undef CA_STEP
        l += __shfl_xor(l, 32);
        const float inv = l > 0.f ? 1.0f / l : 0.f;
        wl[hh * 32 + r] = inv;
        tile_store(oc + hh * 64, O0, O1, inv * gp[hh * 3]);
    }
    LDS_WAIT();
    float* impr = (float*)(ws + WS_IMP) + ((size_t)t * 2 + g) * 256 + h;
    bf16x8 q3[3][4]; float inv6[6];
#pragma unroll
    for (int hh = 0; hh < 6; ++hh) { const float iv = wl[hh * 32 + r]; inv6[hh] = iv > 0.f ? __builtin_amdgcn_logf(iv) - Bc : -1e30f; }
#pragma unroll
    for (int hh = 0; hh < 3; ++hh)
#pragma unroll
        for (int s = 0; s < 4; ++s) { q3[hh][s] = *(const bf16x8*)(qrow + hh * 64 + 16 * s); qL[(hh * 4 + s) * 64] = *(const bf16x8*)(qrow + (3 + hh) * 64 + 16 * s); }
    LDS_WAIT();
    float carry = 0.f;
    bf16x8 kf[4], kn[4];
    { const bf16* kp = Kc + (h * 32 + r) * 8;
#pragma unroll
      for (int s = 0; s < 4; ++s) kf[s] = *(const bf16x8*)(kp + s * 512); }
    for (int st = 0; st < nsteps; ++st) {
        { const int sn = st + 1 < nsteps ? st + 1 : st; const bf16* kp = Kc + (size_t)(sn >> 1) * 4096 + (sn & 1) * 2048 + (h * 32 + r) * 8;
#pragma unroll
            for (int s = 0; s < 4; ++s) kn[s] = *(const bf16x8*)(kp + s * 512); }
        asm volatile("" ::: "memory");
        float Ps[16];
#pragma unroll
        for (int i = 0; i < 16; ++i) Ps[i] = 0.f;
#pragma unroll
        for (int hh = 0; hh < 6; ++hh) {
            f32x16 sc; const float c = inv6[hh] + opaque_zero();
#pragma unroll
            for (int i = 0; i < 16; ++i) sc[i] = c;
            if (hh < 3) {
#pragma unroll
                for (int s = 0; s < 4; ++s) sc = mfma32(kf[s], q3[hh][s], sc);
            } else {
#pragma unroll
                for (int s = 0; s < 4; ++s) sc = mfma32(kf[s], qL[((hh - 3) * 4 + s) * 64], sc);
            }
            if (32 * st + 32 <= nvmin) {
#pragma unroll
                for (int i = 0; i < 16; ++i) Ps[i] += __builtin_amdgcn_exp2f(sc[i]);
            } else {
#pragma unroll
                for (int i = 0; i < 16; ++i) { const int key = 32 * st + (i & 3) + 8 * (i >> 2) + 4 * h; Ps[i] += key < nv ? __builtin_amdgcn_exp2f(sc[i]) : 0.f; }
            }
        }
        float y[4], val[4];
#pragma unroll
        for (int q4 = 0; q4 < 4; ++q4) { y[q4] = __shfl_xor(Ps[4 * q4 + 3], 32); val[q4] = 2.0f * (Ps[4 * q4] + Ps[4 * q4 + 1] + Ps[4 * q4 + 2]) + Ps[4 * q4 + 3]; }
        if (h == 1) {
#pragma unroll
            for (int q4 = 0; q4 < 4; ++q4) val[q4] += y[q4];
        } else { val[0] += carry; val[1] += y[0]; val[2] += y[1]; val[3] += y[2]; }
        carry = y[3];
#pragma unroll
        for (int q4 = 0; q4 < 4; ++q4) impr[8 * st + 2 * q4] = val[q4];
#pragma unroll
        for (int s = 0; s < 4; ++s) kf[s] = kn[s];
    }
    LDS_WAIT();
}
DI void win_tile_task(const Params& P, int qt, int head, float Bw, int lane) {
    unsigned char* ws = P.ws;
    const int r = lane & 31, h = lane >> 5, t0 = 32 * qt, t = t0 + r, g = head / 6;
    const bf16* Kw = (const bf16*)(ws + WS_KWIN) + (size_t)g * S * 64; const bf16* Vw = (const bf16*)(ws + WS_VTWIN) + (size_t)g * 64 * S;
    const int kstart = t0 >= 512 ? t0 - 512 : 0, nsteps = (t0 + 32 - kstart) >> 5;
    bf16x8 qf[4];
#pragma unroll
    for (int s = 0; s < 4; ++s) qf[s] = *(const bf16x8*)((const bf16*)(ws + WS_Q) + (size_t)t * 768 + head * 64 + 16 * s + 8 * h);
    f32x16 O0, O1; float l = 0.f;
#pragma unroll
    for (int i = 0; i < 16; ++i) { O0[i] = 0.f; O1[i] = 0.f; }
    KV32 cur, nxt;
    kv32_load(cur, Kw, Vw, kstart, r, h);
    for (int st = 0; st < nsteps; ++st) {
        { const int sn = st + 1 < nsteps ? st + 1 : st; kv32_load(nxt, Kw, Vw, kstart + 32 * sn, r, h); }
        const f32x16 sc = tile_qk(cur, qf, -Bw); float p[16];
        if (st > 0 && st + 1 < nsteps) {
#pragma unroll
            for (int i = 0; i < 16; ++i) { p[i] = __builtin_amdgcn_exp2f(sc[i]); l += p[i]; }
        } else {
#pragma unroll
            for (int i = 0; i < 16; ++i) { const int kp = kstart + 32 * st + (i & 3) + 8 * (i >> 2) + 4 * h; p[i] = (kp <= t && kp > t - 512) ? __builtin_amdgcn_exp2f(sc[i]) : 0.f; l += p[i]; }
        }
        tile_pv(cur, p, O0, O1);
        cur = nxt;
    }
    l += __shfl_xor(l, 32);
    const float g2 = ((const float*)(ws + WS_GATES))[(size_t)t * 36 + head * 3 + 2];
    tile_store((bf16*)P.out + (size_t)t * 768 + head * 64 + 4 * h, O0, O1, l > 0.f ? g2 / l : 0.f);
}

DI void sel_sub(const KV32& X, int key0, unsigned mb, const bf16x8 (&qa)[4], const LAS bf16x8* qbl, int kl, int tqa, int tqb, float Bs,
                f32x16& Oa0, f32x16& Oa1, f32x16& Ob0, f32x16& Ob1, float& la, float& lb, int h) {
    if (mb & 15u) {
        const bool vr = kl < 4 && ((mb >> kl) & 1u);
        const f32x16 sc = tile_qk(X, qa, vr ? -Bs : -1e30f); float p[16];
#pragma unroll
        for (int i = 0; i < 16; ++i) { const int key = key0 + (i & 3) + 8 * (i >> 2) + 4 * h; p[i] = key <= tqa ? __builtin_amdgcn_exp2f(sc[i]) : 0.f; la += p[i]; }
        tile_pv(X, p, Oa0, Oa1);
    }
    if (mb >> 4) {
        const bool vr = kl < 4 && ((mb >> (4 + kl)) & 1u);
        bf16x8 qb[4];
#pragma unroll
        for (int s = 0; s < 4; ++s) qb[s] = qbl[s * 64];
        const f32x16 sc = tile_qk(X, qb, vr ? -Bs : -1e30f); float p[16];
#pragma unroll
        for (int i = 0; i < 16; ++i) { const int key = key0 + (i & 3) + 8 * (i >> 2) + 4 * h; p[i] = key <= tqb ? __builtin_amdgcn_exp2f(sc[i]) : 0.f; lb += p[i]; }
        tile_pv(X, p, Ob0, Ob1);
    }
}
DI void sel_out(const Params& P, const f32x16& O0, const f32x16& O1, float l, int t, int head, int h) {
    unsigned char* ws = P.ws;
    l += __shfl_xor(l, 32);
    const float g1 = ((const float*)(ws + WS_GATES))[(size_t)t * 36 + head * 3 + 1];
    const float sc = l > 0.f ? g1 / l : 0.f;
    const size_t off = (size_t)t * 768 + head * 64 + 4 * h;
    bf16* op = (bf16*)(ws + WS_MIX) + (size_t)t * D + head * 64 + 4 * h;
    const bf16* oc = (const bf16*)(ws + WS_OC) + off; const bf16* ow = (const bf16*)P.out + off;
#pragma unroll
    for (int q4 = 0; q4 < 4; ++q4) {
        st_bf16x4(op + 8 * q4, (f32x4){O0[4 * q4], O0[4 * q4 + 1], O0[4 * q4 + 2], O0[4 * q4 + 3]} * sc + ld_bf16x4(oc + 8 * q4) + ld_bf16x4(ow + 8 * q4));
        st_bf16x4(op + 32 + 8 * q4, (f32x4){O1[4 * q4], O1[4 * q4 + 1], O1[4 * q4 + 2], O1[4 * q4 + 3]} * sc + ld_bf16x4(oc + 32 + 8 * q4) + ld_bf16x4(ow + 32 + 8 * q4));
    }
}
DI void sel_unit(const Params& P, int tb, int g, float Bs, LAS unsigned char* lds, int tid, int wave, int lane) {
    unsigned char* ws = P.ws;
    LAS unsigned* mask = (LAS unsigned*)lds;
    mask[tid] = 0u;
    __syncthreads();
    if (tb <= 15) { if (tid <= tb) { mask[2 * tid] = 0xffffffffu; mask[2 * tid + 1] = 0xffffffffu; } }
    else {
        if (tid < 3) { const int j = tid == 0 ? 0 : (tid == 1 ? tb - 1 : tb); mask[2 * j] = 0xffffffffu; mask[2 * j + 1] = 0xffffffffu; }
        for (int k = 0; k < 8; ++k) {
            const int q = wave * 8 + k, t = 64 * tb + q;
            const f32x4 a = *(const f32x4*)((const float*)(ws + WS_IMP) + ((size_t)t * 2 + g) * 256 + 4 * lane);
            unsigned key[4];
#pragma unroll
            for (int e = 0; e < 4; ++e) { const int j = 4 * lane + e; key[e] = (j >= 1 && j <= tb - 2) ? __float_as_uint(a[e]) + 1u : 0u; }
            for (int it = 0; it < 13; ++it) {
                unsigned m = key[0] > key[1] ? key[0] : key[1]; const unsigned m2 = key[2] > key[3] ? key[2] : key[3]; m = m > m2 ? m : m2;
                const unsigned wm = wave_max_u32(m);
                const unsigned long long bal = __ballot(m == wm);
                const int src = __ffsll((long long)bal) - 1;
                if (lane == src) {
                    const int e = key[0] == wm ? 0 : (key[1] == wm ? 1 : (key[2] == wm ? 2 : 3));
                    __hip_atomic_fetch_or(mask + 2 * (4 * lane + e) + (q >> 5), 1u << (q & 31), __ATOMIC_RELAXED, __HIP_MEMORY_SCOPE_WORKGROUP);
                    key[0] = e == 0 ? 0u : key[0]; key[1] = e == 1 ? 0u : key[1]; key[2] = e == 2 ? 0u : key[2]; key[3] = e == 3 ? 0u : key[3];
                }
            }
        }
    }
    __syncthreads();
    const int r = lane & 31, h = lane >> 5;
    const int kl = (r * 43) >> 8, hd = r - 6 * kl, klc = kl < 4 ? kl : 0;
    const int tqa = 64 * tb + wave * 8 + klc, tqb = tqa + 4, head = g * 6 + (kl < 4 ? hd : 0);
    const bf16* Ks = (const bf16*)(ws + WS_KSEL) + (size_t)g * S * 64; const bf16* Vs = (const bf16*)(ws + WS_VTSEL) + (size_t)g * 64 * S;
    bf16x8 qa[4]; LAS bf16x8* qb = (LAS bf16x8*)(lds + 16384 + wave * 4096) + lane;
#pragma unroll
    for (int s = 0; s < 4; ++s) { qa[s] = *(const bf16x8*)((const bf16*)(ws + WS_Q) + (size_t)tqa * 768 + head * 64 + 16 * s + 8 * h);
                                  qb[s * 64] = *(const bf16x8*)((const bf16*)(ws + WS_Q) + (size_t)tqb * 768 + head * 64 + 16 * s + 8 * h); }
    LDS_WAIT();
    f32x16 Oa0, Oa1, Ob0, Ob1; float la = 0.f, lb = 0.f;
#pragma unroll
    for (int i = 0; i < 16; ++i) { Oa0[i] = 0.f; Oa1[i] = 0.f; Ob0[i] = 0.f; Ob1[i] = 0.f; }
    LAS unsigned short* wlist = (LAS unsigned short*)(lds + 2048 + wave * 512);
    int n = 0;
#pragma unroll
    for (int i = 0; i < 4; ++i) { const int jj = 64 * i + lane; unsigned bb = 0u;
        if (jj <= tb) bb = (mask[2 * jj + (wave >> 2)] >> (8 * (wave & 3))) & 0xffu;
        const unsigned long long bal = __ballot(bb != 0u); const int pos = n + __popcll(bal & ((1ull << lane) - 1ull));
        if (bb) wlist[pos] = (unsigned short)(jj | (bb << 8));
        n += __popcll(bal); }
    const int n2 = 2 * __builtin_amdgcn_readfirstlane(n);
    LDS_WAIT();
    KV32 A, B, C;
#define SEL_LD(BUF, pos) do { const int _pp = (pos) < n2 ? (pos) : n2 - 1; const int _e = __builtin_amdgcn_readfirstlane((int)wlist[_pp >> 1]); kv32_load(BUF, Ks, Vs, 64 * (_e & 255) + 32 * (_pp & 1), r, h); } while (0)
#define SEL_STEP(BUF, pos) do { if ((pos) < n2) { const int _e = __builtin_amdgcn_readfirstlane((int)wlist[(pos) >> 1]); \
        sel_sub(BUF, 64 * (_e & 255) + 32 * ((pos) & 1), (unsigned)_e >> 8, qa, qb, kl, tqa, tqb, Bs, Oa0, Oa1, Ob0, Ob1, la, lb, h); } SEL_LD(BUF, (pos) + 3); } while (0)
    if (n2 > 0) {
        SEL_LD(A, 0); SEL_LD(B, 1); SEL_LD(C, 2);
        for (int p = 0; p < n2; p += 3) { SEL_STEP(A, p); SEL_STEP(B, p + 1); SEL_STEP(C, p + 2); }
    }
#undef SEL_LD
#undef SEL_STEP
    if (kl < 4) { sel_out(P, Oa0, Oa1, la, tqa, head, h); sel_out(P, Ob0, Ob1, lb, tqb, head, h); }
    __syncthreads();
}

#define XB_TMO      128
#define XB_XCNT(j)  (256  + 64 * (j))
#define XB_XSUB(j)  (1280 + 64 * (j))
#define XB_XGEN(j)  (2304 + 64 * (j))
#define XB_TOP      3328
#define XB_TOPGEN   3392
#define XCD_BAR_WORDS 3456
#define XB_SPIN_CAP (1u << 18)

__device__ __forceinline__ unsigned xb_ld(unsigned* p)              { return __hip_atomic_load(p, __ATOMIC_RELAXED, __HIP_MEMORY_SCOPE_AGENT); }
__device__ __forceinline__ unsigned xb_add(unsigned* p, unsigned v) { return __hip_atomic_fetch_add(p, v, __ATOMIC_RELAXED, __HIP_MEMORY_SCOPE_AGENT); }
__device__ __forceinline__ unsigned xb_xcc_id() { return (unsigned)__builtin_amdgcn_s_getreg((3 << 11) | 20) & 0xFu; }
#define XB_SPIN(cond, bar) do { unsigned _sp = 0; while (cond) { __builtin_amdgcn_s_sleep(1); \
    if ((++_sp & 255u) == 0u) { if (xb_ld(&(bar)[XB_TMO])) break; if (_sp > XB_SPIN_CAP) { atomicAdd(&(bar)[XB_TMO], 1u); break; } } } } while (0)

struct XcdBarrier {
    unsigned* bar; unsigned x;
    volatile LAS unsigned* st;
};

__device__ __forceinline__ XcdBarrier xcd_barrier_post(unsigned* bar, volatile LAS unsigned* st) {
    XcdBarrier b; b.bar = bar; b.x = xb_xcc_id(); b.st = st;
    if (threadIdx.x == 0) (void)xb_add(&bar[XB_XCNT(b.x)], 1u);
    return b;
}
__device__ __forceinline__ void xcd_barrier_complete(unsigned* bar, unsigned x, unsigned& nloc, unsigned& nx) {
    const unsigned G = gridDim.x * gridDim.y * gridDim.z;
    unsigned sum, cnt, mine, sp = 0u;
    for (;;) {
        sum = 0u; cnt = 0u; mine = 0u;
#pragma unroll
        for (unsigned j = 0; j < 16; ++j) { const unsigned c = xb_ld(&bar[XB_XCNT(j)]); sum += c; cnt += (c > 0u) ? 1u : 0u; mine = (j == x) ? c : mine; }
        if (sum == G) break;
        __builtin_amdgcn_s_sleep(1);
        if ((++sp & 255u) == 0u) { if (xb_ld(&bar[XB_TMO])) break; if (sp > XB_SPIN_CAP) { atomicAdd(&bar[XB_TMO], 1u); break; } }
    }
    nloc = mine > 0u ? mine : 1u; nx = cnt > 0u ? cnt : 1u;
}

__device__ __forceinline__ void xcd_barrier(const XcdBarrier& b) {
    asm volatile("s_waitcnt vmcnt(0)" ::: "memory");
    __syncthreads();
    if (threadIdx.x == 0) {
        unsigned* bar = b.bar;
        __builtin_amdgcn_s_waitcnt(0);
        unsigned nloc = b.st[0], nx = b.st[1];
        if (nloc == 0u) { xcd_barrier_complete(bar, b.x, nloc, nx); b.st[0] = nloc; b.st[1] = nx; }
        const unsigned old = xb_add(&bar[XB_XSUB(b.x)], 1u);
        const unsigned gen = old / nloc;
        if (old + 1u == (gen + 1u) * nloc) {
            __builtin_amdgcn_fence(__ATOMIC_RELEASE, "agent");
            asm volatile("s_waitcnt vmcnt(0)" ::: "memory");
            const unsigned og = xb_add(&bar[XB_TOP], 1u);
            const unsigned tg = og / nx;
            if (og + 1u == (tg + 1u) * nx) xb_add(&bar[XB_TOPGEN], 1u);
            else XB_SPIN(xb_ld(&bar[XB_TOPGEN]) == tg, bar);
            __builtin_amdgcn_fence(__ATOMIC_ACQUIRE, "agent");
            xb_add(&bar[XB_XGEN(b.x)], 1u);
            asm volatile("s_waitcnt vmcnt(0)" ::: "memory");
        } else {
            XB_SPIN(xb_ld(&bar[XB_XGEN(b.x)]) == gen, bar);
            __builtin_amdgcn_fence(__ATOMIC_ACQUIRE, "agent");
            asm volatile("s_waitcnt vmcnt(0)" ::: "memory");
        }
    }
    __syncthreads();
}

__global__ void __launch_bounds__(NWAVES * 64, 2) yoco_fwd(Params P) {
    extern __shared__ __attribute__((aligned(16))) unsigned char lds_raw[];
    LAS unsigned char* lds = (LAS unsigned char*)lds_raw;
    const int tid = threadIdx.x, lane = tid & 63, wave = __builtin_amdgcn_readfirstlane(tid >> 6);
    const int G = gridDim.x, bx = blockIdx.x;
    const int gw = bx * NWAVES + wave, NGW = G * NWAVES;
    unsigned char* ws = P.ws;
    const int lo = P.ph_lo, hi = P.ph_hi;
#ifndef PH_MASK
#define PH_MASK 0x3fff
#endif
#define IN(k) (((PH_MASK >> (k)) & 1) && lo <= (k) && (k) < hi)
    volatile LAS unsigned* xst = (volatile LAS unsigned*)(lds + LDS_BYTES - 64);
    if (tid < 2) xst[tid] = 0u;
    __syncthreads();
    const XcdBarrier xbar = xcd_barrier_post((unsigned*)(ws + WS_CNT) + 1024, xst);
#define SEAM(k) do { if (IN(k) && IN((k) + 1)) { { xcd_barrier(xbar); } } } while (0)
    float* ss1 = (float*)(ws + WS_SS); float* ss2 = ss1 + S; float* ss3 = ss2 + S;
    bf16* xb = (bf16*)(ws + WS_XB); bf16* mix = (bf16*)(ws + WS_MIX); bf16* hb = (bf16*)(ws + WS_HB);

    if (IN(0)) { p0_prologue(P, lds, gw, NGW, wave, lane); __syncthreads(); }
    SEAM(0);
    if (IN(1)) {
        { pg8::Gemm g{xb, (const bf16*)(ws + WS_WA), S, 1792, D, D}; pg8::StaticOrder So; So.init(S, 1792, G, bx);
          EpiA E{(bf16*)(ws + WS_VGLU), (bf16*)(ws + WS_QM0), P.in[I_ABGLU], P.in[I_MQG], ss1 + 3 * S};
          pg8::gemm_phase<EpiA, pg8::StaticOrder, true>(lds, g, So, E); }
        { pg8::Gemm g{(const bf16*)(ws + WS_MEMB), (const bf16*)(ws + WS_WM), 256, 1024, D, D};
          const int c = G >= 4 ? bx - (G - 4) : bx; pg8::ListOrder So{4, 4, G >= 4 ? 4 : G, c, 0};
          EpiMem E{(bf16*)(ws + WS_MK), (bf16*)(ws + WS_MVT), P.in[I_MKG]};
          pg8::gemm_phase<EpiMem, pg8::ListOrder, true>(lds, g, So, E); }
    }
    SEAM(1);
    if (IN(2)) {
        for (int task = gw; task < S / 4; task += NGW) conv_task(P, task * 4, lane);
        mem_attn_phase(P, 0, (const bf16*)(ws + WS_QM0), gw, NGW, lane);
        if (bx == 0) { const int i = tid; float s = 0.f; const float* bp = (const float*)(ws + WS_BPART) + (i >> 8) * 64 * 256 + (i & 255);
            for (int kc = 0; kc < 64; ++kc) s += bp[kc * 256];
            ((float*)(ws + WS_BIAS1))[i] = s; }
    }
    SEAM(2);
    if (IN(3)) { pg8::Gemm g{mix, (const bf16*)(ws + WS_WO), S, D, D, D}; pg8::StaticOrder So; So.init(S, D, G, bx);
        EpiRes E{nullptr, xb, nullptr, xb, ss1, 0}; pg8::gemm_phase<EpiRes, pg8::StaticOrder, true>(lds, g, So, E); }
    SEAM(3);
    if (IN(4)) { pg8::Gemm g{xb, (const bf16*)(ws + WS_W1), S, FF, D, D}; pg8::StaticOrder So; So.init(S, FF, G, bx);
        EpiMlpIn E{hb, ss1}; pg8::gemm_phase<EpiMlpIn, pg8::StaticOrder, true>(lds, g, So, E); }
    SEAM(4);
    if (IN(5)) { pg8::Gemm g{hb, (const bf16*)(ws + WS_W2), S, D, FF, FF}; pg8::StaticOrder So; So.init(S, D, G, bx);
        EpiRes E{nullptr, xb, nullptr, xb, ss2, 0}; pg8::gemm_phase<EpiRes, pg8::StaticOrder, true>(lds, g, So, E); }
    SEAM(5);
    if (IN(6)) {
        if (bx == 0 && tid < 512) ((unsigned*)(ws + WS_CBUF + (size_t)4 * S * 64 * 2))[tid] = 0u;
        pg8::Gemm g{xb, (const bf16*)(ws + WS_WB), S, 2048, D, D}; pg8::StaticOrder So; So.init(S, 2048, G, bx);
        EpiB E{ss2, (bf16*)(ws + WS_CBUF), (bf16*)(ws + WS_KSEL), (bf16*)(ws + WS_VTSEL), (bf16*)(ws + WS_KWIN), (bf16*)(ws + WS_VTWIN), (bf16*)(ws + WS_Q), (bf16*)(ws + WS_QM1),
               (float*)(ws + WS_GATES), P.in[I_KNG], P.in[I_BQG], P.in[I_MQG] + 64, P.in[I_BGATEB]};
        pg8::gemm_phase<EpiB, pg8::StaticOrder, true>(lds, g, So, E); }
    SEAM(6);
    if (IN(7)) {
        { pg8::Gemm g{(const bf16*)(ws + WS_CBUF), (const bf16*)(ws + WS_W1C), 4096, 2048, 512, 1024}; pg8::ListOrder So{64, 1, G, bx, 1};
          EpiC E{(float*)(ws + WS_PART)}; pg8::gemm_phase<EpiC, pg8::ListOrder, true>(lds, g, So, E); }
        if (G > 128) mem_attn_phase(P, 1, (const bf16*)(ws + WS_QM1), bx >= 64 ? gw - 64 * NWAVES : -1, NGW - 64 * NWAVES, lane);
        else mem_attn_phase(P, 1, (const bf16*)(ws + WS_QM1), gw, NGW, lane);
    }
    SEAM(7);
    if (IN(8)) { for (int task = gw; task < 128; task += NGW) cmp2_task(P, task, lane); }
    SEAM(8);
    if (IN(9)) {
        const float gq = gain_max(P.in[I_BQG], lane);
        const float Bc = BNDC * gq * gain_max(P.in[I_KNG], lane) * 1.02f, Bw = BNDC * gq * gain_max(P.in[I_KNG] + 128, lane) * 1.02f;
        LAS float* wl = (LAS float*)(lds + wave * 1024);
        unsigned* cq = (unsigned*)(ws + WS_CNT); unsigned* wq = cq + 3;
        volatile LAS unsigned* pflag = (volatile LAS unsigned*)(lds + 120000);
        unsigned idx0 = 0xffffffffu;
        if (wave < 4) { if (lane == 0) idx0 = atomicAdd(cq, 1u); idx0 = (unsigned)__builtin_amdgcn_readfirstlane((int)idx0); if (lane == 0) pflag[wave] = idx0 < 448u ? 1u : 0u; }
        __syncthreads();
        if (wave < 4) {
            if (idx0 < 1024u) cmp_tile_task(P, 511 - (int)(idx0 >> 1), (int)(idx0 & 1u), Bc, wl, (LAS bf16x8*)(lds + 16384 + wave * 12288) + lane, lane);
            if (lane == 0) pflag[wave] = 0u;
        } else {
            while (__builtin_amdgcn_readfirstlane((int)pflag[wave - 4]) != 0) __builtin_amdgcn_s_sleep(32);
        }
        for (int pass = 0; pass < 2; ++pass) {
            const bool do_cmp = (wave < 4) == (pass == 0);
            for (;;) {
                unsigned idx = 0; if (lane == 0) idx = atomicAdd(do_cmp ? cq : wq, 1u); idx = (unsigned)__builtin_amdgcn_readfirstlane((int)idx);
                if (idx >= (do_cmp ? 1024u : 6144u)) break;
                if (do_cmp) cmp_tile_task(P, 511 - (int)(idx >> 1), (int)(idx & 1u), Bc, wl, (LAS bf16x8*)(lds + 16384 + wave * 12288) + lane, lane);
                else win_tile_task(P, (int)(idx / 12u), (int)(idx % 12u), Bw, lane);
            }
        }
        __syncthreads();
    }
    SEAM(9);
    if (IN(10)) {
        const float Bs = BNDC * gain_max(P.in[I_BQG], lane) * gain_max(P.in[I_KNG] + 64, lane) * 1.02f;
        if (G == 256) {
            sel_unit(P, 255 - (bx >> 1), bx & 1, Bs, lds, tid, wave, lane);
            sel_unit(P, bx >> 1, bx & 1, Bs, lds, tid, wave, lane);
        } else {
            for (int i = 0, u = bx; u < 512; ++i, u += G) {
                const int base = i * G, span = (512 - base) < G ? (512 - base) : G;
                const int uu = (i & 1) ? base + span - 1 - (u - base) : u;
                const int v = 511 - uu;
                sel_unit(P, v >> 1, v & 1, Bs, lds, tid, wave, lane);
            }
        }
    }
    SEAM(10);
    if (IN(11)) { pg8::Gemm g{mix, (const bf16*)(ws + WS_WO) + (size_t)D * D, S, D, D, D}; pg8::StaticOrder So; So.init(S, D, G, bx);
        EpiRes E{nullptr, xb, nullptr, xb, ss3, 0}; pg8::gemm_phase<EpiRes, pg8::StaticOrder, true>(lds, g, So, E); }
    SEAM(11);
    if (IN(12)) { pg8::Gemm g{xb, (const bf16*)(ws + WS_W1) + (size_t)D * FF, S, FF, D, D}; pg8::StaticOrder So; So.init(S, FF, G, bx);
        EpiMlpIn E{hb, ss3}; pg8::gemm_phase<EpiMlpIn, pg8::StaticOrder, true>(lds, g, So, E); }
    SEAM(12);
    if (IN(13)) { pg8::Gemm g{hb, (const bf16*)(ws + WS_W2) + (size_t)D * FF, S, D, FF, FF}; pg8::StaticOrder So; So.init(S, D, G, bx);
        EpiRes E{nullptr, xb, P.out, xb, ss3, 1}; pg8::gemm_phase<EpiRes, pg8::StaticOrder, true>(lds, g, So, E); }
    if (P.ph_hi > 1000) cg::this_grid().sync();
#undef IN
#undef SEAM
}

extern "C" void kernel_launch(void* const* d_in, const int* in_sizes, int n_in, void* d_out, int out_size, void* d_ws, size_t ws_size, hipStream_t stream) {
    static int grid = 0;
    if (grid == 0) {
        if (n_in != 29 || out_size != S * D || ws_size < WS_END) { fprintf(stderr, "kernel_launch: unexpected shapes (n_in %d out %d ws %zu)\n", n_in, out_size, ws_size); grid = -1; return; }
        int dev = 0, cus = 0, per_cu = 0;
        hipGetDevice(&dev); hipDeviceGetAttribute(&cus, hipDeviceAttributeMultiprocessorCount, dev);
        hipFuncSetAttribute((const void*)yoco_fwd, hipFuncAttributeMaxDynamicSharedMemorySize, LDS_BYTES);
        hipOccupancyMaxActiveBlocksPerMultiprocessor(&per_cu, (const void*)yoco_fwd, NWAVES * 64, LDS_BYTES);
        if (per_cu < 1) { fprintf(stderr, "kernel_launch: occupancy query reports %d\n", per_cu); per_cu = 1; }
        (void)hipGetLastError();
        grid = cus;
    }
    if (grid < 0) return;
    (void)hipMemsetAsync((char*)d_ws + WS_CNT, 0, 32768, stream);
    Params p{};
    for (int i = 0; i < 29; ++i) p.in[i] = (const float*)d_in[i];
    p.out = (float*)d_out; p.ws = (unsigned char*)d_ws; p.ph_lo = 0; p.ph_hi = 14;
    void* args[] = {&p};
    hipError_t e = hipLaunchCooperativeKernel((const void*)yoco_fwd, dim3(grid), dim3(NWAVES * 64), args, LDS_BYTES, stream);
    if (e != hipSuccess) fprintf(stderr, "cooperative launch failed: %s (grid %d)\n", hipGetErrorString(e), grid);
}
```

```cpp
#include <hip/hip_runtime.h>
#include <hip/hip_cooperative_groups.h>
#include <cstdio>
#include <cstdint>
namespace cg = cooperative_groups;

#define LAS __attribute__((address_space(3)))
typedef unsigned short bf16;
typedef short bf16x8 __attribute__((ext_vector_type(8)));
typedef short s16x4 __attribute__((ext_vector_type(4)));
typedef float f32x2 __attribute__((ext_vector_type(2)));
typedef float f32x4 __attribute__((ext_vector_type(4)));
typedef float f32x16 __attribute__((ext_vector_type(16)));
typedef unsigned u32x2 __attribute__((ext_vector_type(2)));
typedef unsigned u32x4 __attribute__((ext_vector_type(4)));
typedef __bf16 bf16x2_t __attribute__((ext_vector_type(2)));
#define DI __device__ __forceinline__

DI unsigned pk2(float lo, float hi) { f32x2 v = {lo, hi}; bf16x2_t b = __builtin_convertvector(v, bf16x2_t); return __builtin_bit_cast(unsigned, b); }
DI float wave_sum(float v) {
#pragma unroll
    for (int o = 1; o < 64; o <<= 1) v += __shfl_xor(v, o);
    return v;
}
DI float wave_max(float v) {
#pragma unroll
    for (int o = 1; o < 64; o <<= 1) v = fmaxf(v, __shfl_xor(v, o));
    return v;
}
DI unsigned wave_max_u32(unsigned x) {
#define WMX(ctrl, rm) { const unsigned y = (unsigned)__builtin_amdgcn_update_dpp(0, (int)x, ctrl, rm, 0xf, false); x = y > x ? y : x; }
    WMX(0x111, 0xf) WMX(0x112, 0xf) WMX(0x114, 0xf) WMX(0x118, 0xf) WMX(0x142, 0xa) WMX(0x143, 0xc)
#undef WMX
    return (unsigned)__builtin_amdgcn_readlane((int)x, 63);
}
DI float sigmoidf_(float x) { return 1.0f / (1.0f + __expf(-x)); }
#define LDS_WAIT() asm volatile("s_waitcnt lgkmcnt(0)" ::: "memory")

constexpr int S = 16384, D = 1024, FF = 4096, MEML = 256;
constexpr float EPS = 1e-6f;
constexpr float QSCALE = 0.125f * 1.4426950408889634f;
constexpr float BNDC = 64.0f * QSCALE;

namespace pg8 {
#define PG8_LAS __attribute__((address_space(3)))
constexpr int BM = 256, BK = 64, HALF = 128, HTB = HALF * BK * 2, STAGE_BYTES = 8 * HTB, NXCD = 8, WGM = 4;
__host__ __device__ __forceinline__ int lds_byte(int r, int c) { const int st = (r >> 4) * 2 + (c >> 5), rr = r & 15, cc = c & 31, ob = rr * 64 + cc * 2; return st * 1024 + (ob ^ (((ob >> 9) & 1) << 5)); }
__host__ __device__ __forceinline__ void stage_rc(int b, int& R, int& C) { const int st = b / 1024, sb = b % 1024, swz = sb ^ (((sb >> 9) & 1) << 5); R = (st >> 1) * 16 + swz / 64; C = (st & 1) * 32 + (swz % 64) / 2; }
__host__ __device__ __forceinline__ int perm32(int rho) { const int n = rho >> 4, i = rho & 15; return 8 * (i >> 2) + 4 * n + (i & 3); }
struct Unit { int pm, pn; };
struct Gemm { const bf16* A; const bf16* Bt; int M, N, K, lda; };
struct StaticOrder {
    int nM, nN, nwg, G, c;
    __device__ void init(int M, int N, int G_, int c_) { nM = M / BM; nN = N / BM; nwg = nM * nN; G = G_; c = c_; }
    __device__ bool next(int i, Unit& u) const {
        const long L = (long)i * G + c; if (L >= nwg) return false;
        int wgid = (int)L; { const int q = nwg / NXCD, r = nwg % NXCD, xcd = wgid % NXCD, off = wgid / NXCD; wgid = (xcd < r ? xcd * (q + 1) : r * (q + 1) + (xcd - r) * q) + off; }
        const int nig = WGM * nN, gid = wgid / nig, fm = gid * WGM, gsz = (nM - fm) < WGM ? (nM - fm) : WGM;
        u.pm = fm + ((wgid % nig) % gsz); u.pn = (wgid % nig) / gsz; return true;
    }
    __device__ size_t aoff(const Unit&) const { return 0; }
};
struct ListOrder {
    int n, nN, G, c, cmp;
    __device__ bool next(int i, Unit& u) const { const int L = c + i * G; if (c < 0 || L >= n) return false; if (cmp) { u.pm = L >> 2; u.pn = (L >> 5) * 4 + (L & 3); } else { u.pm = L / nN; u.pn = L % nN; } return true; }
    __device__ size_t aoff(const Unit& u) const { return cmp ? (size_t)(u.pn & 3) * 1024 : 0; }
};

template <class Epi, class Sched, bool ALIGN_EPI>
__device__ __forceinline__ void gemm_phase(PG8_LAS unsigned char* lds, const Gemm g, const Sched& S, const Epi& E) {
    const int tid = threadIdx.x, wid = __builtin_amdgcn_readfirstlane(tid >> 6), lane = tid & 63, wr = wid >> 2, wc = wid & 3, fr = lane & 15, fq = lane >> 4;
    const int K = g.K, nt = K / BK, lda = g.lda;
    unsigned voffA[2], voffB[2];
#pragma unroll
    for (int i = 0; i < 2; ++i) { int R, C; stage_rc(tid * 16 + i * 8192, R, C); const int Rb = Epi::PERM ? ((R & ~31) + perm32(R & 31)) : R;
        voffA[i] = (unsigned)(R * lda + C) * 2u; voffB[i] = (unsigned)(Rb * K + C) * 2u; }
    const size_t kstep = (size_t)(BK * 2);
    const size_t hstepA = (size_t)HALF * lda * 2, hstepB = (size_t)HALF * K * 2;
    const size_t tstepA = 2 * hstepA, tstepB = 2 * hstepB;
    const unsigned ldsw = (unsigned)wid * 1024u;
    const int aoff = lds_byte(wr * 64 + fr, fq * 8), boff = lds_byte(wc * 32 + fr, fq * 8);
#define PG8_SA(b, h) (((b) * 2 + (h)) * HTB)
#define PG8_SB(b, h) ((4 + (b) * 2 + (h)) * HTB)
#define PG8_STAGE(bufoff, gbase, voff) do { _Pragma("unroll") for (int _i = 0; _i < 2; ++_i) \
        __builtin_amdgcn_global_load_lds((const unsigned*)((const char*)(gbase) + (voff)[_i]), (PG8_LAS unsigned*)(lds + (bufoff) + ldsw + _i * 8192), 16, 0, 0); } while (0)
#define PG8_LDA(dst, b, h) do { _Pragma("unroll") for (int m = 0; m < 4; ++m) _Pragma("unroll") for (int k = 0; k < 2; ++k) dst[m][k] = *(const PG8_LAS bf16x8*)(lds + PG8_SA(b, h) + aoff + m * 2048 + k * 1024); } while (0)
#define PG8_LDB(dst, b, h) do { _Pragma("unroll") for (int n = 0; n < 2; ++n) _Pragma("unroll") for (int k = 0; k < 2; ++k) dst[n][k] = *(const PG8_LAS bf16x8*)(lds + PG8_SB(b, h) + boff + n * 2048 + k * 1024); } while (0)
#define PG8_MMA(ai, bj, At, Bt) do { __builtin_amdgcn_s_setprio(1); _Pragma("unroll") for (int m = 0; m < 4; ++m) _Pragma("unroll") for (int n = 0; n < 2; ++n) _Pragma("unroll") for (int k = 0; k < 2; ++k) \
        acc[ai][bj][m][n] = __builtin_amdgcn_mfma_f32_16x16x32_bf16(Bt[n][k], At[m][k], acc[ai][bj][m][n], 0, 0, 0); __builtin_amdgcn_s_setprio(0); } while (0)
#define PG8_WAIT_V(n) asm volatile("s_waitcnt vmcnt(" #n ")" ::: "memory")
#define PG8_WAIT_L(n) asm volatile("s_waitcnt lgkmcnt(" #n ")" ::: "memory")
#define PG8_BAR __builtin_amdgcn_s_barrier()
#define PG8_SCHED __builtin_amdgcn_sched_barrier(0)
    Unit cur, nxt; int ui = 0;
    if (!S.next(0, cur)) return;
    f32x4 acc[2][2][4][2];
#pragma unroll
    for (int a = 0; a < 2; ++a)
#pragma unroll
        for (int b = 0; b < 2; ++b)
#pragma unroll
            for (int m = 0; m < 4; ++m)
#pragma unroll
                for (int n = 0; n < 2; ++n) acc[a][b][m][n] = (f32x4){0.f, 0.f, 0.f, 0.f};
    bf16x8 At[4][2], B0[2][2], B1[2][2];
    const char* cA = (const char*)g.A + (size_t)cur.pm * tstepA + S.aoff(cur); const char* cB = (const char*)g.Bt + (size_t)cur.pn * tstepB;
    PG8_STAGE(PG8_SB(0, 0), cB, voffB); PG8_STAGE(PG8_SB(0, 1), cB + hstepB, voffB); PG8_STAGE(PG8_SA(0, 0), cA, voffA); PG8_STAGE(PG8_SA(0, 1), cA + hstepA, voffA);
    if (wr == 1) PG8_BAR;
    PG8_WAIT_V(2); PG8_BAR;
    PG8_STAGE(PG8_SB(1, 0), cB + kstep, voffB); PG8_STAGE(PG8_SA(1, 0), cA + kstep, voffA); PG8_STAGE(PG8_SB(1, 1), cB + hstepB + kstep, voffB);
    PG8_WAIT_V(6); PG8_BAR;
    for (;;) {
        const bool has_next = S.next(ui + 1, nxt);
        const char* nA = has_next ? (const char*)g.A + (size_t)nxt.pm * tstepA + S.aoff(nxt) : cA; const char* nB = has_next ? (const char*)g.Bt + (size_t)nxt.pn * tstepB : cB;
        for (int t = 0; t < nt; t += 2) {
            const bool last = (t == nt - 2);
            const char* a1 = cA + (size_t)(t + 1) * kstep;
            const char* a2 = last ? nA : cA + (size_t)(t + 2) * kstep; const char* b2 = last ? nB : cB + (size_t)(t + 2) * kstep;
            const char* a3 = a2 + kstep; const char* b3 = b2 + kstep;
            PG8_LDB(B0, 0, 0); PG8_LDB(B1, 0, 1); PG8_SCHED; PG8_LDA(At, 0, 0); PG8_STAGE(PG8_SA(1, 1), a1 + hstepA, voffA);
            PG8_WAIT_V(8); PG8_WAIT_L(0); PG8_BAR; PG8_MMA(0, 0, At, B0); PG8_MMA(0, 1, At, B1); PG8_BAR; PG8_SCHED;
            PG8_LDA(At, 0, 1); PG8_STAGE(PG8_SB(0, 0), b2, voffB); PG8_STAGE(PG8_SB(0, 1), b2 + hstepB, voffB); PG8_STAGE(PG8_SA(0, 0), a2, voffA);
            PG8_WAIT_V(8); PG8_WAIT_L(0); PG8_BAR; PG8_MMA(1, 0, At, B0); PG8_MMA(1, 1, At, B1); PG8_BAR; PG8_SCHED;
            PG8_LDB(B0, 1, 0); PG8_LDB(B1, 1, 1); PG8_SCHED; PG8_LDA(At, 1, 0); PG8_STAGE(PG8_SA(0, 1), a2 + hstepA, voffA);
            PG8_WAIT_V(8); PG8_WAIT_L(0); PG8_BAR; PG8_MMA(0, 0, At, B0); PG8_MMA(0, 1, At, B1); PG8_BAR; PG8_SCHED;
            PG8_LDA(At, 1, 1); PG8_STAGE(PG8_SB(1, 0), b3, voffB); PG8_STAGE(PG8_SB(1, 1), b3 + hstepB, voffB); PG8_STAGE(PG8_SA(1, 0), a3, voffA);
            PG8_WAIT_V(8); PG8_WAIT_L(0); PG8_BAR; PG8_MMA(1, 0, At, B0); PG8_MMA(1, 1, At, B1); PG8_BAR; PG8_SCHED;
        }
        if constexpr (ALIGN_EPI) { if (wr == 0) PG8_BAR; }
        E(acc, cur, wr, wc, fr, fq);
        if (!has_next) break;
#pragma unroll
        for (int a = 0; a < 2; ++a)
#pragma unroll
            for (int b = 0; b < 2; ++b)
#pragma unroll
                for (int m = 0; m < 4; ++m)
#pragma unroll
                    for (int n = 0; n < 2; ++n) acc[a][b][m][n] = (f32x4){0.f, 0.f, 0.f, 0.f};
        cur = nxt; cA = nA; cB = nB; ++ui;
        if constexpr (ALIGN_EPI) { if (wr == 1) PG8_BAR; }
    }
    PG8_WAIT_V(0);
    if constexpr (!ALIGN_EPI) { if (wr == 0) PG8_BAR; }
    PG8_BAR;
#undef PG8_SA
#undef PG8_SB
#undef PG8_STAGE
#undef PG8_LDA
#undef PG8_LDB
#undef PG8_MMA
#undef PG8_WAIT_V
#undef PG8_WAIT_L
#undef PG8_BAR
#undef PG8_SCHED
}
}
using pg8::Unit; using pg8::HALF; using pg8::BM;

typedef f32x4 Acc[2][2][4][2];

DI int kimg(int key, int dim) { return ((((key >> 5) & 1) * 4 + (dim >> 4)) * 64 + ((dim >> 3) & 1) * 32 + (key & 31)) * 8 + (dim & 7); }
DI int vimg(int dim, int key) { return (((((key >> 5) & 1) * 2 + ((key >> 4) & 1)) * 2 + (dim >> 5)) * 64 + ((key >> 2) & 1) * 32 + (dim & 31)) * 8 + ((key >> 3) & 1) * 4 + (key & 3); }
DI f32x4 ld_bf16x4(const bf16* p) { const u32x2 raw = *(const u32x2*)p; return (f32x4){__uint_as_float(raw.x << 16), __uint_as_float(raw.x & 0xffff0000u), __uint_as_float(raw.y << 16), __uint_as_float(raw.y & 0xffff0000u)}; }
DI void st_bf16x4(bf16* p, f32x4 v) { u32x2 w; w.x = pk2(v[0], v[1]); w.y = pk2(v[2], v[3]); *(u32x2*)p = w; }

DI float head_rs(const Acc& acc, int ai, int m, float pre) {
    float s = 0.f;
#pragma unroll
    for (int bj = 0; bj < 2; ++bj)
#pragma unroll
        for (int n = 0; n < 2; ++n) { const f32x4 x = acc[ai][bj][m][n] * pre; s += (x[0] * x[0] + x[1] * x[1]) + (x[2] * x[2] + x[3] * x[3]); }
    s += __shfl_xor(s, 16); s += __shfl_xor(s, 32);
    return __builtin_amdgcn_rsqf(s * (1.0f / 64.0f) + EPS);
}

struct EpiA {
    static constexpr bool PERM = true;
    bf16* vglu; bf16* qm; const float* b_glu; const float* qg; const float* ss0;
    DI void operator()(const Acc& acc, const Unit& u, int wr, int wc, int fr, int fq) const {
        const int row0 = u.pm * BM + wr * 64 + fr;
        if (u.pn < 6) {
            const int ch0 = 128 * u.pn + 32 * wc + 8 * fq;
            const f32x4 ba0 = *(const f32x4*)(b_glu + ch0), ba1 = *(const f32x4*)(b_glu + ch0 + 4), bg0 = *(const f32x4*)(b_glu + 768 + ch0), bg1 = *(const f32x4*)(b_glu + 768 + ch0 + 4);
#pragma unroll
            for (int ai = 0; ai < 2; ++ai)
#pragma unroll
                for (int m = 0; m < 4; ++m) {
                    const float rs = __builtin_amdgcn_rsqf(ss0[row0 + ai * HALF + m * 16] * (1.0f / D) + EPS);
                    const f32x4 a0 = acc[ai][0][m][0] * rs + ba0, a1 = acc[ai][0][m][1] * rs + ba1, g0 = acc[ai][1][m][0] * rs + bg0, g1 = acc[ai][1][m][1] * rs + bg1; f32x4 v0, v1;
#pragma unroll
                    for (int e = 0; e < 4; ++e) { v0[e] = a0[e] * sigmoidf_(g0[e]); v1[e] = a1[e] * sigmoidf_(g1[e]); }
                    u32x4 w; w.x = pk2(v0[0], v0[1]); w.y = pk2(v0[2], v0[3]); w.z = pk2(v1[0], v1[1]); w.w = pk2(v1[2], v1[3]);
                    *(u32x4*)(vglu + (size_t)(row0 + ai * HALF + m * 16) * 768 + ch0) = w;
                }
        } else {
#pragma unroll
            for (int ai = 0; ai < 2; ++ai)
#pragma unroll
                for (int m = 0; m < 4; ++m) {
                    const float rs = __builtin_amdgcn_rsqf(ss0[row0 + ai * HALF + m * 16] * (1.0f / D) + EPS);
                    const float r = head_rs(acc, ai, m, rs) * rs * QSCALE;
#pragma unroll
                    for (int bj = 0; bj < 2; ++bj) { const int d0 = 32 * bj + 8 * fq; const f32x4 g0 = *(const f32x4*)(qg + d0), g1 = *(const f32x4*)(qg + d0 + 4);
                        const f32x4 v0 = acc[ai][bj][m][0] * r * g0, v1 = acc[ai][bj][m][1] * r * g1;
                        u32x4 w; w.x = pk2(v0[0], v0[1]); w.y = pk2(v0[2], v0[3]); w.z = pk2(v1[0], v1[1]); w.w = pk2(v1[2], v1[3]);
                        *(u32x4*)(qm + (size_t)(row0 + ai * HALF + m * 16) * 256 + wc * 64 + d0) = w; }
                }
        }
    }
};
struct EpiMem {
    static constexpr bool PERM = false;
    bf16* mk; bf16* mvT; const float* kg;
    DI void operator()(const Acc& acc, const Unit& u, int wr, int wc, int fr, int fq) const {
        const int l = u.pn >> 1, kv = u.pn & 1, row0 = wr * 64 + fr;
#pragma unroll
        for (int ai = 0; ai < 2; ++ai)
#pragma unroll
            for (int m = 0; m < 4; ++m) {
                const int row = row0 + ai * HALF + m * 16;
                if (kv == 0) {
                    const float r = head_rs(acc, ai, m, 1.0f);
#pragma unroll
                    for (int bj = 0; bj < 2; ++bj)
#pragma unroll
                        for (int n = 0; n < 2; ++n) { const int d0 = 32 * bj + 16 * n + 4 * fq; const f32x4 g4 = *(const f32x4*)(kg + l * 64 + d0);
                            st_bf16x4(mk + ((size_t)((l * 4 + wc) * 4 + (row >> 6))) * 4096 + ((row >> 5) & 1) * 2048 + (row & 31) * 8 + (2 * bj + n) * 512 + (fq >> 1) * 256 + 4 * (fq & 1), acc[ai][bj][m][n] * r * g4); }
                } else {
#pragma unroll
                    for (int bj = 0; bj < 2; ++bj)
#pragma unroll
                        for (int n = 0; n < 2; ++n) { const int d0 = 32 * bj + 16 * n + 4 * fq; const f32x4 v = acc[ai][bj][m][n];
#pragma unroll
                            for (int e = 0; e < 4; ++e) mvT[((size_t)((l * 4 + wc) * 4 + (row >> 6))) * 4096 + vimg(0, row & 63) + bj * 512 + (16 * n + 4 * fq + e) * 8] = (bf16)(pk2(v[e], 0.f) & 0xffffu); }
                }
            }
    }
};
struct EpiRes {
    static constexpr bool PERM = true;
    const float* bf; const bf16* bb; float* out; bf16* xb; float* ss; int last;
    DI void operator()(const Acc& acc, const Unit& u, int wr, int wc, int fr, int fq) const {
        const int row0 = u.pm * BM + wr * 64 + fr, col0 = u.pn * BM + wc * 32 + 8 * fq;
#pragma unroll
        for (int ai = 0; ai < 2; ++ai)
#pragma unroll
            for (int m = 0; m < 4; ++m) {
                const int row = row0 + ai * HALF + m * 16; const size_t p = (size_t)row * D + col0; float s = 0.f;
#pragma unroll
                for (int bj = 0; bj < 2; ++bj) { const size_t off = p + bj * HALF;
                    const u32x4 raw = *(const u32x4*)(bb + off);
                    const f32x4 v0 = (f32x4){__uint_as_float(raw.x << 16), __uint_as_float(raw.x & 0xffff0000u), __uint_as_float(raw.y << 16), __uint_as_float(raw.y & 0xffff0000u)} + acc[ai][bj][m][0];
                    const f32x4 v1 = (f32x4){__uint_as_float(raw.z << 16), __uint_as_float(raw.z & 0xffff0000u), __uint_as_float(raw.w << 16), __uint_as_float(raw.w & 0xffff0000u)} + acc[ai][bj][m][1];
                    if (out) { __builtin_nontemporal_store(v0, (f32x4*)(out + off)); __builtin_nontemporal_store(v1, (f32x4*)(out + off + 4)); }
                    if (!last) { u32x4 w; w.x = pk2(v0[0], v0[1]); w.y = pk2(v0[2], v0[3]); w.z = pk2(v1[0], v1[1]); w.w = pk2(v1[2], v1[3]); *(u32x4*)(xb + off) = w;
                        s += (v0[0] * v0[0] + v0[1] * v0[1]) + (v0[2] * v0[2] + v0[3] * v0[3]) + (v1[0] * v1[0] + v1[1] * v1[1]) + (v1[2] * v1[2] + v1[3] * v1[3]); } }
                if (!last) { s += __shfl_xor(s, 16); s += __shfl_xor(s, 32); if (fq == 0) unsafeAtomicAdd(ss + row, s); }
            }
    }
};
struct EpiMlpIn {
    static constexpr bool PERM = true;
    bf16* hb; const float* ss;
    DI void operator()(const Acc& acc, const Unit& u, int wr, int wc, int fr, int fq) const {
        const int row0 = u.pm * BM + wr * 64 + fr, col0 = u.pn * BM + wc * 32 + 8 * fq;
#pragma unroll
        for (int ai = 0; ai < 2; ++ai)
#pragma unroll
            for (int m = 0; m < 4; ++m) {
                const int row = row0 + ai * HALF + m * 16; const float rs = __builtin_amdgcn_rsqf(ss[row] * (1.0f / D) + EPS);
#pragma unroll
                for (int bj = 0; bj < 2; ++bj) { f32x4 v0 = acc[ai][bj][m][0] * rs, v1 = acc[ai][bj][m][1] * rs;
#pragma unroll
                    for (int e = 0; e < 4; ++e) { const float a = fmaxf(v0[e], 0.f), b = fmaxf(v1[e], 0.f); v0[e] = a * a; v1[e] = b * b; }
                    u32x4 w; w.x = pk2(v0[0], v0[1]); w.y = pk2(v0[2], v0[3]); w.z = pk2(v1[0], v1[1]); w.w = pk2(v1[2], v1[3]);
                    *(u32x4*)(hb + (size_t)row * FF + col0 + bj * HALF) = w; }
            }
    }
};
struct EpiB {
    static constexpr bool PERM = true;
    const float* ss; bf16* cbuf; bf16* ksel; bf16* vTsel; bf16* kwin; bf16* vTwin; bf16* q; bf16* qm; float* gates;
    const float* kng; const float* qng; const float* mqg; const float* gate_b;
    DI void operator()(const Acc& acc, const Unit& u, int wr, int wc, int fr, int fq) const {
        const int row0 = u.pm * BM + wr * 64 + fr; const int pn = u.pn;
#pragma unroll
        for (int ai = 0; ai < 2; ++ai)
#pragma unroll
            for (int m = 0; m < 4; ++m) {
                const int row = row0 + ai * HALF + m * 16; const float rs = __builtin_amdgcn_rsqf(ss[row] * (1.0f / D) + EPS);
                if (pn == 0) {
#pragma unroll
                    for (int bj = 0; bj < 2; ++bj) { const f32x4 v0 = acc[ai][bj][m][0] * rs, v1 = acc[ai][bj][m][1] * rs;
                        u32x4 w; w.x = pk2(v0[0], v0[1]); w.y = pk2(v0[2], v0[3]); w.z = pk2(v1[0], v1[1]); w.w = pk2(v1[2], v1[3]);
                        *(u32x4*)(cbuf + ((size_t)wc * S + row) * 64 + 32 * bj + 8 * fq) = w; }
                } else if (pn <= 2) {
                    bf16* kd = pn == 1 ? ksel : kwin; bf16* vd = pn == 1 ? vTsel : vTwin; const float* g = kng + pn * 64;
                    if (wc < 2) {
                        const float r = head_rs(acc, ai, m, rs) * rs;
#pragma unroll
                        for (int bj = 0; bj < 2; ++bj) { const int d0 = 32 * bj + 8 * fq; const f32x4 g0 = *(const f32x4*)(g + d0), g1 = *(const f32x4*)(g + d0 + 4);
                            const f32x4 v0 = acc[ai][bj][m][0] * r * g0, v1 = acc[ai][bj][m][1] * r * g1;
                            u32x4 w; w.x = pk2(v0[0], v0[1]); w.y = pk2(v0[2], v0[3]); w.z = pk2(v1[0], v1[1]); w.w = pk2(v1[2], v1[3]);
                            *(u32x4*)(kd + ((size_t)wc * (S / 64) + (row >> 6)) * 4096 + ((row >> 5) & 1) * 2048 + (2 * bj + (fq >> 1)) * 512 + (fq & 1) * 256 + (row & 31) * 8) = w; }
                    } else {
#pragma unroll
                        for (int bj = 0; bj < 2; ++bj)
#pragma unroll
                            for (int n = 0; n < 2; ++n) { const f32x4 v = acc[ai][bj][m][n] * rs;
#pragma unroll
                                for (int e = 0; e < 4; ++e) vd[((size_t)(wc - 2) * (S / 64) + (row >> 6)) * 4096 + vimg(0, row & 63) + bj * 512 + (8 * fq + 4 * n + e) * 8] = (bf16)(pk2(v[e], 0.f) & 0xffffu); }
                    }
                } else if (pn <= 6) {
                    const float r = head_rs(acc, ai, m, rs) * rs * QSCALE; const float* g = pn == 6 ? mqg : qng;
                    bf16* dst = pn == 6 ? qm + (size_t)row * 256 + wc * 64 : q + (size_t)row * 768 + ((pn - 3) * 4 + wc) * 64;
#pragma unroll
                    for (int bj = 0; bj < 2; ++bj) { const int d0 = 32 * bj + 8 * fq; const f32x4 g0 = *(const f32x4*)(g + d0), g1 = *(const f32x4*)(g + d0 + 4);
                        const f32x4 v0 = acc[ai][bj][m][0] * r * g0, v1 = acc[ai][bj][m][1] * r * g1;
                        u32x4 w; w.x = pk2(v0[0], v0[1]); w.y = pk2(v0[2], v0[3]); w.z = pk2(v1[0], v1[1]); w.w = pk2(v1[2], v1[3]);
                        *(u32x4*)(dst + d0) = w; }
                } else {
                    if (wc < 2) {
#pragma unroll
                        for (int n = 0; n < 2; ++n) { const int p0 = 32 * wc + 8 * fq + 4 * n;
                            if (p0 < 36) { const f32x4 v = acc[ai][0][m][n] * rs;
#pragma unroll
                                for (int e = 0; e < 4; ++e) gates[(size_t)row * 36 + p0 + e] = sigmoidf_(v[e] + gate_b[p0 + e]); } }
                    }
                }
            }
    }
};
struct EpiC {
    static constexpr bool PERM = false;
    float* part;
    DI void operator()(const Acc& acc, const Unit& u, int wr, int wc, int fr, int fq) const {
        const int row0 = u.pm * BM + wr * 64 + fr, col0 = wc * 32 + 4 * fq; float* pb = part + (size_t)(u.pn & 3) * 4096 * 256;
#pragma unroll
        for (int ai = 0; ai < 2; ++ai)
#pragma unroll
            for (int m = 0; m < 4; ++m) { float* rowp = pb + (size_t)(row0 + ai * HALF + m * 16) * 256 + col0;
#pragma unroll
                for (int bj = 0; bj < 2; ++bj)
#pragma unroll
                    for (int n = 0; n < 2; ++n) *(f32x4*)(rowp + bj * HALF + n * 16) = acc[ai][bj][m][n]; }
    }
};

constexpr size_t MiB = 1u << 20;
constexpr size_t WS_SS = 0;
constexpr size_t WS_BPART = 256 * 1024;
constexpr size_t WS_BIAS1 = 400 * 1024;
constexpr size_t WS_MK = 512 * 1024;
constexpr size_t WS_MVT = 768 * 1024;
constexpr size_t WS_KCMP = 1 * MiB;
constexpr size_t WS_VTCMP = 1 * MiB + 256 * 1024;
constexpr size_t WS_MEMB = 1 * MiB + 512 * 1024;
constexpr size_t WS_W = 8 * MiB;
constexpr size_t WS_WA = WS_W;
constexpr size_t WS_WO = WS_WA + 1792 * 1024 * 2;
constexpr size_t WS_W1 = WS_WO + 2 * 1024 * 1024 * 2;
constexpr size_t WS_W2 = WS_W1 + 2 * 4096 * 1024 * 2;
constexpr size_t WS_WB = WS_W2 + 2 * 4096 * 1024 * 2;
constexpr size_t WS_WM = WS_WB + 2048 * 1024 * 2;
constexpr size_t WS_W1C = WS_WM + 1024 * 1024 * 2;
constexpr size_t WS_W2C = WS_W1C + 512 * 2048 * 2;
constexpr size_t WS_WEND = WS_W2C + 2 * 64 * 256 * 2;
constexpr size_t WS_XB = 58 * MiB;
constexpr size_t WS_MIX = 90 * MiB;
constexpr size_t WS_HB = 122 * MiB;
constexpr size_t WS_END = 250 * MiB;
static_assert(WS_WEND <= WS_XB, "weights fit");
constexpr size_t WS_VGLU = WS_HB;
constexpr size_t WS_QM0 = WS_HB + 24 * MiB;
constexpr size_t WS_CBUF = WS_HB;
constexpr size_t WS_KSEL = WS_HB + 10 * MiB;
constexpr size_t WS_VTSEL = WS_HB + 14 * MiB;
constexpr size_t WS_KWIN = WS_HB + 18 * MiB;
constexpr size_t WS_VTWIN = WS_HB + 22 * MiB;
constexpr size_t WS_Q = WS_HB + 26 * MiB;
constexpr size_t WS_QM1 = WS_HB + 50 * MiB;
constexpr size_t WS_GATES = WS_HB + 58 * MiB;
constexpr size_t WS_IMP = WS_HB + 64 * MiB;
constexpr size_t WS_PART = WS_IMP;
constexpr size_t WS_OC = WS_HB + 96 * MiB;
constexpr size_t WS_CNT = 448 * 1024;

constexpr int LDS_BYTES = 147456;
constexpr int NWAVES = 8;

struct Params { const float* in[29]; float* out; unsigned char* ws; int ph_lo, ph_hi; };
enum { I_X = 0, I_MEM, I_NMIX, I_NMLP, I_MEMN, I_WMEMKV, I_MQG, I_MKG, I_WOUT, I_WMLPIN, I_WMLPOUT, I_AWIN, I_ABGLU, I_ADW, I_ADWB, I_ALNG, I_ALNB,
       I_BWIN, I_BGATEB, I_BQG, I_KVNG, I_WKV, I_KNG, I_PEK, I_PEV, I_W1K, I_W2K, I_W1V, I_W2V };

DI int hp(int p) { return 64 * ((p >> 5) & 3) + 32 * (p >> 7) + (p & 31); }
DI void tr_item(const float* __restrict__ W, int ldw, int src_col0, int nvalid, const float* __restrict__ gain, bf16* WT, int K, int dst_row0, int k0, LAS float* scr, int lane) {
    const int cc = lane & 31; const bool ok = cc < nvalid;
    const float* wp = W + (size_t)(k0 + (lane >> 5)) * ldw + src_col0 + (ok ? cc : 0);
    float v[32];
#pragma unroll
    for (int i = 0; i < 32; ++i) v[i] = __builtin_nontemporal_load(wp + (size_t)(2 * i) * ldw);
    const int c = lane & 7;
    f32x4 g0 = {1.f, 1.f, 1.f, 1.f}, g1 = {1.f, 1.f, 1.f, 1.f};
    if (gain) { g0 = *(const f32x4*)(gain + k0 + 8 * c); g1 = *(const f32x4*)(gain + k0 + 8 * c + 4); }
#pragma unroll
    for (int i = 0; i < 32; ++i) scr[(2 * i + (lane >> 5)) * 33 + cc] = ok ? v[i] : 0.f;
    LDS_WAIT();
#pragma unroll
    for (int j = 0; j < 4; ++j) { const int n = (lane >> 3) + 8 * j; const LAS float* s = scr + (8 * c) * 33 + n;
        u32x4 o; o.x = pk2(s[0 * 33] * g0[0], s[1 * 33] * g0[1]); o.y = pk2(s[2 * 33] * g0[2], s[3 * 33] * g0[3]); o.z = pk2(s[4 * 33] * g1[0], s[5 * 33] * g1[1]); o.w = pk2(s[6 * 33] * g1[2], s[7 * 33] * g1[3]);
        *(u32x4*)(WT + (size_t)(dst_row0 + n) * K + k0 + 8 * c) = o; }
    LDS_WAIT();
}
DI void rms_rows2_to_bf16(const float* xrow, bf16* orow, float* ssq, int lane) {
    const f32x4* xr = (const f32x4*)xrow + lane; f32x4 v[8]; float s0 = 0.f, s1 = 0.f;
#pragma unroll
    for (int j = 0; j < 8; ++j) v[j] = __builtin_nontemporal_load(xr + 64 * j);
#pragma unroll
    for (int j = 0; j < 4; ++j) { s0 += (v[j][0] * v[j][0] + v[j][1] * v[j][1]) + (v[j][2] * v[j][2] + v[j][3] * v[j][3]);
                                  s1 += (v[4 + j][0] * v[4 + j][0] + v[4 + j][1] * v[4 + j][1]) + (v[4 + j][2] * v[4 + j][2] + v[4 + j][3] * v[4 + j][3]); }
    s0 = wave_sum(s0); s1 = wave_sum(s1);
    float r0 = __builtin_amdgcn_rsqf(s0 * (1.0f / D) + EPS), r1 = __builtin_amdgcn_rsqf(s1 * (1.0f / D) + EPS);
    if (ssq) { if (lane == 0) { ssq[0] = s0; ssq[1] = s1; } r0 = 1.0f; r1 = 1.0f; }
    u32x2* o8 = (u32x2*)orow + lane;
#pragma unroll
    for (int j = 0; j < 8; ++j) { const float r = j < 4 ? r0 : r1; u32x2 w; w.x = pk2(v[j][0] * r, v[j][1] * r); w.y = pk2(v[j][2] * r, v[j][3] * r); o8[64 * j] = w; }
}
DI void p0_prologue(const Params& P, LAS unsigned char* lds, int gw, int NGW, int wave, int lane) {
    unsigned char* ws = P.ws;
    LAS float* scr = (LAS float*)(lds + wave * 16384);
    constexpr int NM = 11;
    const int rows[NM] = {1792, 1024, 1024, 4096, 4096, 1024, 1024, 2048, 1024, 512, 128};
    const int Ks[NM]   = {1024, 1024, 1024, 1024, 1024, 4096, 4096, 1024, 1024, 2048, 256};
    int total = 0;
#pragma unroll
    for (int m = 0; m < NM; ++m) total += (rows[m] / 32) * (Ks[m] / 64);
    for (int it = gw; it < total; it += NGW) {
        int r = it, m = 0;
#pragma unroll
        for (int mm = 0; mm < NM; ++mm) { const int cnt = (rows[mm] / 32) * (Ks[mm] / 64); if (m == mm && r >= cnt) { r -= cnt; m = mm + 1; } }
        int K = 1024, nkb = 16;
        if (m == 5 || m == 6) { K = 4096; nkb = 64; } else if (m == 9) { K = 2048; nkb = 32; } else if (m == 10) { K = 256; nkb = 4; }
        const int nb = r / nkb, kb = r % nkb, R0 = nb * 32, k0 = kb * 64;
        const float* W; int ldw, col, nvalid = 32; const float* gain = nullptr; bf16* WT;
        if (m == 0) { W = P.in[I_AWIN]; ldw = 1792; gain = P.in[I_NMIX]; WT = (bf16*)(ws + WS_WA);
            const int j = R0 >> 8, p = R0 & 255; col = j < 6 ? (p < 128 ? 128 * j + p : 768 + 128 * j + p - 128) : 1536 + hp(p); }
        else if (m <= 2) { W = P.in[I_WOUT] + (size_t)(m - 1) * D * D; ldw = D; col = R0; WT = (bf16*)(ws + WS_WO) + (size_t)(m - 1) * D * D; }
        else if (m <= 4) { W = P.in[I_WMLPIN] + (size_t)(m - 3) * D * FF; ldw = FF; col = R0; gain = P.in[I_NMLP] + (m - 3) * D; WT = (bf16*)(ws + WS_W1) + (size_t)(m - 3) * D * FF; }
        else if (m <= 6) { W = P.in[I_WMLPOUT] + (size_t)(m - 5) * D * FF; ldw = D; col = R0; WT = (bf16*)(ws + WS_W2) + (size_t)(m - 5) * D * FF; }
        else if (m == 7) { WT = (bf16*)(ws + WS_WB);
            if (R0 < 768) { W = P.in[I_WKV]; ldw = 768; col = (R0 & ~255) + hp(R0 & 255); gain = P.in[I_KVNG]; }
            else { const int uc = R0 - 768, uj = uc >> 8, p = uc & 255; W = P.in[I_BWIN]; ldw = 1060; gain = P.in[I_NMIX] + D; col = uj < 4 ? uj * 256 + hp(p) : 1024 + p;
                   nvalid = 1060 - col; nvalid = nvalid < 0 ? 0 : (nvalid > 32 ? 32 : nvalid); if (nvalid == 0) col = 0; } }
        else if (m == 8) { const int un = R0 >> 8, p = R0 & 255; W = P.in[I_WMEMKV] + (size_t)(un >> 1) * D * 512; ldw = 512; col = (un & 1) * 256 + hp(p); gain = P.in[I_MEMN]; WT = (bf16*)(ws + WS_WM); }
        else if (m == 9) { W = (R0 >> 8) ? P.in[I_W1V] : P.in[I_W1K]; ldw = 256; col = R0 & 255; WT = (bf16*)(ws + WS_W1C) + (size_t)((R0 >> 8) * 4 + (k0 >> 9)) * 256 * 512; }
        else { W = (R0 >> 6) ? P.in[I_W2V] : P.in[I_W2K]; ldw = 64; col = R0 & 63; WT = (bf16*)(ws + WS_W2C); }
        if (m == 9) tr_item(W + (size_t)(k0 & ~511) * ldw, ldw, col, nvalid, gain, WT, 512, R0 & 255, k0 & 511, scr, lane);
        else tr_item(W, ldw, col, nvalid, gain, WT, K, R0, k0, scr, lane);
    }
    for (int r2 = gw; r2 < (S + MEML) / 2; r2 += NGW) { const int r = 2 * r2;
        if (r < S) rms_rows2_to_bf16(P.in[I_X] + (size_t)r * D, (bf16*)(ws + WS_XB) + (size_t)r * D, (float*)(ws + WS_SS) + 3 * S + r, lane);
        else rms_rows2_to_bf16(P.in[I_MEM] + (size_t)(r - S) * D, (bf16*)(ws + WS_MEMB) + (size_t)(r - S) * D, nullptr, lane);
    }
    const int gt = gw * 64 + lane, NGT = NGW * 64;
    for (int i = gt; i < 3 * S; i += NGT) ((float*)(ws + WS_SS))[i] = 0.f;
    for (int i = gt; i < 2 * 64 * 256; i += NGT) { const int type = i >> 14, kc = (i >> 8) & 63, c = i & 255;
        const float* pe = P.in[type ? I_PEV : I_PEK] + kc * 32; const float* w1 = P.in[type ? I_W1V : I_W1K] + (size_t)kc * 32 * 256 + c; float s = 0.f;
#pragma unroll 8
        for (int k = 0; k < 32; ++k) s += pe[k] * w1[(size_t)k * 256];
        ((float*)(ws + WS_BPART))[i] = s; }
}

DI f32x16 mfma32(bf16x8 a, bf16x8 b, f32x16 c) { return __builtin_amdgcn_mfma_f32_32x32x16_bf16(a, b, c, 0, 0, 0); }
DI f32x4 mfma16(bf16x8 a, bf16x8 b, f32x4 c) { return __builtin_amdgcn_mfma_f32_16x16x32_bf16(a, b, c, 0, 0, 0); }
DI float gain_max(const float* g, int lane) { return wave_max(fabsf(g[lane])); }
DI void conv_task(const Params& P, int t0, int lane) {
    const bf16* vg = (const bf16*)(P.ws + WS_VGLU); const float* dw = P.in[I_ADW]; bf16* mix = (bf16*)(P.ws + WS_MIX);
    f32x4 acc[4][3];
#pragma unroll
    for (int i = 0; i < 3; ++i) { const f32x4 b = *(const f32x4*)(P.in[I_ADWB] + 4 * lane + 256 * i);
#pragma unroll
        for (int tt = 0; tt < 4; ++tt) acc[tt][i] = b; }
    f32x4 vr[4][3];
#define CONV_LDROW(dst, rr) do { _Pragma("unroll") for (int i = 0; i < 3; ++i) { u32x2 raw = *(const u32x2*)(vg + (size_t)((rr) >= 0 ? (rr) : 0) * 768 + 4 * lane + 256 * i); if ((rr) < 0) { raw.x = 0u; raw.y = 0u; } \
        dst[i] = (f32x4){__uint_as_float(raw.x << 16), __uint_as_float(raw.x & 0xffff0000u), __uint_as_float(raw.y << 16), __uint_as_float(raw.y & 0xffff0000u)}; } } while (0)
    CONV_LDROW(vr[0], t0 - 30); CONV_LDROW(vr[1], t0 - 29); CONV_LDROW(vr[2], t0 - 28);
#pragma unroll 8
    for (int j = 0; j < 31; ++j) {
        CONV_LDROW(vr[3], t0 - 27 + j);
        f32x4 w[3];
#pragma unroll
        for (int i = 0; i < 3; ++i) w[i] = *(const f32x4*)(dw + (size_t)j * 768 + 4 * lane + 256 * i);
#pragma unroll
        for (int tt = 0; tt < 4; ++tt)
#pragma unroll
            for (int i = 0; i < 3; ++i) acc[tt][i] += vr[tt][i] * w[i];
#pragma unroll
        for (int i = 0; i < 3; ++i) { vr[0][i] = vr[1][i]; vr[1][i] = vr[2][i]; vr[2][i] = vr[3][i]; }
    }
#undef CONV_LDROW
    f32x4 lg[3], lb[3];
#pragma unroll
    for (int i = 0; i < 3; ++i) { lg[i] = *(const f32x4*)(P.in[I_ALNG] + 4 * lane + 256 * i); lb[i] = *(const f32x4*)(P.in[I_ALNB] + 4 * lane + 256 * i); }
#pragma unroll
    for (int tt = 0; tt < 4; ++tt) {
        float s = 0.f;
#pragma unroll
        for (int i = 0; i < 3; ++i) s += (acc[tt][i][0] + acc[tt][i][1]) + (acc[tt][i][2] + acc[tt][i][3]);
        const float mean = wave_sum(s) * (1.0f / 768.0f); float q = 0.f;
#pragma unroll
        for (int i = 0; i < 3; ++i) { const f32x4 d = acc[tt][i] - mean; q += (d[0] * d[0] + d[1] * d[1]) + (d[2] * d[2] + d[3] * d[3]); }
        const float rstd = __builtin_amdgcn_rsqf(wave_sum(q) * (1.0f / 768.0f) + 1e-5f);
#pragma unroll
        for (int i = 0; i < 3; ++i) { f32x4 y = (acc[tt][i] - mean) * rstd * lg[i] + lb[i];
#pragma unroll
            for (int e = 0; e < 4; ++e) y[e] = y[e] * sigmoidf_(y[e]);
            st_bf16x4(mix + (size_t)(t0 + tt) * D + 4 * lane + 256 * i, y); }
    }
}

DI void cmp2_task(const Params& P, int task, int lane) {
    const int r = lane & 31, h = lane >> 5; const int row0 = task * 32; const int type = row0 >> 11, g = (row0 >> 10) & 1, n0 = row0 & 1023;
    const float* part = (const float*)(P.ws + WS_PART) + (size_t)(row0 + r) * 256 + 8 * h; const float* bb = (const float*)(P.ws + WS_BIAS1) + type * 256 + 8 * h;
    const bf16* w2 = (const bf16*)(P.ws + WS_W2C) + (size_t)type * 64 * 256;
    f32x16 O0, O1;
#pragma unroll
    for (int i = 0; i < 16; ++i) { O0[i] = 0.f; O1[i] = 0.f; }
#pragma unroll 4
    for (int s = 0; s < 16; ++s) {
        f32x4 a0 = *(const f32x4*)(bb + 16 * s), a1 = *(const f32x4*)(bb + 16 * s + 4);
#pragma unroll
        for (int kc = 0; kc < 4; ++kc) { a0 += *(const f32x4*)(part + (size_t)kc * 4096 * 256 + 16 * s); a1 += *(const f32x4*)(part + (size_t)kc * 4096 * 256 + 16 * s + 4); }
#pragma unroll
        for (int e = 0; e < 4; ++e) { float x = a0[e]; a0[e] = x * sigmoidf_(1.5957691216f * (x + 0.044715f * x * x * x)); x = a1[e]; a1[e] = x * sigmoidf_(1.5957691216f * (x + 0.044715f * x * x * x)); }
        u32x4 hw; hw.x = pk2(a0[0], a0[1]); hw.y = pk2(a0[2], a0[3]); hw.z = pk2(a1[0], a1[1]); hw.w = pk2(a1[2], a1[3]);
        const bf16x8 hb = __builtin_bit_cast(bf16x8, hw);
        O0 = mfma32(*(const bf16x8*)(w2 + (size_t)r * 256 + 16 * s + 8 * h), hb, O0);
        O1 = mfma32(*(const bf16x8*)(w2 + (size_t)(32 + r) * 256 + 16 * s + 8 * h), hb, O1);
    }
    if (type == 0) {
        float s = 0.f;
#pragma unroll
        for (int i = 0; i < 16; ++i) s += O0[i] * O0[i] + O1[i] * O1[i];
        s += __shfl_xor(s, 32);
        const float rs = __builtin_amdgcn_rsqf(s * (1.0f / 64.0f) + EPS);
        const int nk = n0 + r; bf16* kp = (bf16*)(P.ws + WS_KCMP) + ((size_t)g * 16 + (nk >> 6)) * 4096; const float* kg = P.in[I_KNG] + 4 * h;
#pragma unroll
        for (int q4 = 0; q4 < 4; ++q4) {
            const f32x4 g0 = *(const f32x4*)(kg + 8 * q4), g1 = *(const f32x4*)(kg + 32 + 8 * q4);
            st_bf16x4(kp + kimg(nk & 63, 4 * h + 8 * q4), (f32x4){O0[4 * q4], O0[4 * q4 + 1], O0[4 * q4 + 2], O0[4 * q4 + 3]} * rs * g0);
            st_bf16x4(kp + kimg(nk & 63, 32 + 4 * h + 8 * q4), (f32x4){O1[4 * q4], O1[4 * q4 + 1], O1[4 * q4 + 2], O1[4 * q4 + 3]} * rs * g1);
        }
    } else {
        const int nn = n0 + r; bf16* vp = (bf16*)(P.ws + WS_VTCMP) + ((size_t)g * 16 + (nn >> 6)) * 4096;
#pragma unroll
        for (int i = 0; i < 16; ++i) { const int c = (i & 3) + 8 * (i >> 2) + 4 * h;
            vp[vimg(c, nn & 63)] = (bf16)(pk2(O0[i], 0.f) & 0xffffu); vp[vimg(c + 32, nn & 63)] = (bf16)(pk2(O1[i], 0.f) & 0xffffu); }
    }
}

struct KV32 { bf16x8 k[4]; s16x4 v[8]; };
DI void kv32_load(KV32& d, const bf16* Kb, const bf16* VT, int key0, int r, int h) {
    const int ln = h * 32 + r; const size_t blk = (size_t)(key0 >> 6) * 4096; const int sub = (key0 >> 5) & 1;
    const bf16* kp = Kb + blk + sub * 2048 + ln * 8;
#pragma unroll
    for (int s = 0; s < 4; ++s) d.k[s] = *(const bf16x8*)(kp + s * 512);
    const bf16* vp = VT + blk + sub * 2048 + ln * 8;
#pragma unroll
    for (int i = 0; i < 4; ++i) { const bf16x8 w = *(const bf16x8*)(vp + i * 512); d.v[2 * i] = __builtin_shufflevector(w, w, 0, 1, 2, 3); d.v[2 * i + 1] = __builtin_shufflevector(w, w, 4, 5, 6, 7); }
}
DI float opaque_zero() { float z; asm volatile("v_mov_b32 %0, 0" : "=v"(z)); return z; }
DI f32x16 tile_qk(const KV32& d, const bf16x8 (&qf)[4], float c0) {
    f32x16 sc; const float c = c0 + opaque_zero();
#pragma unroll
    for (int i = 0; i < 16; ++i) sc[i] = c;
#pragma unroll
    for (int s = 0; s < 4; ++s) sc = mfma32(d.k[s], qf[s], sc);
    return sc;
}
DI void tile_pv(const KV32& d, const float (&p)[16], f32x16& O0, f32x16& O1) {
#pragma unroll
    for (int s2 = 0; s2 < 2; ++s2) {
        u32x4 pw; pw.x = pk2(p[8 * s2], p[8 * s2 + 1]); pw.y = pk2(p[8 * s2 + 2], p[8 * s2 + 3]); pw.z = pk2(p[8 * s2 + 4], p[8 * s2 + 5]); pw.w = pk2(p[8 * s2 + 6], p[8 * s2 + 7]);
        const bf16x8 pb = __builtin_bit_cast(bf16x8, pw);
        O0 = mfma32(__builtin_shufflevector(d.v[(s2 * 2) * 2], d.v[(s2 * 2) * 2 + 1], 0, 1, 2, 3, 4, 5, 6, 7), pb, O0);
        O1 = mfma32(__builtin_shufflevector(d.v[(s2 * 2 + 1) * 2], d.v[(s2 * 2 + 1) * 2 + 1], 0, 1, 2, 3, 4, 5, 6, 7), pb, O1);
    }
}
DI void tile_store(bf16* op, const f32x16& O0, const f32x16& O1, float sc) {
#pragma unroll
    for (int q4 = 0; q4 < 4; ++q4) {
        st_bf16x4(op + 8 * q4, (f32x4){O0[4 * q4], O0[4 * q4 + 1], O0[4 * q4 + 2], O0[4 * q4 + 3]} * sc);
        st_bf16x4(op + 32 + 8 * q4, (f32x4){O1[4 * q4], O1[4 * q4 + 1], O1[4 * q4 + 2], O1[4 * q4 + 3]} * sc);
    }
}
DI void mem_attn_task(const bf16* Qm, const bf16* mk, const bf16* mvT, bf16* mix, int t0, int head, float Bq, int lane) {
    const int r = lane & 31, h = lane >> 5;
    bf16x8 qf[4];
#pragma unroll
    for (int s = 0; s < 4; ++s) qf[s] = *(const bf16x8*)(Qm + (size_t)(t0 + r) * 256 + head * 64 + 16 * s + 8 * h);
    const bf16* Kb = mk + (size_t)head * 4 * 4096; const bf16* Vb = mvT + (size_t)head * 4 * 4096;
    f32x16 O0, O1; float l = 0.f;
#pragma unroll
    for (int i = 0; i < 16; ++i) { O0[i] = 0.f; O1[i] = 0.f; }
    KV32 A, B, C;
#define MA_STEP(BUF, st) do { if ((st) < nst) { const f32x16 sc = tile_qk(BUF, qf, -Bq); float p[16]; \
        _Pragma("unroll") for (int i = 0; i < 16; ++i) { p[i] = __builtin_amdgcn_exp2f(sc[i]); l += p[i]; } \
        tile_pv(BUF, p, O0, O1); } { const int _s = (st) + 3 < nst ? (st) + 3 : nst - 1; kv32_load(BUF, Kb, Vb, 32 * _s, r, h); } } while (0)
    const int nst = 8;
    kv32_load(A, Kb, Vb, 0, r, h); kv32_load(B, Kb, Vb, 32, r, h); kv32_load(C, Kb, Vb, 64, r, h);
#pragma unroll 1
    for (int st = 0; st < nst; st += 3) { MA_STEP(A, st); MA_STEP(B, st + 1); MA_STEP(C, st + 2); }
#undef MA_STEP
    l += __shfl_xor(l, 32);
    tile_store(mix + (size_t)(t0 + r) * D + 768 + head * 64 + 4 * h, O0, O1, 1.0f / l);
}
DI void mem_attn_phase(const Params& P, int layer, const bf16* Qm, int gw, int NGW, int lane) {
    if (gw < 0) return;
    const bf16* mk = (const bf16*)(P.ws + WS_MK) + (size_t)layer * 4 * 256 * 64; const bf16* mvT = (const bf16*)(P.ws + WS_MVT) + (size_t)layer * 4 * 64 * 256;
    const float Bq = BNDC * gain_max(P.in[I_MQG] + layer * 64, lane) * gain_max(P.in[I_MKG] + layer * 64, lane) * 1.02f;
    for (int task = gw; task < (S / 32) * 4; task += NGW) mem_attn_task(Qm, mk, mvT, (bf16*)(P.ws + WS_MIX), (task >> 2) * 32, task & 3, Bq, lane);
}

DI void cmp_tile_task(const Params& P, int qt, int g, float Bc, LAS float* wl, LAS bf16x8* qL, int lane) {
    unsigned char* ws = P.ws;
    const int r = lane & 31, h = lane >> 5, t = 32 * qt + r;
    const int nv = t >= 31 ? ((t - 31) >> 4) + 1 : 0;
    const int tl = 32 * qt + 31, nvmax = tl >= 31 ? ((tl - 31) >> 4) + 1 : 0, nsteps = (nvmax + 31) >> 5;
    const int tf = 32 * qt, nvmin = tf >= 31 ? ((tf - 31) >> 4) + 1 : 0;
    const bf16* Kc = (const bf16*)(ws + WS_KCMP) + (size_t)g * 1024 * 64; const bf16* Vc = (const bf16*)(ws + WS_VTCMP) + (size_t)g * 64 * 1024;
    const bf16* qrow = (const bf16*)(ws + WS_Q) + (size_t)t * 768 + g * 384 + 8 * h;
    bf16* oc = (bf16*)(ws + WS_OC) + (size_t)t * 768 + g * 384 + 4 * h;
    const float* gp = (const float*)(ws + WS_GATES) + (size_t)t * 36 + g * 18;
    for (int hh = 0; hh < 6; ++hh) {
        bf16x8 qf[4];
#pragma unroll
        for (int s = 0; s < 4; ++s) qf[s] = *(const bf16x8*)(qrow + hh * 64 + 16 * s);
        f32x16 O0, O1; float l = 0.f;
#pragma unroll
        for (int i = 0; i < 16; ++i) { O0[i] = 0.f; O1[i] = 0.f; }
        KV32 A, B, C;
#define CA_LD(BUF, st) do { const int _s = (st) < nsteps ? (st) : nsteps - 1; kv32_load(BUF, Kc, Vc, 32 * _s, r, h); } while (0)
#define CA_STEP(BUF, st) do { if ((st) < nsteps) { const f32x16 sc = tile_qk(BUF, qf, -Bc); float p[16]; \
        if (32 * (st) + 32 <= nvmin) { _Pragma("unroll") for (int i = 0; i < 16; ++i) { p[i] = __builtin_amdgcn_exp2f(sc[i]); l += p[i]; } } \
        else { _Pragma("unroll") for (int i = 0; i < 16; ++i) { const int key = 32 * (st) + (i & 3) + 8 * (i >> 2) + 4 * h; p[i] = key < nv ? __builtin_amdgcn_exp2f(sc[i]) : 0.f; l += p[i]; } } \
        tile_pv(BUF, p, O0, O1); } CA_LD(BUF, (st) + 3); } while (0)
        if (nsteps > 0) {
        CA_LD(A, 0); CA_LD(B, 1); CA_LD(C, 2);
        for (int st = 0; st < nsteps; st += 3) { CA_STEP(A, st); CA_STEP(B, st + 1); CA_STEP(C, st + 2); }
        }
#undef CA_LD
#undef CA_STEP
        l += __shfl_xor(l, 32);
        const float inv = l > 0.f ? 1.0f / l : 0.f;
        wl[hh * 32 + r] = inv;
        tile_store(oc + hh * 64, O0, O1, inv * gp[hh * 3]);
    }
    LDS_WAIT();
    float* impr = (float*)(ws + WS_IMP) + ((size_t)t * 2 + g) * 256 + h;
    bf16x8 q3[3][4]; float inv6[6];
#pragma unroll
    for (int hh = 0; hh < 6; ++hh) { const float iv = wl[hh * 32 + r]; inv6[hh] = iv > 0.f ? __builtin_amdgcn_logf(iv) - Bc : -1e30f; }
#pragma unroll
    for (int hh = 0; hh < 3; ++hh)
#pragma unroll
        for (int s = 0; s < 4; ++s) { q3[hh][s] = *(const bf16x8*)(qrow + hh * 64 + 16 * s); qL[(hh * 4 + s) * 64] = *(const bf16x8*)(qrow + (3 + hh) * 64 + 16 * s); }
    LDS_WAIT();
    float carry = 0.f;
    bf16x8 kf[4], kn[4];
    { const bf16* kp = Kc + (h * 32 + r) * 8;
#pragma unroll
      for (int s = 0; s < 4; ++s) kf[s] = *(const bf16x8*)(kp + s * 512); }
    for (int st = 0; st < nsteps; ++st) {
        { const int sn = st + 1 < nsteps ? st + 1 : st; const bf16* kp = Kc + (size_t)(sn >> 1) * 4096 + (sn & 1) * 2048 + (h * 32 + r) * 8;
#pragma unroll
            for (int s = 0; s < 4; ++s) kn[s] = *(const bf16x8*)(kp + s * 512); }
        asm volatile("" ::: "memory");
        float Ps[16];
#pragma unroll
        for (int i = 0; i < 16; ++i) Ps[i] = 0.f;
#pragma unroll
        for (int hh = 0; hh < 6; ++hh) {
            f32x16 sc; const float c = inv6[hh] + opaque_zero();
#pragma unroll
            for (int i = 0; i < 16; ++i) sc[i] = c;
            if (hh < 3) {
#pragma unroll
                for (int s = 0; s < 4; ++s) sc = mfma32(kf[s], q3[hh][s], sc);
            } else {
#pragma unroll
                for (int s = 0; s < 4; ++s) sc = mfma32(kf[s], qL[((hh - 3) * 4 + s) * 64], sc);
            }
            if (32 * st + 32 <= nvmin) {
#pragma unroll
                for (int i = 0; i < 16; ++i) Ps[i] += __builtin_amdgcn_exp2f(sc[i]);
            } else {
#pragma unroll
                for (int i = 0; i < 16; ++i) { const int key = 32 * st + (i & 3) + 8 * (i >> 2) + 4 * h; Ps[i] += key < nv ? __builtin_amdgcn_exp2f(sc[i]) : 0.f; }
            }
        }
        float y[4], val[4];
#pragma unroll
        for (int q4 = 0; q4 < 4; ++q4) { y[q4] = __shfl_xor(Ps[4 * q4 + 3], 32); val[q4] = 2.0f * (Ps[4 * q4] + Ps[4 * q4 + 1] + Ps[4 * q4 + 2]) + Ps[4 * q4 + 3]; }
        if (h == 1) {
#pragma unroll
            for (int q4 = 0; q4 < 4; ++q4) val[q4] += y[q4];
        } else { val[0] += carry; val[1] += y[0]; val[2] += y[1]; val[3] += y[2]; }
        carry = y[3];
#pragma unroll
        for (int q4 = 0; q4 < 4; ++q4) impr[8 * st + 2 * q4] = val[q4];
#pragma unroll
        for (int s = 0; s < 4; ++s) kf[s] = kn[s];
    }
    LDS_WAIT();
}
DI void win_tile_task(const Params& P, int qt, int head, float Bw, int lane) {
    unsigned char* ws = P.ws;
    const int r = lane & 31, h = lane >> 5, t0 = 32 * qt, t = t0 + r, g = head / 6;
    const bf16* Kw = (const bf16*)(ws + WS_KWIN) + (size_t)g * S * 64; const bf16* Vw = (const bf16*)(ws + WS_VTWIN) + (size_t)g * 64 * S;
    const int kstart = t0 >= 512 ? t0 - 512 : 0, nsteps = (t0 + 32 - kstart) >> 5;
    bf16x8 qf[4];
#pragma unroll
    for (int s = 0; s < 4; ++s) qf[s] = *(const bf16x8*)((const bf16*)(ws + WS_Q) + (size_t)t * 768 + head * 64 + 16 * s + 8 * h);
    f32x16 O0, O1; float l = 0.f;
#pragma unroll
    for (int i = 0; i < 16; ++i) { O0[i] = 0.f; O1[i] = 0.f; }
    KV32 cur, nxt;
    kv32_load(cur, Kw, Vw, kstart, r, h);
    for (int st = 0; st < nsteps; ++st) {
        { const int sn = st + 1 < nsteps ? st + 1 : st; kv32_load(nxt, Kw, Vw, kstart + 32 * sn, r, h); }
        const f32x16 sc = tile_qk(cur, qf, -Bw); float p[16];
        if (st > 0 && st + 1 < nsteps) {
#pragma unroll
            for (int i = 0; i < 16; ++i) { p[i] = __builtin_amdgcn_exp2f(sc[i]); l += p[i]; }
        } else {
#pragma unroll
            for (int i = 0; i < 16; ++i) { const int kp = kstart + 32 * st + (i & 3) + 8 * (i >> 2) + 4 * h; p[i] = (kp <= t && kp > t - 512) ? __builtin_amdgcn_exp2f(sc[i]) : 0.f; l += p[i]; }
        }
        tile_pv(cur, p, O0, O1);
        cur = nxt;
    }
    l += __shfl_xor(l, 32);
    const float g2 = ((const float*)(ws + WS_GATES))[(size_t)t * 36 + head * 3 + 2];
    tile_store((bf16*)P.out + (size_t)t * 768 + head * 64 + 4 * h, O0, O1, l > 0.f ? g2 / l : 0.f);
}

DI void sel_sub(const KV32& X, int key0, unsigned mb, const bf16x8 (&qa)[4], const LAS bf16x8* qbl, int kl, int tqa, int tqb, float Bs,
                f32x16& Oa0, f32x16& Oa1, f32x16& Ob0, f32x16& Ob1, float& la, float& lb, int h) {
    if (mb & 15u) {
        const bool vr = kl < 4 && ((mb >> kl) & 1u);
        const f32x16 sc = tile_qk(X, qa, vr ? -Bs : -1e30f); float p[16];
#pragma unroll
        for (int i = 0; i < 16; ++i) { const int key = key0 + (i & 3) + 8 * (i >> 2) + 4 * h; p[i] = key <= tqa ? __builtin_amdgcn_exp2f(sc[i]) : 0.f; la += p[i]; }
        tile_pv(X, p, Oa0, Oa1);
    }
    if (mb >> 4) {
        const bool vr = kl < 4 && ((mb >> (4 + kl)) & 1u);
        bf16x8 qb[4];
#pragma unroll
        for (int s = 0; s < 4; ++s) qb[s] = qbl[s * 64];
        const f32x16 sc = tile_qk(X, qb, vr ? -Bs : -1e30f); float p[16];
#pragma unroll
        for (int i = 0; i < 16; ++i) { const int key = key0 + (i & 3) + 8 * (i >> 2) + 4 * h; p[i] = key <= tqb ? __builtin_amdgcn_exp2f(sc[i]) : 0.f; lb += p[i]; }
        tile_pv(X, p, Ob0, Ob1);
    }
}
DI void sel_out(const Params& P, const f32x16& O0, const f32x16& O1, float l, int t, int head, int h) {
    unsigned char* ws = P.ws;
    l += __shfl_xor(l, 32);
    const float g1 = ((const float*)(ws + WS_GATES))[(size_t)t * 36 + head * 3 + 1];
    const float sc = l > 0.f ? g1 / l : 0.f;
    const size_t off = (size_t)t * 768 + head * 64 + 4 * h;
    bf16* op = (bf16*)(ws + WS_MIX) + (size_t)t * D + head * 64 + 4 * h;
    const bf16* oc = (const bf16*)(ws + WS_OC) + off; const bf16* ow = (const bf16*)P.out + off;
#pragma unroll
    for (int q4 = 0; q4 < 4; ++q4) {
        st_bf16x4(op + 8 * q4, (f32x4){O0[4 * q4], O0[4 * q4 + 1], O0[4 * q4 + 2], O0[4 * q4 + 3]} * sc + ld_bf16x4(oc + 8 * q4) + ld_bf16x4(ow + 8 * q4));
        st_bf16x4(op + 32 + 8 * q4, (f32x4){O1[4 * q4], O1[4 * q4 + 1], O1[4 * q4 + 2], O1[4 * q4 + 3]} * sc + ld_bf16x4(oc + 32 + 8 * q4) + ld_bf16x4(ow + 32 + 8 * q4));
    }
}
DI void sel_unit(const Params& P, int tb, int g, float Bs, LAS unsigned char* lds, int tid, int wave, int lane) {
    unsigned char* ws = P.ws;
    LAS unsigned* mask = (LAS unsigned*)lds;
    mask[tid] = 0u;
    __syncthreads();
    if (tb <= 15) { if (tid <= tb) { mask[2 * tid] = 0xffffffffu; mask[2 * tid + 1] = 0xffffffffu; } }
    else {
        if (tid < 3) { const int j = tid == 0 ? 0 : (tid == 1 ? tb - 1 : tb); mask[2 * j] = 0xffffffffu; mask[2 * j + 1] = 0xffffffffu; }
        for (int k = 0; k < 8; ++k) {
            const int q = wave * 8 + k, t = 64 * tb + q;
            const f32x4 a = *(const f32x4*)((const float*)(ws + WS_IMP) + ((size_t)t * 2 + g) * 256 + 4 * lane);
            unsigned key[4];
#pragma unroll
            for (int e = 0; e < 4; ++e) { const int j = 4 * lane + e; key[e] = (j >= 1 && j <= tb - 2) ? __float_as_uint(a[e]) + 1u : 0u; }
            for (int it = 0; it < 13; ++it) {
                unsigned m = key[0] > key[1] ? key[0] : key[1]; const unsigned m2 = key[2] > key[3] ? key[2] : key[3]; m = m > m2 ? m : m2;
                const unsigned wm = wave_max_u32(m);
                const unsigned long long bal = __ballot(m == wm);
                const int src = __ffsll((long long)bal) - 1;
                if (lane == src) {
                    const int e = key[0] == wm ? 0 : (key[1] == wm ? 1 : (key[2] == wm ? 2 : 3));
                    __hip_atomic_fetch_or(mask + 2 * (4 * lane + e) + (q >> 5), 1u << (q & 31), __ATOMIC_RELAXED, __HIP_MEMORY_SCOPE_WORKGROUP);
                    key[0] = e == 0 ? 0u : key[0]; key[1] = e == 1 ? 0u : key[1]; key[2] = e == 2 ? 0u : key[2]; key[3] = e == 3 ? 0u : key[3];
                }
            }
        }
    }
    __syncthreads();
    const int r = lane & 31, h = lane >> 5;
    const int kl = (r * 43) >> 8, hd = r - 6 * kl, klc = kl < 4 ? kl : 0;
    const int tqa = 64 * tb + wave * 8 + klc, tqb = tqa + 4, head = g * 6 + (kl < 4 ? hd : 0);
    const bf16* Ks = (const bf16*)(ws + WS_KSEL) + (size_t)g * S * 64; const bf16* Vs = (const bf16*)(ws + WS_VTSEL) + (size_t)g * 64 * S;
    bf16x8 qa[4]; LAS bf16x8* qb = (LAS bf16x8*)(lds + 16384 + wave * 4096) + lane;
#pragma unroll
    for (int s = 0; s < 4; ++s) { qa[s] = *(const bf16x8*)((const bf16*)(ws + WS_Q) + (size_t)tqa * 768 + head * 64 + 16 * s + 8 * h);
                                  qb[s * 64] = *(const bf16x8*)((const bf16*)(ws + WS_Q) + (size_t)tqb * 768 + head * 64 + 16 * s + 8 * h); }
    LDS_WAIT();
    f32x16 Oa0, Oa1, Ob0, Ob1; float la = 0.f, lb = 0.f;
#pragma unroll
    for (int i = 0; i < 16; ++i) { Oa0[i] = 0.f; Oa1[i] = 0.f; Ob0[i] = 0.f; Ob1[i] = 0.f; }
    LAS unsigned short* wlist = (LAS unsigned short*)(lds + 2048 + wave * 512);
    int n = 0;
#pragma unroll
    for (int i = 0; i < 4; ++i) { const int jj = 64 * i + lane; unsigned bb = 0u;
        if (jj <= tb) bb = (mask[2 * jj + (wave >> 2)] >> (8 * (wave & 3))) & 0xffu;
        const unsigned long long bal = __ballot(bb != 0u); const int pos = n + __popcll(bal & ((1ull << lane) - 1ull));
        if (bb) wlist[pos] = (unsigned short)(jj | (bb << 8));
        n += __popcll(bal); }
    const int n2 = 2 * __builtin_amdgcn_readfirstlane(n);
    LDS_WAIT();
    KV32 A, B, C;
#define SEL_LD(BUF, pos) do { const int _pp = (pos) < n2 ? (pos) : n2 - 1; const int _e = __builtin_amdgcn_readfirstlane((int)wlist[_pp >> 1]); kv32_load(BUF, Ks, Vs, 64 * (_e & 255) + 32 * (_pp & 1), r, h); } while (0)
#define SEL_STEP(BUF, pos) do { if ((pos) < n2) { const int _e = __builtin_amdgcn_readfirstlane((int)wlist[(pos) >> 1]); \
        sel_sub(BUF, 64 * (_e & 255) + 32 * ((pos) & 1), (unsigned)_e >> 8, qa, qb, kl, tqa, tqb, Bs, Oa0, Oa1, Ob0, Ob1, la, lb, h); } SEL_LD(BUF, (pos) + 3); } while (0)
    if (n2 > 0) {
        SEL_LD(A, 0); SEL_LD(B, 1); SEL_LD(C, 2);
        for (int p = 0; p < n2; p += 3) { SEL_STEP(A, p); SEL_STEP(B, p + 1); SEL_STEP(C, p + 2); }
    }
#undef SEL_LD
#undef SEL_STEP
    if (kl < 4) { sel_out(P, Oa0, Oa1, la, tqa, head, h); sel_out(P, Ob0, Ob1, lb, tqb, head, h); }
    __syncthreads();
}

#define XB_TMO      128
#define XB_XCNT(j)  (256  + 64 * (j))
#define XB_XSUB(j)  (1280 + 64 * (j))
#define XB_XGEN(j)  (2304 + 64 * (j))
#define XB_TOP      3328
#define XB_TOPGEN   3392
#define XCD_BAR_WORDS 3456
#define XB_SPIN_CAP (1u << 18)

__device__ __forceinline__ unsigned xb_ld(unsigned* p)              { return __hip_atomic_load(p, __ATOMIC_RELAXED, __HIP_MEMORY_SCOPE_AGENT); }
__device__ __forceinline__ unsigned xb_add(unsigned* p, unsigned v) { return __hip_atomic_fetch_add(p, v, __ATOMIC_RELAXED, __HIP_MEMORY_SCOPE_AGENT); }
__device__ __forceinline__ unsigned xb_xcc_id() { return (unsigned)__builtin_amdgcn_s_getreg((3 << 11) | 20) & 0xFu; }
#define XB_SPIN(cond, bar) do { unsigned _sp = 0; while (cond) { __builtin_amdgcn_s_sleep(1); \
    if ((++_sp & 255u) == 0u) { if (xb_ld(&(bar)[XB_TMO])) break; if (_sp > XB_SPIN_CAP) { atomicAdd(&(bar)[XB_TMO], 1u); break; } } } } while (0)

struct XcdBarrier {
    unsigned* bar; unsigned x;
    volatile LAS unsigned* st;
};

__device__ __forceinline__ XcdBarrier xcd_barrier_post(unsigned* bar, volatile LAS unsigned* st) {
    XcdBarrier b; b.bar = bar; b.x = xb_xcc_id(); b.st = st;
    if (threadIdx.x == 0) (void)xb_add(&bar[XB_XCNT(b.x)], 1u);
    return b;
}
__device__ __forceinline__ void xcd_barrier_complete(unsigned* bar, unsigned x, unsigned& nloc, unsigned& nx) {
    const unsigned G = gridDim.x * gridDim.y * gridDim.z;
    unsigned sum, cnt, mine, sp = 0u;
    for (;;) {
        sum = 0u; cnt = 0u; mine = 0u;
#pragma unroll
        for (unsigned j = 0; j < 16; ++j) { const unsigned c = xb_ld(&bar[XB_XCNT(j)]); sum += c; cnt += (c > 0u) ? 1u : 0u; mine = (j == x) ? c : mine; }
        if (sum == G) break;
        __builtin_amdgcn_s_sleep(1);
        if ((++sp & 255u) == 0u) { if (xb_ld(&bar[XB_TMO])) break; if (sp > XB_SPIN_CAP) { atomicAdd(&bar[XB_TMO], 1u); break; } }
    }
    nloc = mine > 0u ? mine : 1u; nx = cnt > 0u ? cnt : 1u;
}

__device__ __forceinline__ void xcd_barrier(const XcdBarrier& b) {
    asm volatile("s_waitcnt vmcnt(0)" ::: "memory");
    __syncthreads();
    if (threadIdx.x == 0) {
        unsigned* bar = b.bar;
        __builtin_amdgcn_s_waitcnt(0);
        unsigned nloc = b.st[0], nx = b.st[1];
        if (nloc == 0u) { xcd_barrier_complete(bar, b.x, nloc, nx); b.st[0] = nloc; b.st[1] = nx; }
        const unsigned old = xb_add(&bar[XB_XSUB(b.x)], 1u);
        const unsigned gen = old / nloc;
        if (old + 1u == (gen + 1u) * nloc) {
            __builtin_amdgcn_fence(__ATOMIC_RELEASE, "agent");
            asm volatile("s_waitcnt vmcnt(0)" ::: "memory");
            const unsigned og = xb_add(&bar[XB_TOP], 1u);
            const unsigned tg = og / nx;
            if (og + 1u == (tg + 1u) * nx) xb_add(&bar[XB_TOPGEN], 1u);
            else XB_SPIN(xb_ld(&bar[XB_TOPGEN]) == tg, bar);
            __builtin_amdgcn_fence(__ATOMIC_ACQUIRE, "agent");
            xb_add(&bar[XB_XGEN(b.x)], 1u);
            asm volatile("s_waitcnt vmcnt(0)" ::: "memory");
        } else {
            XB_SPIN(xb_ld(&bar[XB_XGEN(b.x)]) == gen, bar);
            __builtin_amdgcn_fence(__ATOMIC_ACQUIRE, "agent");
            asm volatile("s_waitcnt vmcnt(0)" ::: "memory");
        }
    }
    __syncthreads();
}

__global__ void __launch_bounds__(NWAVES * 64, 2) yoco_fwd(Params P) {
    extern __shared__ __attribute__((aligned(16))) unsigned char lds_raw[];
    LAS unsigned char* lds = (LAS unsigned char*)lds_raw;
    const int tid = threadIdx.x, lane = tid & 63, wave = __builtin_amdgcn_readfirstlane(tid >> 6);
    const int G = gridDim.x, bx = blockIdx.x;
    const int gw = bx * NWAVES + wave, NGW = G * NWAVES;
    unsigned char* ws = P.ws;
    const int lo = P.ph_lo, hi = P.ph_hi;
#ifndef PH_MASK
#define PH_MASK 0x3fff
#endif
#define IN(k) (((PH_MASK >> (k)) & 1) && lo <= (k) && (k) < hi)
    volatile LAS unsigned* xst = (volatile LAS unsigned*)(lds + LDS_BYTES - 64);
    if (tid < 2) xst[tid] = 0u;
    __syncthreads();
    const XcdBarrier xbar = xcd_barrier_post((unsigned*)(ws + WS_CNT) + 1024, xst);
#define SEAM(k) do { if (IN(k) && IN((k) + 1)) { { xcd_barrier(xbar); } } } while (0)
    float* ss1 = (float*)(ws + WS_SS); float* ss2 = ss1 + S; float* ss3 = ss2 + S;
    bf16* xb = (bf16*)(ws + WS_XB); bf16* mix = (bf16*)(ws + WS_MIX); bf16* hb = (bf16*)(ws + WS_HB);

    if (IN(0)) { p0_prologue(P, lds, gw, NGW, wave, lane); __syncthreads(); }
    SEAM(0);
    if (IN(1)) {
        { pg8::Gemm g{xb, (const bf16*)(ws + WS_WA), S, 1792, D, D}; pg8::StaticOrder So; So.init(S, 1792, G, bx);
          EpiA E{(bf16*)(ws + WS_VGLU), (bf16*)(ws + WS_QM0), P.in[I_ABGLU], P.in[I_MQG], ss1 + 3 * S};
          pg8::gemm_phase<EpiA, pg8::StaticOrder, true>(lds, g, So, E); }
        { pg8::Gemm g{(const bf16*)(ws + WS_MEMB), (const bf16*)(ws + WS_WM), 256, 1024, D, D};
          const int c = G >= 4 ? bx - (G - 4) : bx; pg8::ListOrder So{4, 4, G >= 4 ? 4 : G, c, 0};
          EpiMem E{(bf16*)(ws + WS_MK), (bf16*)(ws + WS_MVT), P.in[I_MKG]};
          pg8::gemm_phase<EpiMem, pg8::ListOrder, true>(lds, g, So, E); }
    }
    SEAM(1);
    if (IN(2)) {
        for (int task = gw; task < S / 4; task += NGW) conv_task(P, task * 4, lane);
        mem_attn_phase(P, 0, (const bf16*)(ws + WS_QM0), gw, NGW, lane);
        if (bx == 0) { const int i = tid; float s = 0.f; const float* bp = (const float*)(ws + WS_BPART) + (i >> 8) * 64 * 256 + (i & 255);
            for (int kc = 0; kc < 64; ++kc) s += bp[kc * 256];
            ((float*)(ws + WS_BIAS1))[i] = s; }
    }
    SEAM(2);
    if (IN(3)) { pg8::Gemm g{mix, (const bf16*)(ws + WS_WO), S, D, D, D}; pg8::StaticOrder So; So.init(S, D, G, bx);
        EpiRes E{nullptr, xb, nullptr, xb, ss1, 0}; pg8::gemm_phase<EpiRes, pg8::StaticOrder, true>(lds, g, So, E); }
    SEAM(3);
    if (IN(4)) { pg8::Gemm g{xb, (const bf16*)(ws + WS_W1), S, FF, D, D}; pg8::StaticOrder So; So.init(S, FF, G, bx);
        EpiMlpIn E{hb, ss1}; pg8::gemm_phase<EpiMlpIn, pg8::StaticOrder, true>(lds, g, So, E); }
    SEAM(4);
    if (IN(5)) { pg8::Gemm g{hb, (const bf16*)(ws + WS_W2), S, D, FF, FF}; pg8::StaticOrder So; So.init(S, D, G, bx);
        EpiRes E{nullptr, xb, nullptr, xb, ss2, 0}; pg8::gemm_phase<EpiRes, pg8::StaticOrder, true>(lds, g, So, E); }
    SEAM(5);
    if (IN(6)) {
        if (bx == 0 && tid < 512) ((unsigned*)(ws + WS_CBUF + (size_t)4 * S * 64 * 2))[tid] = 0u;
        pg8::Gemm g{xb, (const bf16*)(ws + WS_WB), S, 2048, D, D}; pg8::StaticOrder So; So.init(S, 2048, G, bx);
        EpiB E{ss2, (bf16*)(ws + WS_CBUF), (bf16*)(ws + WS_KSEL), (bf16*)(ws + WS_VTSEL), (bf16*)(ws + WS_KWIN), (bf16*)(ws + WS_VTWIN), (bf16*)(ws + WS_Q), (bf16*)(ws + WS_QM1),
               (float*)(ws + WS_GATES), P.in[I_KNG], P.in[I_BQG], P.in[I_MQG] + 64, P.in[I_BGATEB]};
        pg8::gemm_phase<EpiB, pg8::StaticOrder, true>(lds, g, So, E); }
    SEAM(6);
    if (IN(7)) {
        { pg8::Gemm g{(const bf16*)(ws + WS_CBUF), (const bf16*)(ws + WS_W1C), 4096, 2048, 512, 1024}; pg8::ListOrder So{64, 1, G, bx, 1};
          EpiC E{(float*)(ws + WS_PART)}; pg8::gemm_phase<EpiC, pg8::ListOrder, true>(lds, g, So, E); }
        if (G > 128) mem_attn_phase(P, 1, (const bf16*)(ws + WS_QM1), bx >= 64 ? gw - 64 * NWAVES : -1, NGW - 64 * NWAVES, lane);
        else mem_attn_phase(P, 1, (const bf16*)(ws + WS_QM1), gw, NGW, lane);
    }
    SEAM(7);
    if (IN(8)) { for (int task = wave * G + bx; task < 128; task += NWAVES * G) cmp2_task(P, task, lane); }
    SEAM(8);
    if (IN(9)) {
        const float gq = gain_max(P.in[I_BQG], lane);
        const float Bc = BNDC * gq * gain_max(P.in[I_KNG], lane) * 1.02f, Bw = BNDC * gq * gain_max(P.in[I_KNG] + 128, lane) * 1.02f;
        LAS float* wl = (LAS float*)(lds + wave * 1024);
        unsigned* cq = (unsigned*)(ws + WS_CNT); unsigned* wq = cq + 3;
        volatile LAS unsigned* pflag = (volatile LAS unsigned*)(lds + 120000);
        unsigned idx0 = 0xffffffffu;
        if (wave < 4) { if (lane == 0) idx0 = atomicAdd(cq, 1u); idx0 = (unsigned)__builtin_amdgcn_readfirstlane((int)idx0); if (lane == 0) pflag[wave] = idx0 < 448u ? 1u : 0u; }
        __syncthreads();
        if (wave < 4) {
            if (idx0 < 1024u) cmp_tile_task(P, 511 - (int)(idx0 >> 1), (int)(idx0 & 1u), Bc, wl, (LAS bf16x8*)(lds + 16384 + wave * 12288) + lane, lane);
            if (lane == 0) pflag[wave] = 0u;
        } else {
            while (__builtin_amdgcn_readfirstlane((int)pflag[wave - 4]) != 0) __builtin_amdgcn_s_sleep(32);
        }
        for (int pass = 0; pass < 2; ++pass) {
            const bool do_cmp = (wave < 4) == (pass == 0);
            for (;;) {
                unsigned idx = 0; if (lane == 0) idx = atomicAdd(do_cmp ? cq : wq, 1u); idx = (unsigned)__builtin_amdgcn_readfirstlane((int)idx);
                if (idx >= (do_cmp ? 1024u : 6144u)) break;
                if (do_cmp) cmp_tile_task(P, 511 - (int)(idx >> 1), (int)(idx & 1u), Bc, wl, (LAS bf16x8*)(lds + 16384 + wave * 12288) + lane, lane);
                else win_tile_task(P, (int)(idx / 12u), (int)(idx % 12u), Bw, lane);
            }
        }
        __syncthreads();
    }
    SEAM(9);
    if (IN(10)) {
        const float Bs = BNDC * gain_max(P.in[I_BQG], lane) * gain_max(P.in[I_KNG] + 64, lane) * 1.02f;
        if (G == 256) {
            sel_unit(P, 255 - (bx >> 1), bx & 1, Bs, lds, tid, wave, lane);
            sel_unit(P, bx >> 1, bx & 1, Bs, lds, tid, wave, lane);
        } else {
            for (int i = 0, u = bx; u < 512; ++i, u += G) {
                const int base = i * G, span = (512 - base) < G ? (512 - base) : G;
                const int uu = (i & 1) ? base + span - 1 - (u - base) : u;
                const int v = 511 - uu;
                sel_unit(P, v >> 1, v & 1, Bs, lds, tid, wave, lane);
            }
        }
    }
    SEAM(10);
    if (IN(11)) { pg8::Gemm g{mix, (const bf16*)(ws + WS_WO) + (size_t)D * D, S, D, D, D}; pg8::StaticOrder So; So.init(S, D, G, bx);
        EpiRes E{nullptr, xb, nullptr, xb, ss3, 0}; pg8::gemm_phase<EpiRes, pg8::StaticOrder, true>(lds, g, So, E); }
    SEAM(11);
    if (IN(12)) { pg8::Gemm g{xb, (const bf16*)(ws + WS_W1) + (size_t)D * FF, S, FF, D, D}; pg8::StaticOrder So; So.init(S, FF, G, bx);
        EpiMlpIn E{hb, ss3}; pg8::gemm_phase<EpiMlpIn, pg8::StaticOrder, true>(lds, g, So, E); }
    SEAM(12);
    if (IN(13)) { pg8::Gemm g{hb, (const bf16*)(ws + WS_W2) + (size_t)D * FF, S, D, FF, FF}; pg8::StaticOrder So; So.init(S, D, G, bx);
        EpiRes E{nullptr, xb, P.out, xb, ss3, 1}; pg8::gemm_phase<EpiRes, pg8::StaticOrder, true>(lds, g, So, E); }
    if (P.ph_hi > 1000) cg::this_grid().sync();
#undef IN
#undef SEAM
}

extern "C" void kernel_launch(void* const* d_in, const int* in_sizes, int n_in, void* d_out, int out_size, void* d_ws, size_t ws_size, hipStream_t stream) {
    static int grid = 0;
    if (grid == 0) {
        if (n_in != 29 || out_size != S * D || ws_size < WS_END) { fprintf(stderr, "kernel_launch: unexpected shapes (n_in %d out %d ws %zu)\n", n_in, out_size, ws_size); grid = -1; return; }
        int dev = 0, cus = 0, per_cu = 0;
        hipGetDevice(&dev); hipDeviceGetAttribute(&cus, hipDeviceAttributeMultiprocessorCount, dev);
        hipFuncSetAttribute((const void*)yoco_fwd, hipFuncAttributeMaxDynamicSharedMemorySize, LDS_BYTES);
        hipOccupancyMaxActiveBlocksPerMultiprocessor(&per_cu, (const void*)yoco_fwd, NWAVES * 64, LDS_BYTES);
        if (per_cu < 1) { fprintf(stderr, "kernel_launch: occupancy query reports %d\n", per_cu); per_cu = 1; }
        (void)hipGetLastError();
        grid = cus;
    }
    if (grid < 0) return;
    (void)hipMemsetAsync((char*)d_ws + WS_CNT, 0, 32768, stream);
    Params p{};
    for (int i = 0; i < 29; ++i) p.in[i] = (const float*)d_in[i];
    p.out = (float*)d_out; p.ws = (unsigned char*)d_ws; p.ph_lo = 0; p.ph_hi = 14;
    void* args[] = {&p};
    hipError_t e = hipLaunchCooperativeKernel((const void*)yoco_fwd, dim3(grid), dim3(NWAVES * 64), args, LDS_BYTES, stream);
    if (e != hipSuccess) fprintf(stderr, "cooperative launch failed: %s (grid %d)\n", hipGetErrorString(e), grid);
}
```
